# Optimizing an MI355X kernel written in HIP

```python
import math
import jax, jax.numpy as jnp
from jax import lax
import numpy as np

D_MODEL = 1024
BATCH = 2
SEQ = 8192
DEPTH = 2

FOX_HEADS = 8
FOX_HEAD_DIM = 64
FOX_WIDTH = FOX_HEADS * FOX_HEAD_DIM
Q_BLOCK = 128
CONV_CHANNELS = D_MODEL // 2
CONV_WIDTH = 31
MLSTM_HEADS = 8
MLSTM_HEAD_DIM = 128
MLSTM_WIDTH = MLSTM_HEADS * MLSTM_HEAD_DIM
MLSTM_CONV_WIDTH = 4
MLSTM_CHUNK = 64
D_FF = 2816
N_EXPERTS = 8
TOP_K = 2
D_FF_EXPERT = 3584
EPS = 1e-6

IN0_WIDTH = 3 * FOX_WIDTH + FOX_HEADS + 2 * CONV_CHANNELS
IN1_WIDTH = 3 * MLSTM_WIDTH + 2 * MLSTM_HEADS

kernel_name = "fox_conformer_mlstm_moe_hybrid"


def rms_norm(x, g):
    xf = x.astype(jnp.float32)
    y = xf * lax.rsqrt(jnp.mean(xf * xf, axis=-1, keepdims=True) + EPS)
    return (y * g.astype(jnp.float32)).astype(x.dtype)


def layer_norm(x, g, b):
    xf = x.astype(jnp.float32)
    mu = jnp.mean(xf, axis=-1, keepdims=True)
    var = jnp.mean(jnp.square(xf - mu), axis=-1, keepdims=True)
    y = (xf - mu) * lax.rsqrt(var + EPS)
    return (y * g.astype(jnp.float32) + b.astype(jnp.float32)).astype(x.dtype)


def causal_depthwise_conv(x, w, b):
    width, ch = w.shape
    y = lax.conv_general_dilated(
        x, w[:, None, :].astype(x.dtype), window_strides=(1,), padding=[(width - 1, 0)],
        dimension_numbers=("NWC", "WIO", "NWC"), feature_group_count=ch)
    return y + b.astype(x.dtype)


def swiglu(h, w_gate, w_up, w_down):
    return (jax.nn.silu(h @ w_gate) * (h @ w_up)) @ w_down


def forgetting_attention(q, k, v, log_f):
    b_, h_, s_, dh = q.shape
    nb = s_ // Q_BLOCK
    c = jnp.cumsum(log_f, axis=-1)
    scale = dh ** -0.5
    qb = q.reshape(b_, h_, nb, Q_BLOCK, dh).transpose(2, 0, 1, 3, 4)
    cb = c.reshape(b_, h_, nb, Q_BLOCK).transpose(2, 0, 1, 3)
    key_pos = jnp.arange(s_)

    def one_block(args):
        q_blk, c_blk, blk = args
        logits = jnp.einsum("bhqd,bhkd->bhqk", q_blk, k,
                            preferred_element_type=jnp.float32) * scale
        logits = logits + (c_blk[..., :, None] - c[..., None, :])
        q_pos = blk * Q_BLOCK + jnp.arange(Q_BLOCK)
        logits = jnp.where(key_pos[None, :] <= q_pos[:, None], logits, -jnp.inf)
        p = jax.nn.softmax(logits, axis=-1)
        return jnp.einsum("bhqk,bhkd->bhqd", p.astype(v.dtype), v)

    out = lax.map(one_block, (qb, cb, jnp.arange(nb)))
    return out.transpose(1, 2, 0, 3, 4).reshape(b_, h_, s_, dh)


def mlstm_chunkwise(q, k, v, log_i, log_f):
    b_, h_, s_, dk = q.shape
    dv = v.shape[-1]
    L = MLSTM_CHUNK
    nc = s_ // L

    def chunks(t):
        return jnp.moveaxis(t.reshape(b_, h_, nc, L, *t.shape[3:]), 2, 0)

    qc = chunks(q.astype(jnp.float32))
    kc = chunks(k.astype(jnp.float32))
    vc = chunks(v.astype(jnp.float32))
    ic, fc = chunks(log_i), chunks(log_f)
    bcum = jnp.cumsum(fc, axis=-1)
    gtot = bcum[..., -1]
    a_end = gtot[..., None] - bcum + ic
    tri = jnp.tril(jnp.ones((L, L), dtype=bool))
    dmat = jnp.where(tri, bcum[..., :, None] - bcum[..., None, :] + ic[..., None, :], -jnp.inf)

    def step(carry, xs):
        C, n, m = carry
        q_, k_, v_, b_c, g_c, a_c, d_c = xs
        inter = b_c + m[..., None]
        m_t = jnp.maximum(inter, jnp.max(d_c, axis=-1))
        w_inter = jnp.exp(inter - m_t)
        w_intra = jnp.exp(d_c - m_t[..., None]) * jnp.einsum("bhld,bhsd->bhls", q_, k_)
        num = (w_inter[..., None] * jnp.einsum("bhvd,bhld->bhlv", C, q_)
               + jnp.einsum("bhls,bhsv->bhlv", w_intra, v_))
        nq = w_inter * jnp.einsum("bhd,bhld->bhl", n, q_) + jnp.sum(w_intra, axis=-1)
        h = num / jnp.maximum(jnp.abs(nq), jnp.exp(-m_t))[..., None]
        m_new = jnp.maximum(g_c + m, jnp.max(a_c, axis=-1))
        decay = jnp.exp(g_c + m - m_new)
        w_in = jnp.exp(a_c - m_new[..., None])
        C_new = decay[..., None, None] * C + jnp.einsum("bhs,bhsv,bhsd->bhvd", w_in, v_, k_)
        n_new = decay[..., None] * n + jnp.einsum("bhs,bhsd->bhd", w_in, k_)
        return (C_new, n_new, m_new), h

    init = (jnp.zeros((b_, h_, dv, dk), jnp.float32),
            jnp.zeros((b_, h_, dk), jnp.float32),
            jnp.zeros((b_, h_), jnp.float32))
    _, hs = lax.scan(step, init, (qc, kc, vc, bcum, gtot, a_end, dmat))
    return jnp.moveaxis(hs, 0, 2).reshape(b_, h_, s_, dv)


def even_mixer(h, w_in, b_f, dw_w, dw_b, cln_g, cln_b, w_out):
    b_, s_, _ = h.shape
    proj = h @ w_in
    q, k, v, f_pre, glu_in = jnp.split(
        proj, [FOX_WIDTH, 2 * FOX_WIDTH, 3 * FOX_WIDTH, 3 * FOX_WIDTH + FOX_HEADS], axis=-1)

    def heads(t):
        return t.reshape(b_, s_, FOX_HEADS, FOX_HEAD_DIM).transpose(0, 2, 1, 3)

    log_f = jax.nn.log_sigmoid((f_pre + b_f).astype(jnp.float32)).transpose(0, 2, 1)
    att = forgetting_attention(heads(q), heads(k), heads(v), log_f)
    att = att.transpose(0, 2, 1, 3).reshape(b_, s_, FOX_WIDTH)

    a, gate = jnp.split(glu_in, 2, axis=-1)
    u = a * jax.nn.sigmoid(gate)
    u = causal_depthwise_conv(u, dw_w, dw_b)
    u = jax.nn.silu(layer_norm(u, cln_g, cln_b))

    return jnp.concatenate([att, u], axis=-1) @ w_out


def odd_mixer(h, w_in, b_i, b_f, conv_w, conv_b, wq_head, wk_head, hnorm_g, w_out):
    b_, s_, _ = h.shape
    proj = h @ w_in
    u, v, o, i_pre, f_pre = jnp.split(
        proj, [MLSTM_WIDTH, 2 * MLSTM_WIDTH, 3 * MLSTM_WIDTH, 3 * MLSTM_WIDTH + MLSTM_HEADS], axis=-1)
    u = jax.nn.silu(causal_depthwise_conv(u, conv_w, conv_b))
    u = u.reshape(b_, s_, MLSTM_HEADS, MLSTM_HEAD_DIM)
    q = jnp.einsum("bshd,hde->bhse", u, wq_head)
    k = jnp.einsum("bshd,hde->bhse", u, wk_head) * (MLSTM_HEAD_DIM ** -0.5)
    vh = v.reshape(b_, s_, MLSTM_HEADS, MLSTM_HEAD_DIM).transpose(0, 2, 1, 3)
    log_i = (i_pre + b_i).astype(jnp.float32).transpose(0, 2, 1)
    log_f = jax.nn.log_sigmoid((f_pre + b_f).astype(jnp.float32)).transpose(0, 2, 1)
    h_tilde = mlstm_chunkwise(q, k, vh, log_i, log_f)
    h_tilde = h_tilde.transpose(0, 2, 1, 3).astype(h.dtype)
    og = jax.nn.sigmoid(o).reshape(b_, s_, MLSTM_HEADS, MLSTM_HEAD_DIM)
    hc = og * h_tilde
    hc = rms_norm(hc, hnorm_g.reshape(MLSTM_HEADS, MLSTM_HEAD_DIM))
    return hc.reshape(b_, s_, MLSTM_WIDTH) @ w_out


def moe_swiglu(h, router, e_gate, e_up, e_down):
    logits = (h @ router).astype(jnp.float32)
    top_vals, top_idx = lax.top_k(logits, TOP_K)
    gates = jax.nn.softmax(top_vals, axis=-1)
    combine = jnp.sum(jax.nn.one_hot(top_idx, N_EXPERTS, dtype=jnp.float32) * gates[..., None],
                      axis=-2).astype(h.dtype)
    y = jnp.zeros_like(h)
    for e in range(N_EXPERTS):
        y = y + combine[..., e:e + 1] * swiglu(h, e_gate[e], e_up[e], e_down[e])
    return y


def setup_inputs(seed: int = 0) -> dict:
    key = jax.random.key(seed)
    ks = iter(jax.random.split(key, 32))

    def nrm(shape, scale):
        return jax.random.normal(next(ks), shape, jnp.float32) * scale

    def gain(n):
        return 1.0 + nrm((n,), 0.02)

    D = D_MODEL
    return {
        "x": nrm((BATCH, SEQ, D), 1.0),
        "l0_norm1_g": gain(D),
        "l0_w_in": nrm((D, IN0_WIDTH), D ** -0.5),
        "l0_b_f": 2.0 + nrm((FOX_HEADS,), 0.5),
        "l0_dw_w": nrm((CONV_WIDTH, CONV_CHANNELS), CONV_WIDTH ** -0.5),
        "l0_dw_b": nrm((CONV_CHANNELS,), 0.02),
        "l0_cln_g": gain(CONV_CHANNELS),
        "l0_cln_b": nrm((CONV_CHANNELS,), 0.02),
        "l0_w_out": nrm((FOX_WIDTH + CONV_CHANNELS, D), (FOX_WIDTH + CONV_CHANNELS) ** -0.5),
        "l0_norm2_g": gain(D),
        "l0_w_gate": nrm((D, D_FF), D ** -0.5),
        "l0_w_up": nrm((D, D_FF), D ** -0.5),
        "l0_w_down": nrm((D_FF, D), D_FF ** -0.5),
        "l1_norm1_g": gain(D),
        "l1_w_in": nrm((D, IN1_WIDTH), D ** -0.5),
        "l1_b_i": nrm((MLSTM_HEADS,), 0.1),
        "l1_b_f": 3.0 + nrm((MLSTM_HEADS,), 0.5),
        "l1_conv_w": nrm((MLSTM_CONV_WIDTH, MLSTM_WIDTH), MLSTM_CONV_WIDTH ** -0.5),
        "l1_conv_b": nrm((MLSTM_WIDTH,), 0.02),
        "l1_wq_head": nrm((MLSTM_HEADS, MLSTM_HEAD_DIM, MLSTM_HEAD_DIM), MLSTM_HEAD_DIM ** -0.5),
        "l1_wk_head": nrm((MLSTM_HEADS, MLSTM_HEAD_DIM, MLSTM_HEAD_DIM), MLSTM_HEAD_DIM ** -0.5),
        "l1_hnorm_g": gain(MLSTM_WIDTH),
        "l1_w_out": nrm((MLSTM_WIDTH, D), MLSTM_WIDTH ** -0.5),
        "l1_norm2_g": gain(D),
        "l1_router": nrm((D, N_EXPERTS), D ** -0.5),
        "l1_e_gate": nrm((N_EXPERTS, D, D_FF_EXPERT), D ** -0.5),
        "l1_e_up": nrm((N_EXPERTS, D, D_FF_EXPERT), D ** -0.5),
        "l1_e_down": nrm((N_EXPERTS, D_FF_EXPERT, D), D_FF_EXPERT ** -0.5),
        "final_norm_g": gain(D),
    }


def reference(x, l0_norm1_g, l0_w_in, l0_b_f, l0_dw_w, l0_dw_b, l0_cln_g, l0_cln_b, l0_w_out,
              l0_norm2_g, l0_w_gate, l0_w_up, l0_w_down,
              l1_norm1_g, l1_w_in, l1_b_i, l1_b_f, l1_conv_w, l1_conv_b, l1_wq_head, l1_wk_head,
              l1_hnorm_g, l1_w_out, l1_norm2_g, l1_router, l1_e_gate, l1_e_up, l1_e_down,
              final_norm_g):
    for layer in range(DEPTH):
        if layer % 2 == 0:
            x = x + even_mixer(rms_norm(x, l0_norm1_g), l0_w_in, l0_b_f, l0_dw_w, l0_dw_b,
                               l0_cln_g, l0_cln_b, l0_w_out)
            x = x + swiglu(rms_norm(x, l0_norm2_g), l0_w_gate, l0_w_up, l0_w_down)
        else:
            x = x + odd_mixer(rms_norm(x, l1_norm1_g), l1_w_in, l1_b_i, l1_b_f, l1_conv_w,
                              l1_conv_b, l1_wq_head, l1_wk_head, l1_hnorm_g, l1_w_out)
            x = x + moe_swiglu(rms_norm(x, l1_norm2_g), l1_router, l1_e_gate, l1_e_up, l1_e_down)
    return rms_norm(x, final_norm_g)
```

```cpp
#include <hip/hip_runtime.h>
#include <cstdio>
#include <cstdint>
#include <cmath>
#ifndef MK_ONE_LAUNCH
#define MK_ONE_LAUNCH 0
#endif
namespace pg8 {
#define PG8_LAS __attribute__((address_space(3)))
typedef unsigned short bf16_t;
typedef short bf16x8 __attribute__((ext_vector_type(8)));
typedef float f32x4 __attribute__((ext_vector_type(4)));
typedef unsigned u32x4 __attribute__((ext_vector_type(4)));
constexpr int BM = 256, BK = 64, HALF = 128, HTB = HALF * BK * 2  , STAGE_BYTES = 8 * HTB, NXCD = 8, WGM = 8;

__host__ __device__ __forceinline__ int lds_byte(int r, int c) { const int st = (r >> 4) * 2 + (c >> 5), rr = r & 15, cc = c & 31, ob = rr * 64 + cc * 2; return st * 1024 + (ob ^ (((ob >> 9) & 1) << 5)); }
__host__ __device__ __forceinline__ void stage_rc(int b, int& R, int& C) { const int st = b / 1024, sb = b % 1024, swz = sb ^ (((sb >> 9) & 1) << 5); R = (st >> 1) * 16 + swz / 64; C = (st & 1) * 32 + (swz % 64) / 2; }
__host__ __device__ __forceinline__ int perm32(int rho) { const int n = rho >> 4, i = rho & 15; return 8 * (i >> 2) + 4 * n + (i & 3); }

struct Unit { int pm, pn, pb; };
struct Gemm { const bf16_t* A; const bf16_t* Bt; int M, N, K; };

struct StaticOrder {
    int nM, nN, nwg, G, c;
    __host__ __device__ void init(int M, int N, int G_, int c_) { nM = M / BM; nN = N / BM; nwg = nM * nN; G = G_; c = c_; }
    __host__ __device__ bool next(int i, Unit& u) const {
        const long L = (long)i * G + c; if (L >= nwg) return false;
        int wgid = (int)L; { const int q = nwg / NXCD, r = nwg % NXCD, xcd = wgid % NXCD, off = wgid / NXCD; wgid = (xcd < r ? xcd * (q + 1) : r * (q + 1) + (xcd - r) * q) + off; }
        const int nig = WGM * nN, gid = wgid / nig, fm = gid * WGM, gsz = (nM - fm) < WGM ? (nM - fm) : WGM;
        u.pm = fm + ((wgid % nig) % gsz); u.pn = (wgid % nig) / gsz; u.pb = u.pn; return true;
    }
    __device__ __forceinline__ void a_ready(const Unit&) const {}
    __device__ __forceinline__ void done(const Unit&) const {}
};

__device__ __forceinline__ unsigned cvt_pk_bf16(float lo, float hi) { unsigned r; asm volatile("v_cvt_pk_bf16_f32 %0, %1, %2" : "=v"(r) : "v"(lo), "v"(hi)); return r; }
typedef float f32x2 __attribute__((ext_vector_type(2)));
__device__ __forceinline__ f32x2 gelu_pk(f32x2 v) {
    const f32x2 av = __builtin_elementwise_abs(v), d = av * 0.2316418882f + 1.0f;
    f32x2 t; t.x = __builtin_amdgcn_rcpf(d.x); t.y = __builtin_amdgcn_rcpf(d.y);
    f32x2 q = t * 0.5307027145f + (-0.7265760135f); q = q * t + 0.7107068705f; q = q * t + (-0.142248368f); q = q * t + 0.127414796f; q = q * t;
    const f32x2 s = (v * v) * (-0.72134752044f);
    f32x2 e; e.x = __builtin_amdgcn_exp2f(s.x); e.y = __builtin_amdgcn_exp2f(s.y);
    const f32x2 m = v * (q * e), r = v - m;
    f32x2 o; o.x = v.x < 0.f ? m.x : r.x; o.y = v.y < 0.f ? m.y : r.y; return o;
}

template <int ACT  > struct EpiBf16 {
    static constexpr bool PERM = true, AFTER_DRAIN = false; static_assert(ACT == 0 || ACT == 1, "EpiBf16: ACT is 0 (none) or 1 (gelu_pk)");
    bf16_t* O; int ldc; const float* bias; int split_cols; size_t split_stride; float scale0;
    __device__ __forceinline__ void operator()(const f32x4 (&acc)[2][2][4][2], const Unit& u, int wr, int wc, int fr, int fq) const {
        const int row0 = u.pm * BM + wr * 64 + fr; int colt = u.pn * BM; bf16_t* base = O;
        float sc = 1.f; if (split_cols) { const int t = colt / split_cols; base += (size_t)t * split_stride; colt -= t * split_cols; if (t == 0) sc = scale0; }
        const int col0 = colt + wc * 32 + 8 * fq, bcol0 = u.pn * BM + wc * 32 + 8 * fq;
        f32x4 bv[2][2];
#pragma unroll
        for (int bj = 0; bj < 2; ++bj)
#pragma unroll
            for (int n = 0; n < 2; ++n) bv[bj][n] = bias ? *(const f32x4*)(bias + bcol0 + bj * HALF + 4 * n) : (f32x4){0.f, 0.f, 0.f, 0.f};
#pragma unroll
        for (int ai = 0; ai < 2; ++ai)
#pragma unroll
            for (int m = 0; m < 4; ++m) { bf16_t* rowp = base + (size_t)(row0 + ai * HALF + m * 16) * ldc + col0;
#pragma unroll
                for (int bj = 0; bj < 2; ++bj) { f32x4 v0 = acc[ai][bj][m][0] + bv[bj][0], v1 = acc[ai][bj][m][1] + bv[bj][1];
                    if (ACT == 1) { f32x2 a = gelu_pk((f32x2){v0[0], v0[1]}), b = gelu_pk((f32x2){v0[2], v0[3]}), c = gelu_pk((f32x2){v1[0], v1[1]}), d = gelu_pk((f32x2){v1[2], v1[3]});
                        v0 = (f32x4){a.x, a.y, b.x, b.y}; v1 = (f32x4){c.x, c.y, d.x, d.y}; }
                    v0 = v0 * sc; v1 = v1 * sc; u32x4 w; w.x = cvt_pk_bf16(v0[0], v0[1]); w.y = cvt_pk_bf16(v0[2], v0[3]); w.z = cvt_pk_bf16(v1[0], v1[1]); w.w = cvt_pk_bf16(v1[2], v1[3]);
                    *(u32x4*)(rowp + bj * HALF) = w; } }
    }
};
__device__ __forceinline__ float silu_f(float g) { return g * __builtin_amdgcn_rcpf(1.0f + __builtin_amdgcn_exp2f(-1.4426950408889634f * g)); }
struct EpiRes {
    static constexpr bool PERM = false, AFTER_DRAIN = false;
    const float* base; float* out; int ldc;
    __device__ __forceinline__ void operator()(const f32x4 (&acc)[2][2][4][2], const Unit& u, int wr, int wc, int fr, int fq) const {
        const int row0 = u.pm * BM + wr * 64 + fr, col0 = u.pn * BM + wc * 32 + 4 * fq;
#pragma unroll
        for (int ai = 0; ai < 2; ++ai)
#pragma unroll
            for (int m = 0; m < 4; ++m) { const size_t off = (size_t)(row0 + ai * HALF + m * 16) * ldc + col0;
#pragma unroll
                for (int bj = 0; bj < 2; ++bj)
#pragma unroll
                    for (int n = 0; n < 2; ++n) { const f32x4 b = *(const f32x4*)(base + off + bj * HALF + n * 16); *(f32x4*)(out + off + bj * HALF + n * 16) = b + acc[ai][bj][m][n]; } }
    }
};
struct EpiSwiGLU {
    static constexpr bool PERM = true, AFTER_DRAIN = false;
    bf16_t* O; int ldo;
    __device__ __forceinline__ void operator()(const f32x4 (&acc)[2][2][4][2], const Unit& u, int wr, int wc, int fr, int fq) const {
        const int row0 = u.pm * BM + wr * 64 + fr, col0 = u.pn * HALF + wc * 32 + 8 * fq;
#pragma unroll
        for (int ai = 0; ai < 2; ++ai)
#pragma unroll
            for (int m = 0; m < 4; ++m) { bf16_t* rowp = O + (size_t)(row0 + ai * HALF + m * 16) * ldo + col0;
                const f32x4 g0 = acc[ai][0][m][0], g1 = acc[ai][0][m][1], u0 = acc[ai][1][m][0], u1 = acc[ai][1][m][1];
                u32x4 w; w.x = cvt_pk_bf16(silu_f(g0[0]) * u0[0], silu_f(g0[1]) * u0[1]); w.y = cvt_pk_bf16(silu_f(g0[2]) * u0[2], silu_f(g0[3]) * u0[3]);
                w.z = cvt_pk_bf16(silu_f(g1[0]) * u1[0], silu_f(g1[1]) * u1[1]); w.w = cvt_pk_bf16(silu_f(g1[2]) * u1[2], silu_f(g1[3]) * u1[3]);
                *(u32x4*)rowp = w; }
    }
};
struct EpiRowScale {
    static constexpr bool PERM = false, AFTER_DRAIN = false;
    float* Y; int ldc; const float* rs;
    __device__ __forceinline__ void operator()(const f32x4 (&acc)[2][2][4][2], const Unit& u, int wr, int wc, int fr, int fq) const {
        const int row0 = u.pm * BM + wr * 64 + fr, col0 = u.pn * BM + wc * 32 + 4 * fq;
#pragma unroll
        for (int ai = 0; ai < 2; ++ai)
#pragma unroll
            for (int m = 0; m < 4; ++m) { const int row = row0 + ai * HALF + m * 16; const float s = rs[row]; float* rowp = Y + (size_t)row * ldc + col0;
#pragma unroll
                for (int bj = 0; bj < 2; ++bj)
#pragma unroll
                    for (int n = 0; n < 2; ++n) *(f32x4*)(rowp + bj * HALF + n * 16) = acc[ai][bj][m][n] * s; }
    }
};
struct MoeOrder {
    int nM, nN, nwg, G, c; int ct[9];
    __device__ void init(const int* meta, int nN_, int G_, int c_) { for (int e = 0; e < 9; ++e) ct[e] = meta[e]; nM = ct[8]; nN = nN_; nwg = nM * nN; G = G_; c = c_; }
    __device__ bool next(int i, Unit& u) const {
        const long L = (long)i * G + c; if (L >= nwg) return false;
        int wgid = (int)L; { const int q = nwg / NXCD, r = nwg % NXCD, xcd = wgid % NXCD, off = wgid / NXCD; wgid = (xcd < r ? xcd * (q + 1) : r * (q + 1) + (xcd - r) * q) + off; }
        const int nig = WGM * nN, gid = wgid / nig, fm = gid * WGM, gsz = (nM - fm) < WGM ? (nM - fm) : WGM;
        u.pm = fm + ((wgid % nig) % gsz); u.pn = (wgid % nig) / gsz;
        int e = 0;
#pragma unroll
        for (int k = 1; k < 8; ++k) e += (u.pm >= ct[k]) ? 1 : 0;
        u.pb = e * nN + u.pn; return true;
    }
    __device__ __forceinline__ void a_ready(const Unit&) const {}
    __device__ __forceinline__ void done(const Unit&) const {}
};
template <class Epi, class Sched, bool ALIGN_EPI = false, bool SP2 = false>
__device__ __forceinline__ void gemm_phase(PG8_LAS unsigned char* lds, const Gemm g, const Sched& S, const Epi& E) {
    const int tid = threadIdx.x, wid = __builtin_amdgcn_readfirstlane(tid >> 6), lane = tid & 63, wr = wid >> 2, wc = wid & 3, fr = lane & 15, fq = lane >> 4;
    const int K = g.K, nt = K / BK;
    unsigned voffA[2], voffB[2];
#pragma unroll
    for (int i = 0; i < 2; ++i) { int R, C; stage_rc(tid * 16 + i * 8192, R, C); const int Rb = Epi::PERM ? ((R & ~31) + perm32(R & 31)) : R;
        voffA[i] = (unsigned)(R * K + C) * 2u; voffB[i] = (unsigned)(Rb * K + C) * 2u; }
    const size_t kstep = (size_t)(BK * 2);
    const size_t hstep = (size_t)HALF * K * 2;
    const size_t tstep = 2 * hstep;
    const unsigned ldsw = (unsigned)wid * 1024u;
    const int aoff = lds_byte(wr * 64 + fr, fq * 8), boff = lds_byte(wc * 32 + fr, fq * 8);
#define PG8_SA(b, h) (((b) * 2 + (h)) * HTB)
#define PG8_SB(b, h) ((4 + (b) * 2 + (h)) * HTB)
#define PG8_STAGE(bufoff, gbase, voff) do { _Pragma("unroll") for (int _i = 0; _i < 2; ++_i) \
        __builtin_amdgcn_global_load_lds((const unsigned*)((const char*)(gbase) + (voff)[_i]), (PG8_LAS unsigned*)(lds + (bufoff) + ldsw + _i * 8192), 16, 0, 0); } while (0)
#define PG8_LDA(dst, b, h) do { _Pragma("unroll") for (int m = 0; m < 4; ++m) _Pragma("unroll") for (int k = 0; k < 2; ++k) dst[m][k] = *(const PG8_LAS bf16x8*)(lds + PG8_SA(b, h) + aoff + m * 2048 + k * 1024); } while (0)
#define PG8_LDB(dst, b, h) do { _Pragma("unroll") for (int n = 0; n < 2; ++n) _Pragma("unroll") for (int k = 0; k < 2; ++k) dst[n][k] = *(const PG8_LAS bf16x8*)(lds + PG8_SB(b, h) + boff + n * 2048 + k * 1024); } while (0)
#define PG8_MMA(ai, bj, At, Bt) do { __builtin_amdgcn_s_setprio(1); _Pragma("unroll") for (int m = 0; m < 4; ++m) _Pragma("unroll") for (int n = 0; n < 2; ++n) _Pragma("unroll") for (int k = 0; k < 2; ++k) \
        acc[ai][bj][m][n] = __builtin_amdgcn_mfma_f32_16x16x32_bf16(Bt[n][k], At[m][k], acc[ai][bj][m][n], 0, 0, 0); __builtin_amdgcn_s_setprio(0); } while (0)
#define PG8_WAIT_V(n) asm volatile("s_waitcnt vmcnt(" #n ")" ::: "memory")
#define PG8_WAIT_L(n) asm volatile("s_waitcnt lgkmcnt(" #n ")" ::: "memory")
#define PG8_BAR __builtin_amdgcn_s_barrier()
#define PG8_SCHED __builtin_amdgcn_sched_barrier(0)
    Unit cur, nxt; int ui = 0;
    if (!S.next(0, cur)) return;
    f32x4 acc[2][2][4][2];
#pragma unroll
    for (int a = 0; a < 2; ++a)
#pragma unroll
        for (int b = 0; b < 2; ++b)
#pragma unroll
            for (int m = 0; m < 4; ++m)
#pragma unroll
                for (int n = 0; n < 2; ++n) acc[a][b][m][n] = (f32x4){0.f, 0.f, 0.f, 0.f};
    bf16x8 At[4][2], B0[2][2], B1[2][2];
    const char* cA = (const char*)g.A + (size_t)cur.pm * tstep; const char* cB = (const char*)g.Bt + (size_t)cur.pb * tstep;
    S.a_ready(cur);
    if constexpr (SP2) {
        PG8_STAGE(PG8_SB(0, 0), cB, voffB); PG8_STAGE(PG8_SB(0, 1), cB + hstep, voffB); PG8_STAGE(PG8_SA(0, 0), cA, voffA); PG8_STAGE(PG8_SA(0, 1), cA + hstep, voffA);
        if (wr == 1) PG8_BAR;
        PG8_WAIT_V(2); PG8_BAR;
        PG8_STAGE(PG8_SB(1, 0), cB + kstep, voffB); PG8_STAGE(PG8_SA(1, 0), cA + kstep, voffA); PG8_STAGE(PG8_SB(1, 1), cB + hstep + kstep, voffB);
        PG8_WAIT_V(6); PG8_BAR;
    } else {
        PG8_STAGE(PG8_SB(0, 0), cB, voffB); PG8_STAGE(PG8_SA(0, 0), cA, voffA); PG8_STAGE(PG8_SB(0, 1), cB + hstep, voffB); PG8_STAGE(PG8_SA(0, 1), cA + hstep, voffA);
        if (wr == 1) PG8_BAR;
        PG8_WAIT_V(4); PG8_BAR;
        PG8_STAGE(PG8_SB(1, 0), cB + kstep, voffB); PG8_STAGE(PG8_SA(1, 0), cA + kstep, voffA); PG8_STAGE(PG8_SB(1, 1), cB + hstep + kstep, voffB);
        PG8_WAIT_V(6); PG8_BAR;
    }
    for (;;) {
        const bool has_next = S.next(ui + 1, nxt);
        const char* nA = has_next ? (const char*)g.A + (size_t)nxt.pm * tstep : cA; const char* nB = has_next ? (const char*)g.Bt + (size_t)nxt.pb * tstep : cB;
        for (int t = 0; t < nt; t += 2) {
            const bool last = (t == nt - 2);
            const char* a1 = cA + (size_t)(t + 1) * kstep;
            const char* a2 = last ? nA : cA + (size_t)(t + 2) * kstep; const char* b2 = last ? nB : cB + (size_t)(t + 2) * kstep;
            const char* a3 = a2 + kstep; const char* b3 = b2 + kstep;
            if (last && has_next) S.a_ready(nxt);
            if constexpr (SP2) {
            PG8_LDB(B0, 0, 0); PG8_LDB(B1, 0, 1); PG8_SCHED; PG8_LDA(At, 0, 0); PG8_STAGE(PG8_SA(1, 1), a1 + hstep, voffA);
            PG8_WAIT_V(8); PG8_WAIT_L(0); PG8_BAR; PG8_MMA(0, 0, At, B0); PG8_MMA(0, 1, At, B1); PG8_BAR; PG8_SCHED;
            PG8_LDA(At, 0, 1); PG8_STAGE(PG8_SB(0, 0), b2, voffB); PG8_STAGE(PG8_SB(0, 1), b2 + hstep, voffB); PG8_STAGE(PG8_SA(0, 0), a2, voffA);
            PG8_WAIT_V(8); PG8_WAIT_L(0); PG8_BAR; PG8_MMA(1, 0, At, B0); PG8_MMA(1, 1, At, B1); PG8_BAR; PG8_SCHED;
            PG8_LDB(B0, 1, 0); PG8_LDB(B1, 1, 1); PG8_SCHED; PG8_LDA(At, 1, 0); PG8_STAGE(PG8_SA(0, 1), a2 + hstep, voffA);
            PG8_WAIT_V(8); PG8_WAIT_L(0); PG8_BAR; PG8_MMA(0, 0, At, B0); PG8_MMA(0, 1, At, B1); PG8_BAR; PG8_SCHED;
            PG8_LDA(At, 1, 1); PG8_STAGE(PG8_SB(1, 0), b3, voffB); PG8_STAGE(PG8_SB(1, 1), b3 + hstep, voffB); PG8_STAGE(PG8_SA(1, 0), a3, voffA);
            PG8_WAIT_V(8); PG8_WAIT_L(0); PG8_BAR; PG8_MMA(1, 0, At, B0); PG8_MMA(1, 1, At, B1); PG8_BAR; PG8_SCHED;
            } else {
            PG8_LDB(B0, 0, 0); PG8_SCHED; PG8_LDA(At, 0, 0); PG8_STAGE(PG8_SA(1, 1), a1 + hstep, voffA);
            PG8_WAIT_L(8); PG8_BAR; PG8_WAIT_L(0); PG8_MMA(0, 0, At, B0); PG8_BAR; PG8_SCHED;
            PG8_LDB(B1, 0, 1); PG8_STAGE(PG8_SB(0, 0), b2, voffB);
            PG8_BAR; PG8_WAIT_L(0); PG8_MMA(0, 1, At, B1); PG8_BAR;
            PG8_LDA(At, 0, 1); PG8_STAGE(PG8_SA(0, 0), a2, voffA);
            PG8_BAR; PG8_WAIT_L(0); PG8_MMA(1, 0, At, B0); PG8_BAR; PG8_SCHED;
            PG8_STAGE(PG8_SB(0, 1), b2 + hstep, voffB);
            PG8_WAIT_V(6); PG8_BAR; PG8_MMA(1, 1, At, B1); PG8_BAR;
            PG8_LDB(B0, 1, 0); PG8_SCHED; PG8_LDA(At, 1, 0); PG8_STAGE(PG8_SA(0, 1), a2 + hstep, voffA);
            PG8_WAIT_L(8); PG8_BAR; PG8_WAIT_L(0); PG8_MMA(0, 0, At, B0); PG8_BAR; PG8_SCHED;
            PG8_LDB(B1, 1, 1); PG8_STAGE(PG8_SB(1, 0), b3, voffB);
            PG8_BAR; PG8_WAIT_L(0); PG8_MMA(0, 1, At, B1); PG8_BAR;
            PG8_LDA(At, 1, 1); PG8_STAGE(PG8_SA(1, 0), a3, voffA);
            PG8_BAR; PG8_WAIT_L(0); PG8_MMA(1, 0, At, B0); PG8_BAR; PG8_SCHED;
            PG8_STAGE(PG8_SB(1, 1), b3 + hstep, voffB);
            PG8_WAIT_V(6); PG8_BAR; PG8_MMA(1, 1, At, B1); PG8_BAR;
            }
        }
        if constexpr (ALIGN_EPI) { if (wr == 0) PG8_BAR; }
        if constexpr (!Epi::AFTER_DRAIN) { E(acc, cur, wr, wc, fr, fq); S.done(cur); }
        if (!has_next) break;
#pragma unroll
        for (int a = 0; a < 2; ++a)
#pragma unroll
            for (int b = 0; b < 2; ++b)
#pragma unroll
                for (int m = 0; m < 4; ++m)
#pragma unroll
                    for (int n = 0; n < 2; ++n) acc[a][b][m][n] = (f32x4){0.f, 0.f, 0.f, 0.f};
        cur = nxt; cA = nA; cB = nB; ++ui;
        if constexpr (ALIGN_EPI) { if (wr == 1) PG8_BAR; }
    }
    PG8_WAIT_V(0);
    if constexpr (!ALIGN_EPI) { if (wr == 0) PG8_BAR; }
    PG8_BAR;
    if constexpr (Epi::AFTER_DRAIN) { E.fused(acc, cur, wr, wc, fr, fq, lds, wid, lane); S.done(cur); }
#undef PG8_SA
#undef PG8_SB
#undef PG8_STAGE
#undef PG8_LDA
#undef PG8_LDB
#undef PG8_MMA
#undef PG8_WAIT_V
#undef PG8_WAIT_L
#undef PG8_BAR
#undef PG8_SCHED
}
}
#include <hip/hip_bf16.h>
#include <cmath>
namespace attn_body {
using bf16=__hip_bfloat16;
using bf16x8=__attribute__((ext_vector_type(8)))short;
using s16x4=__attribute__((ext_vector_type(4)))short;
using f32x16=__attribute__((ext_vector_type(16)))float;
using u32x4=__attribute__((ext_vector_type(4)))unsigned;
constexpr int BATCH=2,NHEAD=8,SEQ=8192,D=64,DM=2560,OPITCH=1024;
constexpr int NW=8,QBLK=32,QB=QBLK*NW,KVBLK=64,NQB=SEQ/QB;
constexpr int ATTN_PITCH=DM, ATTN_UNIT_ROWS=QB;
__device__ __forceinline__ int crow(int r,int hi){return (r&3)+8*(r>>2)+4*hi;}
#define SBAR() __builtin_amdgcn_sched_barrier(0)
__device__ __forceinline__ void cmask(f32x16&p0,f32x16&p1,int jb,int qrel,int hi){
  const float NEG=-INFINITY; int kb=64*jb+4*hi;
  #pragma unroll
  for(int r=0;r<16;++r){int kv=kb+(r&3)+8*(r>>2); if(kv>qrel)p0[r]=NEG; if(kv+32>qrel)p1[r]=NEG;}
}

constexpr int NSLOT=3, SLOTB=8192;
constexpr int LDS_K=0, LDS_V=NSLOT*SLOTB, LDS_WS=2*NSLOT*SLOTB, LDS_OST=LDS_WS+NW*64*4, LDS_BIAS=LDS_OST+NW*4096, LDS_PRE=LDS_BIAS+SEQ*4, LDS_BYTES=LDS_PRE+512;
constexpr float C2=0.125f*1.4426950408889634f;
__device__ __forceinline__ void glds16(const void*gsrc,unsigned lds_dst){unsigned keep;
  asm volatile("s_mov_b32 %0, m0\n\ts_mov_b32 m0, %2\n\ts_nop 0\n\tglobal_load_lds_dwordx4 %1, off\n\ts_mov_b32 m0, %0":"=&s"(keep):"v"(gsrc),"s"(lds_dst):"memory");}
__device__ __forceinline__ float max3f(float a,float b,float c){float r;asm("v_max3_f32 %0, %1, %2, %3":"=v"(r):"v"(a),"v"(b),"v"(c));return r;}
__device__ __forceinline__ float max2f(float a,float b){float r;asm("v_max_f32_e32 %0, %1, %2":"=v"(r):"v"(a),"v"(b));return r;}
__device__ __forceinline__ float fadd_s(float a,float b){float r;asm("v_add_f32_e32 %0, %1, %2":"=v"(r):"v"(a),"v"(b));return r;}
__device__ __forceinline__ float fsub_s(float a,float b){float r;asm("v_sub_f32_e32 %0, %1, %2":"=v"(r):"v"(a),"v"(b));return r;}
typedef float f32x2_t __attribute__((ext_vector_type(2))); typedef __bf16 bf16x2_t __attribute__((ext_vector_type(2)));
__device__ __forceinline__ unsigned cvtpk_s(float lo,float hi){f32x2_t v={lo,hi};bf16x2_t b=__builtin_convertvector(v,bf16x2_t);return __builtin_bit_cast(unsigned,b);}
#define WAIT_BAR(N) asm volatile("s_waitcnt vmcnt(" #N ") lgkmcnt(0)\n\ts_barrier":::"memory")

__device__ __forceinline__ void qkt(f32x16&p0,f32x16&p1,const char*Kslot,const bf16x8*qr,int r32,int hi){
  const char*kb=Kslot+hi*1024+r32*16;
  #pragma unroll
  for(int d0=0;d0<4;++d0){
    const bf16x8 b0=*reinterpret_cast<const bf16x8*>(kb+d0*2048);
    const bf16x8 b1=*reinterpret_cast<const bf16x8*>(kb+d0*2048+512);
    p0=__builtin_amdgcn_mfma_f32_32x32x16_bf16(b0,qr[d0],p0,0,0,0);p1=__builtin_amdgcn_mfma_f32_32x32x16_bf16(b1,qr[d0],p1,0,0,0);}
}
typedef __attribute__((address_space(3))) const char* lds_cptr;
typedef short v4i16_t __attribute__((ext_vector_type(4)));
__device__ __forceinline__ void kload8(bf16x8*kf,lds_cptr kp){
  kf[0]=*(const __attribute__((address_space(3))) bf16x8*)(kp);      kf[1]=*(const __attribute__((address_space(3))) bf16x8*)(kp+512);
  kf[2]=*(const __attribute__((address_space(3))) bf16x8*)(kp+2048); kf[3]=*(const __attribute__((address_space(3))) bf16x8*)(kp+2560);
  kf[4]=*(const __attribute__((address_space(3))) bf16x8*)(kp+4096); kf[5]=*(const __attribute__((address_space(3))) bf16x8*)(kp+4608);
  kf[6]=*(const __attribute__((address_space(3))) bf16x8*)(kp+6144); kf[7]=*(const __attribute__((address_space(3))) bf16x8*)(kp+6656);
}
__device__ __forceinline__ void kload2(bf16x8*kf,lds_cptr kp,int j){ kf[2*j]=*(const __attribute__((address_space(3))) bf16x8*)(kp+j*2048); kf[2*j+1]=*(const __attribute__((address_space(3))) bf16x8*)(kp+j*2048+512); }
__device__ __forceinline__ s16x4 vtr(lds_cptr p){ return __builtin_bit_cast(s16x4,__builtin_amdgcn_ds_read_tr16_b64_v4i16((__attribute__((address_space(3))) v4i16_t*)p)); }
__device__ __forceinline__ float rowmax(const f32x16&p0,const f32x16&p1){
  float a=max3f(p0[0],p0[1],p1[0]),b=max3f(p0[2],p0[3],p1[1]);a=max3f(a,p1[2],p1[3]);
  #pragma unroll
  for(int r=4;r<16;r+=4){a=max3f(a,p0[r],p0[r+1]);b=max3f(b,p0[r+2],p0[r+3]);a=max3f(a,p1[r],p1[r+1]);b=max3f(b,p1[r+2],p1[r+3]);}
  const float m=max2f(a,b);
  auto rr=__builtin_amdgcn_permlane32_swap(__float_as_uint(m),__float_as_uint(m),false,false);
  return max2f(__uint_as_float(rr[0]),__uint_as_float(rr[1]));
}
__device__ __forceinline__ void pv(f32x16*o,int vb,bf16x8 pa0,bf16x8 pa1,bf16x8 pa2,bf16x8 pa3){
  #pragma unroll
  for(int d0=0;d0<2;++d0){s16x4 lo[4],hi[4];
    #pragma unroll
    for(int ks=0;ks<4;++ks){
      asm volatile("ds_read_b64_tr_b16 %0,%1 offset:%c2":"=&v"(lo[ks]):"v"(vb),"i"(d0*4096+ks*1024):"memory");
      asm volatile("ds_read_b64_tr_b16 %0,%1 offset:%c2":"=&v"(hi[ks]):"v"(vb),"i"(d0*4096+ks*1024+512):"memory");}
    asm volatile("s_waitcnt lgkmcnt(0)":::"memory");SBAR();
    #define PK(k) (bf16x8){lo[k][0],lo[k][1],lo[k][2],lo[k][3],hi[k][0],hi[k][1],hi[k][2],hi[k][3]}
    o[d0]=__builtin_amdgcn_mfma_f32_32x32x16_bf16(pa0,PK(0),o[d0],0,0,0);
    o[d0]=__builtin_amdgcn_mfma_f32_32x32x16_bf16(pa1,PK(1),o[d0],0,0,0);
    o[d0]=__builtin_amdgcn_mfma_f32_32x32x16_bf16(pa2,PK(2),o[d0],0,0,0);
    o[d0]=__builtin_amdgcn_mfma_f32_32x32x16_bf16(pa3,PK(3),o[d0],0,0,0);
    #undef PK
  }
}

#ifndef ATTN_STORE16
#define ATTN_STORE16(p,v) (*(u32x4*)(p)=(v))
#endif
typedef float f32x4b __attribute__((ext_vector_type(4)));
template<int THRL> __device__ __forceinline__ void attn_unit(int b,int h,int qb,const bf16*Q,const bf16*__restrict__ K,const bf16*__restrict__ V,bf16*O,const float*__restrict__ floc,const float*__restrict__ ftot,char*shm){
  const int tid=threadIdx.x,lane=tid&63,r32=lane&31,hi=lane>>5; const int wid=__builtin_amdgcn_readfirstlane(tid>>6);
  const long rowbase=(long)b*SEQ; const int q0=qb*QB;
  const bf16*Qw=Q+(rowbase+q0+wid*QBLK)*DM+h*D;
  const bf16*Kh=K+rowbase*DM+h*D,*Vh=V+rowbase*DM+h*D;
  const lds_cptr shm3=(lds_cptr)shm;
  const unsigned lds0=(unsigned)(uintptr_t)shm;
  float*wsf=(float*)(shm+LDS_WS)+wid*64;
  const bf16*ksrc=Kh+(long)lane*DM+wid*8;
  const bf16*vsrc=Vh+(long)(16*(wid&3)+(lane>>2))*DM+(wid>>2)*32+(lane&3)*8;
  const unsigned kdst=lds0+LDS_K+wid*1024, vdst=lds0+LDS_V+wid*1024;
  #define DMA_K(t,slot) glds16(ksrc+(long)(t)*KVBLK*DM,(unsigned)__builtin_amdgcn_readfirstlane(kdst+(slot)))
  #define DMA_V(t,slot) glds16(vsrc+(long)(t)*KVBLK*DM,(unsigned)__builtin_amdgcn_readfirstlane(vdst+(slot)))
  const int vb0=(int)(lds0+LDS_V)+((lane>>4)&1)*32+(lane&3)*8+(4*hi+((lane&15)>>2))*64;
  const char*Kbase=shm+LDS_K; bf16x8 kf[8];
  const lds_cptr kp0=shm3+LDS_K+hi*1024+r32*16; const lds_cptr vp0=shm3+LDS_V+((lane>>4)&1)*32+(lane&3)*8+(4*hi+((lane&15)>>2))*64;
  const int NT=(q0+QB)/KVBLK;
  typedef __attribute__((address_space(3))) float* lds_fptr;
  const lds_fptr prel=(lds_fptr)(shm3+LDS_PRE); const lds_fptr biasl=(lds_fptr)(shm3+LDS_BIAS);
  { const int nblk=4*(qb+1);
    if(wid==0){ float a0=(lane<nblk)?ftot[(b*128+lane)*8+h]:0.f, a1=(lane+64<nblk)?ftot[(b*128+64+lane)*8+h]:0.f; float s0=a0,s1=a1;
      #pragma unroll
      for(int o_=1;o_<64;o_<<=1){ const float t0_=__shfl_up(s0,o_),t1_=__shfl_up(s1,o_); if(lane>=o_){s0+=t0_;s1+=t1_;} }
      s1+=__shfl(s0,63); prel[lane]=s0-a0; prel[lane+64]=s1-a1; }
    asm volatile("s_waitcnt vmcnt(0) lgkmcnt(0)\n\ts_barrier":::"memory");
    const float cref=prel[4*qb];
    for(int s_=tid;s_<256*(qb+1);s_+=NW*64) biasl[s_]=(cref-(prel[s_>>6]+floc[(rowbase+s_)*8+h]))*1.4426950408889634f;
    asm volatile("s_waitcnt vmcnt(0) lgkmcnt(0)\n\ts_barrier":::"memory"); }
  #define BIASINIT(P0,P1,t) do{ const __attribute__((address_space(3))) f32x4b* bq_=(const __attribute__((address_space(3))) f32x4b*)(biasl+64*(t)+4*hi); \
    _Pragma("unroll") for(int g_=0;g_<4;++g_){ const f32x4b x0_=bq_[2*g_],x1_=bq_[8+2*g_]; \
      P0[4*g_]=x0_[0]-mhat;P0[4*g_+1]=x0_[1]-mhat;P0[4*g_+2]=x0_[2]-mhat;P0[4*g_+3]=x0_[3]-mhat; P1[4*g_]=x1_[0]-mhat;P1[4*g_+1]=x1_[1]-mhat;P1[4*g_+2]=x1_[2]-mhat;P1[4*g_+3]=x1_[3]-mhat; } }while(0)
  DMA_K(0,0);DMA_V(0,0);DMA_K(1,SLOTB);
  bf16x8 qr[4];
  #pragma unroll
  for(int d0=0;d0<4;++d0)qr[d0]=*reinterpret_cast<const bf16x8*>(&Qw[(long)r32*DM+d0*16+hi*8]);
  float mhat=0.f,l_reg=0.f;f32x16 o[2];o[0]=f32x16{};o[1]=f32x16{};
  const int qrel=wid*QBLK+r32;
  #define CMASK(P0,P1,t) do{int jb_=(t)-(NT-4); if(jb_>=0)cmask(P0,P1,jb_,qrel,hi);}while(0)
  bool resc=false;
  #define START(P0,P1) do{ const float rm=rowmax(P0,P1); resc=false; \
    { const float dl=rm; mhat=fadd_s(mhat,dl); \
      _Pragma("unroll") for(int r=0;r<16;++r){P0[r]=fsub_s(P0[r],dl);P1[r]=fsub_s(P1[r],dl);} } \
    _Pragma("unroll") for(int r=0;r<16;++r)P0[r]=__builtin_amdgcn_exp2f(P0[r]); }while(0)
  #define RESC() do{ if(resc){ asm volatile("s_waitcnt lgkmcnt(0)":::"memory"); \
      _Pragma("unroll") for(int d_=0;d_<2;++d_) _Pragma("unroll") for(int r=0;r<16;++r)o[d_][r]*=wsf[crow(r,hi)]; } }while(0)
  f32x16 pA0,pA1,pB0,pB1;
  int sl_prev=0,sl_cur=0,sl_next=SLOTB;
  #define ROT() do{sl_prev=sl_cur;sl_cur=sl_next;sl_next=(sl_next==(NSLOT-1)*SLOTB)?0:sl_next+SLOTB;}while(0)
  DMA_K(2,2*SLOTB);
  WAIT_BAR(3);
  BIASINIT(pA0,pA1,0);qkt(pA0,pA1,Kbase,qr,r32,hi);asm volatile("s_nop 15\n\ts_nop 7":"+v"(pA0),"+v"(pA1));CMASK(pA0,pA1,0);
  START(pA0,pA1);
  _Pragma("unroll") for(int r=0;r<16;++r)pA1[r]=__builtin_amdgcn_exp2f(pA1[r]);
  WAIT_BAR(0);
  DMA_K(3,0);DMA_V(1,SLOTB);
  ROT();
  kload8(kf,kp0+sl_cur);
  WAIT_BAR(2);
  s16x4 vlo[8],vhi[8]; u32x4 pw0,pw1,pw2,pw3;
  #define PKW(P,B) cvtpk_s(P[B],P[B+1])
  #define PAF(k) __builtin_bit_cast(bf16x8,pw##k)
  #define VFR(i) (bf16x8){vlo[i][0],vlo[i][1],vlo[i][2],vlo[i][3],vhi[i][0],vhi[i][1],vhi[i][2],vhi[i][3]}
  #define PIN(x) asm volatile("":"+v"(x))
  #define MX3(a,b,c) __builtin_fmaxf(__builtin_fmaxf((a),(b)),(c))
  #define GAPA(MF,A0,A1,A2,A3,W0,W1,PW) do{ MF; sacc+=A0; sacc+=A1; sacc+=A2; sacc+=A3; PIN(sacc); W0; W1; PIN(PW); SBAR(); }while(0)
  #define EX(v) __builtin_amdgcn_exp2f(v)
  #define GAPB(MF,X,B) do{ MF; X[B]=EX(X[B]); X[B+1]=EX(X[B+1]); X[B+2]=EX(X[B+2]); X[B+3]=EX(X[B+3]); PIN(X); SBAR(); }while(0)
  #define VRD(i) do{ vlo[i]=vtr(vp_+(((i)>>2)*4096+((i)&3)*1024)); vhi[i]=vtr(vp_+(((i)>>2)*4096+((i)&3)*1024+512)); }while(0)
  #define KRD(G,j) do{ if(G){ kload2(kf,kp0+sl_next,j); SBAR(); } }while(0)
  #define STEP(C0,C1,P0,P1,t,GK,GV,GL) do{ SBAR(); BIASINIT(C0,C1,t); SBAR(); \
    const lds_cptr vp_=vp0+sl_prev; \
    VRD(0); SBAR(); float sacc=(P0[0]+P0[1]); \
    GAPA(C0=__builtin_amdgcn_mfma_f32_32x32x16_bf16(kf[0],qr[0],C0,0,0,0), P0[2],P0[3],P0[4],P0[5],     pw0[0]=PKW(P0,0), pw0[1]=PKW(P0,2), pw0); \
    VRD(4); SBAR(); GAPA(C1=__builtin_amdgcn_mfma_f32_32x32x16_bf16(kf[1],qr[0],C1,0,0,0), P0[6],P0[7],P0[8],P0[9],     pw0[2]=PKW(P0,4), pw0[3]=PKW(P0,6), pw0); \
    VRD(1); SBAR(); GAPA(C0=__builtin_amdgcn_mfma_f32_32x32x16_bf16(kf[2],qr[1],C0,0,0,0),   P0[10],P0[11],P0[12],P0[13], pw1[0]=PKW(P0,8), pw1[1]=PKW(P0,10), pw1); \
    VRD(5); SBAR(); GAPA(C1=__builtin_amdgcn_mfma_f32_32x32x16_bf16(kf[3],qr[1],C1,0,0,0),   P0[14],P0[15],P1[0],P1[1],   pw1[2]=PKW(P0,12),pw1[3]=PKW(P0,14), pw1); \
    VRD(2); SBAR(); GAPA(C0=__builtin_amdgcn_mfma_f32_32x32x16_bf16(kf[4],qr[2],C0,0,0,0),   P1[2],P1[3],P1[4],P1[5],     pw2[0]=PKW(P1,0), pw2[1]=PKW(P1,2), pw2); \
    VRD(6); SBAR(); GAPA(C1=__builtin_amdgcn_mfma_f32_32x32x16_bf16(kf[5],qr[2],C1,0,0,0),   P1[6],P1[7],P1[8],P1[9],     pw2[2]=PKW(P1,4), pw2[3]=PKW(P1,6), pw2); \
    VRD(3); SBAR(); GAPA(C0=__builtin_amdgcn_mfma_f32_32x32x16_bf16(kf[6],qr[3],C0,0,0,0),   P1[10],P1[11],P1[12],P1[13], pw3[0]=PKW(P1,8), pw3[1]=PKW(P1,10), pw3); \
    VRD(7); SBAR(); GAPA(C1=__builtin_amdgcn_mfma_f32_32x32x16_bf16(kf[7],qr[3],C1,0,0,0),   P1[14],P1[15],0.f,0.f,       pw3[2]=PKW(P1,12),pw3[3]=PKW(P1,14), pw3); \
    l_reg+=sacc; \
    if(GK){DMA_K((t)+3,sl_cur);} if(GV){DMA_V((t)+1,sl_next);} \
    CMASK(C0,C1,t); \
    { float a=MX3(C0[0],C0[1],C1[0]),b=MX3(C0[2],C0[3],C1[1]); a=MX3(a,C1[2],C1[3]); \
      _Pragma("unroll") for(int r=4;r<16;r+=4){a=MX3(a,C0[r],C0[r+1]);b=MX3(b,C0[r+2],C0[r+3]);a=MX3(a,C1[r],C1[r+1]);b=MX3(b,C1[r+2],C1[r+3]);} \
      float rm=__builtin_fmaxf(a,b); { auto rr=__builtin_amdgcn_permlane32_swap(__float_as_uint(rm),__float_as_uint(rm),false,false); rm=__builtin_fmaxf(__uint_as_float(rr[0]),__uint_as_float(rr[1])); } \
      resc=false; \
      if(__builtin_expect(__any(rm>(float)THRL),0)){ const float dl=__builtin_fmaxf(rm,0.f); mhat+=dl; \
        _Pragma("unroll") for(int r=0;r<16;++r){C0[r]-=dl;C1[r]-=dl;} \
        const float f=__builtin_amdgcn_exp2f(-dl); l_reg*=f; if(hi==0)wsf[r32]=f; resc=true; } } \
    SBAR(); \
    GAPB(o[0]=__builtin_amdgcn_mfma_f32_32x32x16_bf16(PAF(0),VFR(0),o[0],0,0,0), C0,0); \
    GAPB(o[1]=__builtin_amdgcn_mfma_f32_32x32x16_bf16(PAF(0),VFR(4),o[1],0,0,0), C0,4); \
    KRD(GL,0); GAPB(o[0]=__builtin_amdgcn_mfma_f32_32x32x16_bf16(PAF(1),VFR(1),o[0],0,0,0), C0,8); \
    KRD(GL,1); GAPB(o[1]=__builtin_amdgcn_mfma_f32_32x32x16_bf16(PAF(1),VFR(5),o[1],0,0,0), C0,12); \
    KRD(GL,2); GAPB(o[0]=__builtin_amdgcn_mfma_f32_32x32x16_bf16(PAF(2),VFR(2),o[0],0,0,0), C1,0); \
    KRD(GL,3); GAPB(o[1]=__builtin_amdgcn_mfma_f32_32x32x16_bf16(PAF(2),VFR(6),o[1],0,0,0), C1,4); \
    GAPB(o[0]=__builtin_amdgcn_mfma_f32_32x32x16_bf16(PAF(3),VFR(3),o[0],0,0,0), C1,8); \
    GAPB(o[1]=__builtin_amdgcn_mfma_f32_32x32x16_bf16(PAF(3),VFR(7),o[1],0,0,0), C1,12); \
    }while(0)
  int t=1;
  #undef CMASK
  #define CMASK(P0,P1,t) do{}while(0)
  for(;t+5<NT;t+=2){
    STEP(pB0,pB1,pA0,pA1,t,true,true,true);     WAIT_BAR(2); RESC(); ROT();
    STEP(pA0,pA1,pB0,pB1,t+1,true,true,true);   WAIT_BAR(2); RESC(); ROT();
  }
  #undef CMASK
  #define CMASK(P0,P1,t) do{int jb_=(t)-(NT-4); if(jb_>=0)cmask(P0,P1,jb_,qrel,hi);}while(0)
  #define ENDW(tt) do{ if((tt)+3<NT){WAIT_BAR(2);} else if((tt)+2<NT){WAIT_BAR(1);} else {WAIT_BAR(0);} }while(0)
  for(;t+1<NT;t+=2){
    STEP(pB0,pB1,pA0,pA1,t,(t+3<NT),(t+1<NT),(t+1<NT));       ENDW(t);   RESC(); ROT();
    STEP(pA0,pA1,pB0,pB1,t+1,(t+4<NT),(t+2<NT),(t+2<NT));     ENDW(t+1); RESC(); ROT();
  }
  STEP(pB0,pB1,pA0,pA1,NT-1,false,false,false); RESC();
  { float sacc=pB0[0]+pB0[1]; _Pragma("unroll") for(int r=2;r<16;++r)sacc+=pB0[r]; _Pragma("unroll") for(int r=0;r<16;++r)sacc+=pB1[r]; l_reg+=sacc;
    pw0=(u32x4){PKW(pB0,0),PKW(pB0,2),PKW(pB0,4),PKW(pB0,6)};pw1=(u32x4){PKW(pB0,8),PKW(pB0,10),PKW(pB0,12),PKW(pB0,14)};pw2=(u32x4){PKW(pB1,0),PKW(pB1,2),PKW(pB1,4),PKW(pB1,6)};pw3=(u32x4){PKW(pB1,8),PKW(pB1,10),PKW(pB1,12),PKW(pB1,14)};
    SBAR(); pv(o,vb0+sl_cur,PAF(0),PAF(1),PAF(2),PAF(3)); }
  #undef PKW
  #undef PAF
  #undef VFR
  #undef PIN
  #undef MX3
  #undef GAPA
  #undef GAPB
  #undef EX
  #undef VRD
  #undef KRD
  #undef STEP
  #undef ENDW
  {auto rr=__builtin_amdgcn_permlane32_swap(__float_as_uint(l_reg),__float_as_uint(l_reg),false,false);l_reg=__uint_as_float(rr[0])+__uint_as_float(rr[1]);}
  if(hi==0)wsf[32+r32]=l_reg;asm volatile("s_waitcnt lgkmcnt(0)":::"memory");
  float rli[16];
  #pragma unroll
  for(int r=0;r<16;++r)rli[r]=__builtin_amdgcn_rcpf(wsf[32+crow(r,hi)]);
  bf16*Ow=O+(rowbase+q0+wid*QBLK)*OPITCH+h*D;
  { bf16*stg=(bf16*)(shm+LDS_OST)+wid*2048;
    #pragma unroll
    for(int r=0;r<16;++r){const int orow=crow(r,hi);
      #pragma unroll
      for(int d0=0;d0<2;++d0)stg[orow*64+d0*32+r32]=__float2bfloat16(o[d0][r]*rli[r]);}
    asm volatile("s_waitcnt lgkmcnt(0)":::"memory");
    #pragma unroll
    for(int i=0;i<4;++i){const int row=i*8+(lane>>3),ch=lane&7; const u32x4 v=*(const u32x4*)(stg+row*64+ch*8); ATTN_STORE16(Ow+(long)row*OPITCH+ch*8,v);} }
  asm volatile("s_waitcnt lgkmcnt(0)\n\ts_barrier":::"memory");
  #undef DMA_K
  #undef DMA_V
  #undef BIASINIT
  #undef CMASK
  #undef START
  #undef RESC
  #undef ROT
}
constexpr int ATTN_LDS_BYTES=LDS_BYTES;
struct AttnTensors { const bf16* Q; const bf16* K; const bf16* V; bf16* O; const float* floc; const float* ftot; };
struct AttnUnit { int bh; int qb; };
struct StaticOrder {
  int vcu, G;
  __device__ __forceinline__ explicit StaticOrder(int grid,int block):vcu((grid%8==0)?(block%8)*(grid/8)+block/8:block),G(grid){}
  __device__ __forceinline__ bool next(int i,AttnUnit&u)const{ const int pair=vcu+(i>>1)*G; if(pair>=256)return false; const int s=pair&15; u.bh=pair>>4; u.qb=(i&1)?s:31-s; return true; }
  __device__ __forceinline__ void a_ready(const AttnUnit&)const{}
  __device__ __forceinline__ void done(const AttnUnit&)const{}
};
template<class Sched,int THRL=8> __device__ __forceinline__ void attn_phase(char*lds,const AttnTensors&T,const Sched&S){
  AttnUnit u;
  for(int i=0;S.next(i,u);++i){ S.a_ready(u); attn_unit<THRL>(u.bh/NHEAD,u.bh%NHEAD,u.qb,T.Q,T.K,T.V,T.O,T.floc,T.ftot,lds); S.done(u); }
}
#undef SBAR
#undef WAIT_BAR
}
#define GAS __attribute__((address_space(1)))
#define LAS __attribute__((address_space(3)))
typedef unsigned short bf16;
typedef unsigned v4u __attribute__((ext_vector_type(4)));
typedef float f32x4 __attribute__((ext_vector_type(4)));
typedef short bf16x8 __attribute__((ext_vector_type(8)));
typedef GAS unsigned gu32;
typedef GAS unsigned long long gu64;
#define RLX_AGENT __ATOMIC_RELAXED, __HIP_MEMORY_SCOPE_AGENT
#define LDS_WAIT() asm volatile("s_waitcnt lgkmcnt(0)" ::: "memory")
#define VM_WAIT() asm volatile("s_waitcnt vmcnt(0)" ::: "memory")
__device__ __forceinline__ unsigned long long rt() { return __builtin_amdgcn_s_memrealtime(); }
__device__ __forceinline__ unsigned f2bf(float f) { unsigned u = __builtin_bit_cast(unsigned, f); return (u + 0x7fffu + ((u >> 16) & 1u)) >> 16; }
__device__ __forceinline__ unsigned pk2(float lo, float hi) { return f2bf(lo) | (f2bf(hi) << 16); }

#define XB_TMO      128
#define XB_XCNT(j)  (256  + 64 * (j))
#define XB_XSUB(j)  (1280 + 64 * (j))
#define XB_XGEN(j)  (2304 + 64 * (j))
#define XB_TOP      3328
#define XB_TOPGEN   3392
#define XCD_BAR_WORDS 3456
#define XB_SPIN_CAP (1u << 18)

__device__ __forceinline__ unsigned xb_ld(unsigned* p)              { return __hip_atomic_load(p, __ATOMIC_RELAXED, __HIP_MEMORY_SCOPE_AGENT); }
__device__ __forceinline__ unsigned xb_add(unsigned* p, unsigned v) { return __hip_atomic_fetch_add(p, v, __ATOMIC_RELAXED, __HIP_MEMORY_SCOPE_AGENT); }
__device__ __forceinline__ unsigned xb_xcc_id() { return (unsigned)__builtin_amdgcn_s_getreg((3 << 11) | 20) & 0xFu; }
#define XB_SPIN(cond, bar) do { unsigned _sp = 0; while (cond) { __builtin_amdgcn_s_sleep(1); \
    if ((++_sp & 255u) == 0u) { if (xb_ld(&(bar)[XB_TMO])) break; if (_sp > XB_SPIN_CAP) { atomicAdd(&(bar)[XB_TMO], 1u); break; } } } } while (0)

struct XcdBarrier {
    unsigned* bar; unsigned x;
    volatile LAS unsigned* st;
};

__device__ __forceinline__ XcdBarrier xcd_barrier_post(unsigned* bar, volatile LAS unsigned* st) {
    XcdBarrier b; b.bar = bar; b.x = xb_xcc_id(); b.st = st;
    if (threadIdx.x == 0) (void)xb_add(&bar[XB_XCNT(b.x)], 1u);
    return b;
}
__device__ __forceinline__ void xcd_barrier_complete(unsigned* bar, unsigned x, unsigned& nloc, unsigned& nx) {
    const unsigned G = gridDim.x * gridDim.y * gridDim.z;
    unsigned sum, cnt, mine, sp = 0u;
    for (;;) {
        sum = 0u; cnt = 0u; mine = 0u;
#pragma unroll
        for (unsigned j = 0; j < 16; ++j) { const unsigned c = xb_ld(&bar[XB_XCNT(j)]); sum += c; cnt += (c > 0u) ? 1u : 0u; mine = (j == x) ? c : mine; }
        if (sum == G) break;
        __builtin_amdgcn_s_sleep(1);
        if ((++sp & 255u) == 0u) { if (xb_ld(&bar[XB_TMO])) break; if (sp > XB_SPIN_CAP) { atomicAdd(&bar[XB_TMO], 1u); break; } }
    }
    nloc = mine > 0u ? mine : 1u; nx = cnt > 0u ? cnt : 1u;
}

__device__ __forceinline__ void xcd_barrier(const XcdBarrier& b) {
    asm volatile("s_waitcnt vmcnt(0)" ::: "memory");
    __syncthreads();
    if (threadIdx.x == 0) {
        unsigned* bar = b.bar;
        __builtin_amdgcn_s_waitcnt(0);
        unsigned nloc = b.st[0], nx = b.st[1];
        if (nloc == 0u) { xcd_barrier_complete(bar, b.x, nloc, nx); b.st[0] = nloc; b.st[1] = nx; }
        const unsigned old = xb_add(&bar[XB_XSUB(b.x)], 1u);
        const unsigned gen = old / nloc;
        if (old + 1u == (gen + 1u) * nloc) {
            __builtin_amdgcn_fence(__ATOMIC_RELEASE, "agent");
            asm volatile("s_waitcnt vmcnt(0)" ::: "memory");
            const unsigned og = xb_add(&bar[XB_TOP], 1u);
            const unsigned tg = og / nx;
            if (og + 1u == (tg + 1u) * nx) xb_add(&bar[XB_TOPGEN], 1u);
            else XB_SPIN(xb_ld(&bar[XB_TOPGEN]) == tg, bar);
            __builtin_amdgcn_fence(__ATOMIC_ACQUIRE, "agent");
            xb_add(&bar[XB_XGEN(b.x)], 1u);
            asm volatile("s_waitcnt vmcnt(0)" ::: "memory");
        } else {
            XB_SPIN(xb_ld(&bar[XB_XGEN(b.x)]) == gen, bar);
            __builtin_amdgcn_fence(__ATOMIC_ACQUIRE, "agent");
            asm volatile("s_waitcnt vmcnt(0)" ::: "memory");
        }
    }
    __syncthreads();
}
constexpr int NWAVES = 8, NTHR = 512;
constexpr int BATCH = 2, SEQ = 8192, DMODEL = 1024, MROWS = BATCH * SEQ;
constexpr int N0 = 2560, N0SRC = 2568, DFF = 2816, N1 = 3072, N1SRC = 3088, NEXP = 8, DFFE = 3584;
constexpr int MOE_TILES = 136, MOE_ROWS = MOE_TILES * 256;
constexpr float EPS = 1e-6f, LOG2E = 1.4426950408889634f;
constexpr int NPHASE = 18;
#ifndef MK_ONE_LAUNCH
#define MK_ONE_LAUNCH 1
#endif
constexpr size_t MiB = 1u << 20;
constexpr size_t WS_CTL = 0, CTL_ZERO_BYTES = 65536;
constexpr size_t WS_FLOC0 = 1 * MiB, WS_FLOC1 = WS_FLOC0 + 512 * 1024, WS_IG1 = WS_FLOC1 + 512 * 1024;
constexpr size_t WS_TOKE = WS_IG1 + 512 * 1024, WS_TOKG = WS_TOKE + 128 * 1024, WS_TOKR = WS_TOKG + 128 * 1024, WS_TOKS = WS_TOKR + 128 * 1024;
constexpr size_t WS_SGATE = WS_TOKS + 128 * 1024;
constexpr size_t WS_FTOT0 = WS_SGATE + 256 * 1024, WS_FTOT1 = WS_FTOT0 + 8192, WS_GMAX1 = WS_FTOT1 + 8192, WS_HIST = WS_GMAX1 + 8192, WS_META = WS_HIST + 8192;
static_assert(WS_META + 4096 <= 4 * MiB, "small arrays");
constexpr size_t WS_EGU = 4 * MiB;
constexpr size_t WS_H = 116 * MiB;
constexpr size_t WS_W0IN = 148 * MiB, WS_W0OUT = WS_W0IN + 5 * MiB, WS_W0GU = WS_W0OUT + 2 * MiB, WS_W0D = WS_W0GU + 11 * MiB, WS_W1IN = WS_W0D + 5632 * 1024,
                 WS_WQ = WS_W1IN + 6 * MiB, WS_WK = WS_WQ + 256 * 1024, WS_W1OUT = WS_WK + 256 * 1024;
static_assert(WS_W1OUT + 2 * MiB == 180 * MiB, "dense weights");
constexpr size_t WS_R = 180 * MiB;
constexpr size_t WS_CAT = 276 * MiB, WS_Q1 = 308 * MiB, WS_K1 = 340 * MiB, WS_TST = 372 * MiB;
constexpr size_t WS_AG = 148 * MiB;
constexpr size_t WS_ACTM = 216 * MiB;
constexpr size_t WS_ED = 4 * MiB;
constexpr size_t WS_Y = 60 * MiB;
constexpr size_t WS_END = WS_ACTM + (size_t)MOE_ROWS * DFFE * 2;
static_assert(WS_AG + (size_t)MOE_ROWS * 1024 * 2 <= WS_ACTM && WS_Y + (size_t)MOE_ROWS * 1024 * 4 <= WS_ACTM && WS_ED + (size_t)8 * 1024 * DFFE * 2 <= WS_Y && WS_END <= 455 * MiB, "moe map");
constexpr int CW_TMO = 0, CW_BAR = 4096;
constexpr int SCR_BYTES = 143360, MISC_OFF = SCR_BYTES, LDS_BYTES = 147456;
__device__ __forceinline__ float bf2f(unsigned short b) { return __uint_as_float((unsigned)b << 16); }
__device__ __forceinline__ float bflo(unsigned w) { return __uint_as_float(w << 16); }
__device__ __forceinline__ float bfhi(unsigned w) { return __uint_as_float(w & 0xffff0000u); }
__device__ __forceinline__ float wave_sum(float v) {
#pragma unroll
    for (int o = 1; o < 64; o <<= 1) v += __shfl_xor(v, o);
    return v;
}
__device__ __forceinline__ float wave_max(float v) {
#pragma unroll
    for (int o = 1; o < 64; o <<= 1) v = fmaxf(v, __shfl_xor(v, o));
    return v;
}
__device__ __forceinline__ float scan_add(float v, int lane) {
#pragma unroll
    for (int o = 1; o < 64; o <<= 1) { const float t = __shfl_up(v, o); if (lane >= o) v += t; }
    return v;
}
__device__ __forceinline__ float scan_max(float v, int lane) {
#pragma unroll
    for (int o = 1; o < 64; o <<= 1) { const float t = __shfl_up(v, o); if (lane >= o) v = fmaxf(v, t); }
    return v;
}
__device__ __forceinline__ float log_sigmoid(float z) { return fminf(z, 0.f) - log1pf(expf(-fabsf(z))); }
__device__ __forceinline__ float sigmoid_f(float z) { return 1.0f / (1.0f + expf(-z)); }

struct KP {
    const float* in[29]; float* out; unsigned char* ws; int ph_lo, ph_hi;
};
typedef const __attribute__((address_space(4))) KP* KPp;
__device__ __forceinline__ KPp kp_get() { KPp q = (KPp)__builtin_amdgcn_kernarg_segment_ptr(); asm volatile("" : "+s"(q)); return q; }
enum { I_X = 0, I_L0N1G, I_L0WIN, I_L0BF, I_L0DWW, I_L0DWB, I_L0CLNG, I_L0CLNB, I_L0WOUT, I_L0N2G, I_L0WG, I_L0WU, I_L0WD,
       I_L1N1G, I_L1WIN, I_L1BI, I_L1BF, I_L1CW, I_L1CB, I_L1WQ, I_L1WK, I_L1HG, I_L1WOUT, I_L1N2G, I_L1RT, I_L1EG, I_L1EU, I_L1ED, I_FNG };

__device__ __forceinline__ void cvt_item(const float* src, int ld, int c0, int k0, bf16* dst, int K, int r0, float scale, LAS float* scr, int lane) {
    const GAS float* s = (const GAS float*)src + (size_t)k0 * ld + c0;
    f32x4 v[16];
#pragma unroll
    for (int i = 0; i < 16; ++i) v[i] = *(const GAS f32x4*)(s + (size_t)(4 * i + (lane >> 4)) * ld + 4 * (lane & 15));
#pragma unroll
    for (int i = 0; i < 16; ++i) { LAS float* p = scr + (4 * i + (lane >> 4)) * 65 + 4 * (lane & 15); p[0] = v[i][0]; p[1] = v[i][1]; p[2] = v[i][2]; p[3] = v[i][3]; }
    LDS_WAIT(); asm volatile("" ::: "memory");
    const int c = lane & 7;
#pragma unroll
    for (int j = 0; j < 8; ++j) { const int n = (lane >> 3) + 8 * j; const LAS float* q = scr + (8 * c) * 65 + n;
        v4u o; o.x = pk2(q[0] * scale, q[65] * scale); o.y = pk2(q[130] * scale, q[195] * scale); o.z = pk2(q[260] * scale, q[325] * scale); o.w = pk2(q[390] * scale, q[455] * scale);
        *(GAS v4u*)(dst + (size_t)(r0 + n) * K + k0 + 8 * c) = o; }
    LDS_WAIT(); asm volatile("" ::: "memory");
}
__device__ __forceinline__ void convert_weights(KPp p, LAS unsigned char* lds, int gw, int ngw, int lane, int wave, bool late) {
    LAS float* scr = (LAS float*)(lds + wave * 16640);
    unsigned char* ws = p->ws;
    constexpr int J0 = 16 * 40, J1 = 256, J2 = 16 * 88, J3 = 44 * 16, J4 = 16 * 48, J5 = 32, J6 = 32, J7 = 256, J8 = 8 * 16 * 112;
    const int NIT = late ? 8 * 56 * 16 : J0 + J1 + J2 + J3 + J4 + J5 + J6 + J7 + J8;
    for (int it = gw; it < NIT; it += ngw) {
        const float* src; int ld, c0, k0, K, r0; size_t dsto; float scale = 1.f;
        int r = it;
        if (late) { const int e = r / (56 * 16), q = r % (56 * 16), kb = q / 16, nb = q % 16;
            src = p->in[I_L1ED] + (size_t)e * DFFE * 1024; ld = 1024; c0 = nb * 64; k0 = kb * 64; dsto = WS_ED + (size_t)e * 1024 * DFFE * 2; K = DFFE; r0 = nb * 64; }
        else if (r < J0) { const int kb = r / 40, nb = r % 40, n0 = nb * 64; src = p->in[I_L0WIN]; ld = N0SRC; c0 = n0 < 1536 ? n0 : n0 + 8; k0 = kb * 64; dsto = WS_W0IN; K = 1024; r0 = n0; }
        else if ((r -= J0) < J1) { const int kb = r / 16, nb = r % 16; src = p->in[I_L0WOUT]; ld = 1024; c0 = nb * 64; k0 = kb * 64; dsto = WS_W0OUT; K = 1024; r0 = nb * 64; }
        else if ((r -= J1) < J2) { const int kb = r / 88, nb = r % 88, n0 = nb * 64, pn = n0 >> 8, j = n0 & 255; src = j < 128 ? p->in[I_L0WG] : p->in[I_L0WU]; ld = DFF; c0 = 128 * pn + (j & 127); k0 = kb * 64; dsto = WS_W0GU; K = 1024; r0 = n0; }
        else if ((r -= J2) < J3) { const int kb = r / 16, nb = r % 16; src = p->in[I_L0WD]; ld = 1024; c0 = nb * 64; k0 = kb * 64; dsto = WS_W0D; K = DFF; r0 = nb * 64; }
        else if ((r -= J3) < J4) { const int kb = r / 48, nb = r % 48; src = p->in[I_L1WIN]; ld = N1SRC; c0 = nb * 64; k0 = kb * 64; dsto = WS_W1IN; K = 1024; r0 = nb * 64; }
        else if ((r -= J4) < J5) { const int h = r >> 2, kb = (r >> 1) & 1, nb = r & 1; src = p->in[I_L1WQ] + (size_t)h * 16384; ld = 128; c0 = nb * 64; k0 = kb * 64; dsto = WS_WQ + (size_t)h * 32768; K = 128; r0 = nb * 64; }
        else if ((r -= J5) < J6) { const int h = r >> 2, kb = (r >> 1) & 1, nb = r & 1; src = p->in[I_L1WK] + (size_t)h * 16384; ld = 128; c0 = nb * 64; k0 = kb * 64; dsto = WS_WK + (size_t)h * 32768; K = 128; r0 = nb * 64; scale = 0.08838834764831845f; }
        else if ((r -= J6) < J7) { const int kb = r / 16, nb = r % 16; src = p->in[I_L1WOUT]; ld = 1024; c0 = nb * 64; k0 = kb * 64; dsto = WS_W1OUT; K = 1024; r0 = nb * 64; }
        else { r -= J7; const int e = r / (16 * 112), q = r % (16 * 112), kb = q / 112, nb = q % 112, n0 = nb * 64, pn = n0 >> 8, j = n0 & 255;
            src = (j < 128 ? p->in[I_L1EG] : p->in[I_L1EU]) + (size_t)e * 1024 * DFFE; ld = DFFE; c0 = 128 * pn + (j & 127); k0 = kb * 64; dsto = WS_EGU + (size_t)e * 7168 * 1024 * 2; K = 1024; r0 = n0; }
        cvt_item(src, ld, c0, k0, (bf16*)(ws + dsto), K, r0, scale, scr, lane);
    }
}

template <int MODE> __device__ __forceinline__ void norm_phase(KPp p, LAS unsigned char* lds, int tid, int lane, int wave, const float* src, const float* gain, bf16* dst) {
    constexpr int NC = MODE == 0 ? 0 : (MODE == 2 ? 16 : 8);
    unsigned char* ws = p->ws;
    LAS float* wt = (LAS float*)lds;
    LAS float* gt = (LAS float*)(lds + 65536);
    LAS int* et = (LAS int*)(lds + 65536 + 4096);
    if (NC) {
        const float* wsrc = MODE == 1 ? p->in[I_L0WIN] + 1536 : MODE == 2 ? p->in[I_L1WIN] + 3072 : p->in[I_L1RT];
        const int wld = MODE == 1 ? N0SRC : MODE == 2 ? N1SRC : 8;
        for (int k = tid; k < 1024; k += NTHR) {
#pragma unroll
            for (int c4 = 0; c4 < NC / 4; ++c4) { const f32x4 w = *(const GAS f32x4*)(wsrc + (size_t)k * wld + 4 * c4);
                wt[(4 * c4 + 0) * 1024 + k] = w[0]; wt[(4 * c4 + 1) * 1024 + k] = w[1]; wt[(4 * c4 + 2) * 1024 + k] = w[2]; wt[(4 * c4 + 3) * 1024 + k] = w[3]; }
        }
        __syncthreads();
    }
    f32x4 g4[4];
#pragma unroll
    for (int j = 0; j < 4; ++j) g4[j] = *(const GAS f32x4*)(gain + 4 * lane + 256 * j);
    for (int blk = blockIdx.x; blk < MROWS / 64; blk += gridDim.x) {
        for (int rr = 0; rr < 8; ++rr) {
            const int rl = wave * 8 + rr, row = blk * 64 + rl;
            const GAS f32x4* xr = (const GAS f32x4*)(src + (size_t)row * DMODEL) + lane;
            f32x4 v[4]; float ss = 0.f;
#pragma unroll
            for (int j = 0; j < 4; ++j) { v[j] = xr[64 * j]; ss += (v[j][0] * v[j][0] + v[j][1] * v[j][1]) + (v[j][2] * v[j][2] + v[j][3] * v[j][3]); }
            const float rstd = rsqrtf(wave_sum(ss) * (1.f / DMODEL) + EPS);
#pragma unroll
            for (int j = 0; j < 4; ++j) v[j] = v[j] * rstd * g4[j];
            GAS unsigned long long* o8 = (GAS unsigned long long*)(dst + (size_t)row * DMODEL) + lane;
#pragma unroll
            for (int j = 0; j < 4; ++j) o8[64 * j] = (unsigned long long)pk2(v[j][0], v[j][1]) | ((unsigned long long)pk2(v[j][2], v[j][3]) << 32);
            if (NC) {
                float a[NC ? NC : 1];
#pragma unroll
                for (int c = 0; c < NC; ++c) { float s = 0.f;
#pragma unroll
                    for (int j = 0; j < 4; ++j) { const f32x4 w = *(const LAS f32x4*)(wt + c * 1024 + 4 * lane + 256 * j); s += (v[j][0] * w[0] + v[j][1] * w[1]) + (v[j][2] * w[2] + v[j][3] * w[3]); }
                    a[c] = wave_sum(s); }
                if (MODE == 3) {
                    int e1 = 0; float l1 = a[0];
#pragma unroll
                    for (int c = 1; c < 8; ++c) if (a[c] > l1) { l1 = a[c]; e1 = c; }
                    int e2 = -1; float l2 = -INFINITY;
#pragma unroll
                    for (int c = 0; c < 8; ++c) if (c != e1 && a[c] > l2) { l2 = a[c]; e2 = c; }
                    const float g1 = 1.f / (1.f + expf(l2 - l1)), g2 = 1.f - g1;
                    if (lane == 0) { et[rl * 2] = e1; et[rl * 2 + 1] = e2; ((int*)(ws + WS_TOKE))[row * 2] = e1; ((int*)(ws + WS_TOKE))[row * 2 + 1] = e2;
                        ((float*)(ws + WS_TOKG))[row * 2] = g1; ((float*)(ws + WS_TOKG))[row * 2 + 1] = g2; }
                } else {
                    float val = a[0];
#pragma unroll
                    for (int c = 1; c < NC; ++c) val = (lane == c) ? a[c] : val;
                    if (lane < NC) gt[rl * 16 + lane] = val;
                }
            }
        }
        if (NC) {
            __syncthreads();
            const int row = blk * 64 + lane, h = wave;
            if (MODE == 1) {
                const float lf = log_sigmoid(gt[lane * 16 + h] + p->in[I_L0BF][h]); const float cs = scan_add(lf, lane);
                ((float*)(ws + WS_FLOC0))[row * 8 + h] = cs; if (lane == 63) ((float*)(ws + WS_FTOT0))[blk * 8 + h] = cs;
            } else if (MODE == 2) {
                const float li = gt[lane * 16 + h] + p->in[I_L1BI][h]; const float lf = log_sigmoid(gt[lane * 16 + 8 + h] + p->in[I_L1BF][h]); const float cs = scan_add(lf, lane);
                ((float*)(ws + WS_FLOC1))[row * 8 + h] = cs; ((float*)(ws + WS_IG1))[row * 8 + h] = li;
                const float gm = wave_max(li - cs);
                if (lane == 63) { ((float*)(ws + WS_FTOT1))[blk * 8 + h] = cs; ((float*)(ws + WS_GMAX1))[blk * 8 + h] = gm; }
            } else if (MODE == 3) {
                if (tid < 8) { int cnt = 0;
                    for (int r = 0; r < 64; ++r) { const int e1 = et[r * 2], e2 = et[r * 2 + 1];
                        if (e1 == tid) { ((int*)(ws + WS_TOKR))[(blk * 64 + r) * 2] = cnt; ++cnt; }
                        if (e2 == tid) { ((int*)(ws + WS_TOKR))[(blk * 64 + r) * 2 + 1] = cnt; ++cnt; } }
                    ((int*)(ws + WS_HIST))[blk * 8 + tid] = cnt; }
            }
            __syncthreads();
        }
    }
}

__device__ __forceinline__ void scatter_phase(KPp p, LAS unsigned char* lds, int tid, int lane, int wave) {
    unsigned char* ws = p->ws;
    LAS int* tb = (LAS int*)lds;
    const int* hist = (const int*)(ws + WS_HIST);
    for (int blk = blockIdx.x; blk < MROWS / 64; blk += gridDim.x) {
        if (tid < 8) { int tot = 0, pre = 0; for (int b = 0; b < MROWS / 64; ++b) { const int c = hist[b * 8 + tid]; tot += c; if (b < blk) pre += c; } tb[tid] = tot; tb[16 + tid] = pre; }
        __syncthreads();
        if (tid == 0) { int base = 0; for (int e = 0; e < 8; ++e) { tb[8 + e] = base; base += ((tb[e] + 255) >> 8) << 8; } tb[24] = base;
            if (blk == 0) { int* meta = (int*)(ws + WS_META); for (int e = 0; e < 8; ++e) meta[e] = tb[8 + e] >> 8; meta[8] = base >> 8; } }
        __syncthreads();
        for (int rr = 0; rr < 8; ++rr) { const int row = blk * 64 + wave * 8 + rr;
            const v4u a0 = *(const GAS v4u*)((const bf16*)(ws + WS_H) + (size_t)row * 1024 + lane * 8), a1 = *(const GAS v4u*)((const bf16*)(ws + WS_H) + (size_t)row * 1024 + 512 + lane * 8);
#pragma unroll
            for (int k = 0; k < 2; ++k) { const int e = ((const int*)(ws + WS_TOKE))[row * 2 + k]; const int slot = tb[8 + e] + tb[16 + e] + ((const int*)(ws + WS_TOKR))[row * 2 + k];
                if (lane == 0) { ((int*)(ws + WS_TOKS))[row * 2 + k] = slot; ((float*)(ws + WS_SGATE))[slot] = ((const float*)(ws + WS_TOKG))[row * 2 + k]; }
                *(GAS v4u*)((bf16*)(ws + WS_AG) + (size_t)slot * 1024 + lane * 8) = a0; *(GAS v4u*)((bf16*)(ws + WS_AG) + (size_t)slot * 1024 + 512 + lane * 8) = a1; } }
        if (blk < 8) {
            const int lo = tb[8 + blk] + tb[blk], hi = tb[8 + blk] + (((tb[blk] + 255) >> 8) << 8); const v4u z = {0u, 0u, 0u, 0u};
            for (int s = lo + wave; s < hi; s += NWAVES) { if (lane == 0) ((float*)(ws + WS_SGATE))[s] = 0.f;
                *(GAS v4u*)((bf16*)(ws + WS_AG) + (size_t)s * 1024 + lane * 8) = z; *(GAS v4u*)((bf16*)(ws + WS_AG) + (size_t)s * 1024 + 512 + lane * 8) = z; } }
        __syncthreads();
    }
}

__device__ __forceinline__ void final_phase(KPp p, int lane, int wave) {
    unsigned char* ws = p->ws; const float* Y = (const float*)(ws + WS_Y);
    f32x4 g4[4];
#pragma unroll
    for (int j = 0; j < 4; ++j) g4[j] = *(const GAS f32x4*)(p->in[I_FNG] + 4 * lane + 256 * j);
    for (int row = blockIdx.x * NWAVES + wave; row < MROWS; row += gridDim.x * NWAVES) {
        const int s1 = ((const int*)(ws + WS_TOKS))[row * 2], s2 = ((const int*)(ws + WS_TOKS))[row * 2 + 1];
        const GAS f32x4* xr = (const GAS f32x4*)(p->out + (size_t)row * DMODEL) + lane; const GAS f32x4* y1 = (const GAS f32x4*)(Y + (size_t)s1 * DMODEL) + lane; const GAS f32x4* y2 = (const GAS f32x4*)(Y + (size_t)s2 * DMODEL) + lane;
        f32x4 v[4]; float ss = 0.f;
#pragma unroll
        for (int j = 0; j < 4; ++j) { v[j] = xr[64 * j] + y1[64 * j] + y2[64 * j]; ss += (v[j][0] * v[j][0] + v[j][1] * v[j][1]) + (v[j][2] * v[j][2] + v[j][3] * v[j][3]); }
        const float rstd = rsqrtf(wave_sum(ss) * (1.f / DMODEL) + EPS);
        GAS f32x4* o = (GAS f32x4*)(p->out + (size_t)row * DMODEL) + lane;
#pragma unroll
        for (int j = 0; j < 4; ++j) o[64 * j] = v[j] * rstd * g4[j];
    }
}

__device__ __forceinline__ void conv_phase(KPp p, LAS unsigned char* lds, int tid, int lane, int wave) {
    unsigned char* ws = p->ws; const bf16* P0 = (const bf16*)(ws + WS_R); bf16* CAT = (bf16*)(ws + WS_CAT);
    LAS float* yt = (LAS float*)lds;
    const int c = tid;
    float w[31];
#pragma unroll
    for (int j = 0; j < 31; ++j) w[j] = p->in[I_L0DWW][j * 512 + c];
    const float bias = p->in[I_L0DWB][c];
    for (int u = blockIdx.x; u < MROWS / 16; u += gridDim.x) {
        const int row0 = u * 16, b = row0 / SEQ, t0 = row0 % SEQ;
        float y[16];
#pragma unroll
        for (int i = 0; i < 16; ++i) y[i] = bias;
#pragma unroll
        for (int r = 0; r < 46; ++r) {
            const int t = t0 - 30 + r; float uv = 0.f;
            if (t >= 0) { const size_t off = (size_t)(b * SEQ + t) * N0; const float a = bf2f(P0[off + 1536 + c]), g = bf2f(P0[off + 2048 + c]); uv = a * sigmoid_f(g); }
#pragma unroll
            for (int i = 0; i < 16; ++i) { const int j = r - i; if (j >= 0 && j <= 30) y[i] += w[j] * uv; }
        }
#pragma unroll
        for (int i = 0; i < 16; ++i) yt[i * 512 + c] = y[i];
        __syncthreads();
#pragma unroll
        for (int k = 0; k < 2; ++k) { const int i = wave * 2 + k;
            const f32x4 v0 = *(const LAS f32x4*)(yt + i * 512 + lane * 8), v1 = *(const LAS f32x4*)(yt + i * 512 + lane * 8 + 4);
            const float mu = wave_sum((v0[0] + v0[1]) + (v0[2] + v0[3]) + (v1[0] + v1[1]) + (v1[2] + v1[3])) * (1.f / 512.f);
            const f32x4 d0 = v0 - mu, d1 = v1 - mu;
            const float var = wave_sum((d0[0] * d0[0] + d0[1] * d0[1]) + (d0[2] * d0[2] + d0[3] * d0[3]) + (d1[0] * d1[0] + d1[1] * d1[1]) + (d1[2] * d1[2] + d1[3] * d1[3])) * (1.f / 512.f);
            const float rstd = rsqrtf(var + EPS);
            const f32x4 ga = *(const GAS f32x4*)(p->in[I_L0CLNG] + lane * 8), gb = *(const GAS f32x4*)(p->in[I_L0CLNG] + lane * 8 + 4), ba = *(const GAS f32x4*)(p->in[I_L0CLNB] + lane * 8), bb = *(const GAS f32x4*)(p->in[I_L0CLNB] + lane * 8 + 4);
            f32x4 o0 = d0 * rstd * ga + ba, o1 = d1 * rstd * gb + bb;
#pragma unroll
            for (int e = 0; e < 4; ++e) { o0[e] = o0[e] * sigmoid_f(o0[e]); o1[e] = o1[e] * sigmoid_f(o1[e]); }
            v4u o; o.x = pk2(o0[0], o0[1]); o.y = pk2(o0[2], o0[3]); o.z = pk2(o1[0], o1[1]); o.w = pk2(o1[2], o1[3]);
            *(GAS v4u*)(CAT + (size_t)(row0 + i) * 1024 + 512 + lane * 8) = o; }
        __syncthreads();
    }
}
namespace ml {
typedef float f32x16 __attribute__((ext_vector_type(16)));
typedef short s16x4 __attribute__((ext_vector_type(4)));
typedef unsigned u32x2 __attribute__((ext_vector_type(2)));
constexpr int LD = 136, LDV = 168, LDP = 72, LDH = 132;
constexpr int O_QL = 0, O_KL = 17408, O_KP = 34816, O_VL = 52224, O_PL = 73728, O_SL = 91136, O_TB = 134656;
constexpr int T_FPRE = 0, T_MST = 128, T_G2 = 272, T_M2 = 336, T_WI = 400, T_EDM = 464, T_NQ = 528, T_WS = 592, T_CW = 656, T_END = 656 + 640;
static_assert(O_TB + T_END * 4 <= SCR_BYTES, "mlstm lds");
__device__ __forceinline__ f32x16 mfma32(bf16x8 a, bf16x8 b, f32x16 c) { return __builtin_amdgcn_mfma_f32_32x32x16_bf16(a, b, c, 0, 0, 0); }
__device__ __forceinline__ bf16x8 tr_frag(const LAS bf16* X, int ldx, int k0, int i0, int lane) {
    const int g4 = lane >> 4, hh = g4 >> 1, cg = g4 & 1, i = lane & 15, q = i >> 2, pp = i & 3;
    const LAS bf16* a = X + (k0 + 8 * hh + q) * ldx + i0 + 16 * cg + 4 * pp;
    const s16x4 lo = __builtin_bit_cast(s16x4, __builtin_amdgcn_ds_read_tr16_b64_v4i16((LAS s16x4*)a));
    const s16x4 hi = __builtin_bit_cast(s16x4, __builtin_amdgcn_ds_read_tr16_b64_v4i16((LAS s16x4*)(a + 4 * ldx)));
    return (bf16x8){lo[0], lo[1], lo[2], lo[3], hi[0], hi[1], hi[2], hi[3]};
}
__device__ __forceinline__ f32x16 mma_nt8(f32x16 acc, const LAS bf16* a, const LAS bf16* b) {
#pragma unroll
    for (int ks = 0; ks < 8; ++ks) acc = mfma32(*(const LAS bf16x8*)(a + 16 * ks), *(const LAS bf16x8*)(b + 16 * ks), acc);
    return acc;
}
__device__ __forceinline__ void st4(LAS bf16* d, float a, float b, float c, float e) { *(LAS u32x2*)d = (u32x2){pk2(a, b), pk2(c, e)}; }
__device__ __forceinline__ void gate_setup(const unsigned char* ws, LAS float* tb, int b, int h, int lane, int wave) {
    if (wave == 0) {
        const float* ft = (const float*)(ws + WS_FTOT1); const float* gm = (const float*)(ws + WS_GMAX1);
        const float a0 = ft[(b * 128 + lane) * 8 + h], a1 = ft[(b * 128 + 64 + lane) * 8 + h];
        const float s0 = scan_add(a0, lane), s1 = scan_add(a1, lane) + __shfl(s0, 63);
        const float f0 = s0 - a0, f1 = s1 - a1;
        tb[T_FPRE + lane] = f0; tb[T_FPRE + 64 + lane] = f1;
        const float m0 = scan_max(gm[(b * 128 + lane) * 8 + h] - f0, lane); const float m1 = fmaxf(scan_max(gm[(b * 128 + 64 + lane) * 8 + h] - f1, lane), __shfl(m0, 63));
        tb[T_MST + 1 + lane] = fmaxf(m0, 0.f); tb[T_MST + 65 + lane] = fmaxf(m1, 0.f); if (lane == 0) tb[T_MST] = 0.f;
    }
}
__device__ __forceinline__ void unpack16(const v4u x0, const v4u x1, float (&f)[16]) {
    f[0] = bflo(x0.x); f[1] = bfhi(x0.x); f[2] = bflo(x0.y); f[3] = bfhi(x0.y); f[4] = bflo(x0.z); f[5] = bfhi(x0.z); f[6] = bflo(x0.w); f[7] = bfhi(x0.w);
    f[8] = bflo(x1.x); f[9] = bfhi(x1.x); f[10] = bflo(x1.y); f[11] = bfhi(x1.y); f[12] = bflo(x1.z); f[13] = bfhi(x1.z); f[14] = bflo(x1.w); f[15] = bfhi(x1.w);
}
__device__ __forceinline__ void pack16(const float (&f)[16], v4u& x0, v4u& x1) {
    x0.x = pk2(f[0], f[1]); x0.y = pk2(f[2], f[3]); x0.z = pk2(f[4], f[5]); x0.w = pk2(f[6], f[7]); x1.x = pk2(f[8], f[9]); x1.y = pk2(f[10], f[11]); x1.z = pk2(f[12], f[13]); x1.w = pk2(f[14], f[15]);
}

__device__ __forceinline__ void pass_a(KPp p, LAS unsigned char* lds, int tid, int lane, int wave) {
    unsigned char* ws = p->ws;
    const bf16* P1 = (const bf16*)(ws + WS_R); bf16* Q1 = (bf16*)(ws + WS_Q1); bf16* K1 = (bf16*)(ws + WS_K1); float* TST = (float*)(ws + WS_TST);
    const float* FLOC1 = (const float*)(ws + WS_FLOC1); const float* IG1 = (const float*)(ws + WS_IG1);
    LAS bf16* Ql = (LAS bf16*)(lds + O_QL); LAS bf16* Kl = (LAS bf16*)(lds + O_KL); LAS bf16* Kp = (LAS bf16*)(lds + O_KP); LAS bf16* Vl = (LAS bf16*)(lds + O_VL); LAS bf16* Ul = (LAS bf16*)(lds + O_PL);
    LAS float* tb = (LAS float*)(lds + O_TB);
    const int r = lane & 31, hh = lane >> 5, etile = wave >> 1, ttile = wave & 1, vtile = wave & 3, kt0 = 2 * (wave >> 2), t = tid >> 3, dg = tid & 7;
    for (int unit = blockIdx.x; unit < 256; unit += gridDim.x) {
        const int b = unit >> 7, h = (unit >> 4) & 7, j = unit & 15;
        gate_setup(ws, tb, b, h, lane, wave);
        for (int idx = tid; idx < 640; idx += NTHR) { const int jj = idx >> 7, d = idx & 127; tb[T_CW + idx] = jj < 4 ? p->in[I_L1CW][jj * 1024 + h * 128 + d] : p->in[I_L1CB][h * 128 + d]; }
        *(LAS u32x2*)(Vl + t * LDV + 128 + 4 * dg) = (u32x2){dg == 0 ? 0x3F80u : 0u, 0u};
        bf16x8 wqf[8], wkf[8];
        { const bf16* wq = (const bf16*)(ws + WS_WQ) + (size_t)(h * 128 + etile * 32 + r) * 128 + 8 * hh; const bf16* wk = (const bf16*)(ws + WS_WK) + (size_t)(h * 128 + etile * 32 + r) * 128 + 8 * hh;
#pragma unroll
          for (int ks = 0; ks < 8; ++ks) { wqf[ks] = *(const GAS bf16x8*)(wq + 16 * ks); wkf[ks] = *(const GAS bf16x8*)(wk + 16 * ks); } }
        f32x16 aT0 = {}, aT1 = {}, aN = {};
        __syncthreads();
        const float Mend = tb[T_MST + 8 * j + 8];
        for (int cc = 0; cc < 8; ++cc) {
            const int c = 8 * j + cc; const size_t row0 = (size_t)b * SEQ + c * 64;
            {
                float yv[16];
#pragma unroll
                for (int i = 0; i < 16; ++i) yv[i] = tb[T_CW + 512 + 16 * dg + i];
#pragma unroll
                for (int jj = 0; jj < 4; ++jj) { const int tt = c * 64 + t - 3 + jj;
                    if (tt >= 0) { const bf16* src = P1 + ((size_t)b * SEQ + tt) * N1 + h * 128 + 16 * dg; const v4u x0 = *(const GAS v4u*)src, x1 = *(const GAS v4u*)(src + 8); float xf[16]; unpack16(x0, x1, xf);
#pragma unroll
                        for (int i = 0; i < 16; ++i) yv[i] += tb[T_CW + jj * 128 + 16 * dg + i] * xf[i]; } }
#pragma unroll
                for (int i = 0; i < 16; ++i) yv[i] = yv[i] * sigmoid_f(yv[i]);
                v4u u0, u1; pack16(yv, u0, u1); *(LAS v4u*)(Ul + t * LD + 16 * dg) = u0; *(LAS v4u*)(Ul + t * LD + 16 * dg + 8) = u1;
                const bf16* vs = P1 + (row0 + t) * N1 + 1024 + h * 128 + 16 * dg; *(LAS v4u*)(Vl + t * LDV + 16 * dg) = *(const GAS v4u*)vs; *(LAS v4u*)(Vl + t * LDV + 16 * dg + 8) = *(const GAS v4u*)(vs + 8);
                if (dg == 0) { const float G = IG1[(row0 + t) * 8 + h] - (tb[T_FPRE + c] + FLOC1[(row0 + t) * 8 + h]); tb[T_WS + t] = expf(G - Mend); }
            }
            __syncthreads();
            {
                f32x16 aq = {}, ak = {}; const LAS bf16* ub = Ul + (ttile * 32 + r) * LD + 8 * hh;
#pragma unroll
                for (int ks = 0; ks < 8; ++ks) { const bf16x8 bf = *(const LAS bf16x8*)(ub + 16 * ks); aq = mfma32(wqf[ks], bf, aq); ak = mfma32(wkf[ks], bf, ak); }
                const int tq = ttile * 32 + r; const float w = tb[T_WS + tq];
#pragma unroll
                for (int g = 0; g < 4; ++g) { const int e0 = etile * 32 + 8 * g + 4 * hh;
                    st4(Ql + tq * LD + e0, aq[4 * g], aq[4 * g + 1], aq[4 * g + 2], aq[4 * g + 3]); st4(Kl + tq * LD + e0, ak[4 * g], ak[4 * g + 1], ak[4 * g + 2], ak[4 * g + 3]);
                    st4(Kp + tq * LD + e0, ak[4 * g] * w, ak[4 * g + 1] * w, ak[4 * g + 2] * w, ak[4 * g + 3] * w); }
            }
            __syncthreads();
            {
                bf16* qd = Q1 + (row0 + t) * 1024 + h * 128 + 16 * dg; bf16* kd = K1 + (row0 + t) * 1024 + h * 128 + 16 * dg;
                *(GAS v4u*)qd = *(const LAS v4u*)(Ql + t * LD + 16 * dg); *(GAS v4u*)(qd + 8) = *(const LAS v4u*)(Ql + t * LD + 16 * dg + 8);
                *(GAS v4u*)kd = *(const LAS v4u*)(Kl + t * LD + 16 * dg); *(GAS v4u*)(kd + 8) = *(const LAS v4u*)(Kl + t * LD + 16 * dg + 8);
#pragma unroll
                for (int ks = 0; ks < 4; ++ks) { const bf16x8 bv = tr_frag(Vl, LDV, 16 * ks, vtile * 32, lane), a0 = tr_frag(Kp, LD, 16 * ks, kt0 * 32, lane), a1 = tr_frag(Kp, LD, 16 * ks, kt0 * 32 + 32, lane);
                    aT0 = mfma32(a0, bv, aT0); aT1 = mfma32(a1, bv, aT1); }
                if (wave < 4) {
#pragma unroll
                    for (int ks = 0; ks < 4; ++ks) { const bf16x8 bn = tr_frag(Vl, LDV, 16 * ks, 128, lane), a = tr_frag(Kp, LD, 16 * ks, wave * 32, lane); aN = mfma32(a, bn, aN); } }
            }
            __syncthreads();
        }
        float* T = TST + (size_t)unit * 160 * 128;
#pragma unroll
        for (int g = 0; g < 4; ++g) { const int k0 = kt0 * 32 + 8 * g + 4 * hh;
            *(GAS f32x4*)(T + (vtile * 32 + r) * 128 + k0) = (f32x4){aT0[4 * g], aT0[4 * g + 1], aT0[4 * g + 2], aT0[4 * g + 3]};
            *(GAS f32x4*)(T + (vtile * 32 + r) * 128 + k0 + 32) = (f32x4){aT1[4 * g], aT1[4 * g + 1], aT1[4 * g + 2], aT1[4 * g + 3]};
            if (wave < 4) *(GAS f32x4*)(T + (128 + r) * 128 + wave * 32 + 8 * g + 4 * hh) = (f32x4){aN[4 * g], aN[4 * g + 1], aN[4 * g + 2], aN[4 * g + 3]}; }
    }
}

__device__ __forceinline__ void pass_b(KPp p, LAS unsigned char* lds, int tid, int lane, int wave) {
    unsigned char* ws = p->ws;
    const bf16* P1 = (const bf16*)(ws + WS_R); const bf16* Q1 = (const bf16*)(ws + WS_Q1); const bf16* K1 = (const bf16*)(ws + WS_K1); const float* TST = (const float*)(ws + WS_TST); bf16* CAT = (bf16*)(ws + WS_CAT);
    const float* FLOC1 = (const float*)(ws + WS_FLOC1); const float* IG1 = (const float*)(ws + WS_IG1);
    LAS bf16* Ql = (LAS bf16*)(lds + O_QL); LAS bf16* Kl = (LAS bf16*)(lds + O_KL); LAS bf16* Kp = (LAS bf16*)(lds + O_KP); LAS bf16* Vl = (LAS bf16*)(lds + O_VL); LAS bf16* Pl = (LAS bf16*)(lds + O_PL);
    LAS bf16* Sl = (LAS bf16*)(lds + O_SL); LAS float* Hst = (LAS float*)(lds + O_QL); LAS float* tb = (LAS float*)(lds + O_TB);
    const int r = lane & 31, hh = lane >> 5, vth = wave >> 1, ttile = wave & 1, vtile = wave & 3, kt0 = 2 * (wave >> 2), t = tid >> 3, dg = tid & 7;
    for (int unit = blockIdx.x; unit < 256; unit += gridDim.x) {
        const int b = unit >> 7, h = (unit >> 4) & 7, j = unit & 15;
        gate_setup(ws, tb, b, h, lane, wave);
        *(LAS u32x2*)(Vl + t * LDV + 128 + 4 * dg) = (u32x2){dg == 0 ? 0x3F80u : 0u, 0u};
        __syncthreads();
        f32x16 S0 = {}, S1 = {}, SN = {};
        { const float Mstart = tb[T_MST + 8 * j];
          for (int jp = 0; jp < j; ++jp) { const float wgt = expf(tb[T_MST + 8 * jp + 8] - Mstart); const float* T = TST + (size_t)(unit - j + jp) * 160 * 128;
#pragma unroll
              for (int g = 0; g < 4; ++g) { const int k0 = kt0 * 32 + 8 * g + 4 * hh; const f32x4 x0 = *(const GAS f32x4*)(T + (vtile * 32 + r) * 128 + k0), x1 = *(const GAS f32x4*)(T + (vtile * 32 + r) * 128 + k0 + 32);
#pragma unroll
                  for (int i = 0; i < 4; ++i) { S0[4 * g + i] += wgt * x0[i]; S1[4 * g + i] += wgt * x1[i]; }
                  if (wave < 4) { const f32x4 xn = *(const GAS f32x4*)(T + (128 + r) * 128 + wave * 32 + 8 * g + 4 * hh);
#pragma unroll
                      for (int i = 0; i < 4; ++i) SN[4 * g + i] += wgt * xn[i]; } } } }
#define ML_WRITE_SL() do { _Pragma("unroll") for (int g = 0; g < 4; ++g) { const int k0 = kt0 * 32 + 8 * g + 4 * hh; \
            st4(Sl + (vtile * 32 + r) * LD + k0, S0[4 * g], S0[4 * g + 1], S0[4 * g + 2], S0[4 * g + 3]); st4(Sl + (vtile * 32 + r) * LD + k0 + 32, S1[4 * g], S1[4 * g + 1], S1[4 * g + 2], S1[4 * g + 3]); \
            if (wave < 4) st4(Sl + (128 + r) * LD + wave * 32 + 8 * g + 4 * hh, SN[4 * g], SN[4 * g + 1], SN[4 * g + 2], SN[4 * g + 3]); } } while (0)
        ML_WRITE_SL();
        __syncthreads();
        for (int cc = 0; cc < 8; ++cc) {
            const int c = 8 * j + cc; const size_t row0 = (size_t)b * SEQ + c * 64;
            const float Mc = tb[T_MST + c], Mc1 = tb[T_MST + c + 1], Fp = tb[T_FPRE + c];
            {
                const bf16* qs = Q1 + (row0 + t) * 1024 + h * 128 + 16 * dg; const bf16* ks_ = K1 + (row0 + t) * 1024 + h * 128 + 16 * dg; const bf16* vs = P1 + (row0 + t) * N1 + 1024 + h * 128 + 16 * dg;
                const v4u q0 = *(const GAS v4u*)qs, q1 = *(const GAS v4u*)(qs + 8), k0 = *(const GAS v4u*)ks_, k1 = *(const GAS v4u*)(ks_ + 8), v0 = *(const GAS v4u*)vs, v1 = *(const GAS v4u*)(vs + 8);
                const float G = IG1[(row0 + t) * 8 + h] - (Fp + FLOC1[(row0 + t) * 8 + h]); const float w = expf(G - Mc1);
                *(LAS v4u*)(Ql + t * LD + 16 * dg) = q0; *(LAS v4u*)(Ql + t * LD + 16 * dg + 8) = q1; *(LAS v4u*)(Kl + t * LD + 16 * dg) = k0; *(LAS v4u*)(Kl + t * LD + 16 * dg + 8) = k1;
                *(LAS v4u*)(Vl + t * LDV + 16 * dg) = v0; *(LAS v4u*)(Vl + t * LDV + 16 * dg + 8) = v1;
                float kf[16]; unpack16(k0, k1, kf);
#pragma unroll
                for (int i = 0; i < 16; ++i) kf[i] *= w;
                v4u p0, p1; pack16(kf, p0, p1); *(LAS v4u*)(Kp + t * LD + 16 * dg) = p0; *(LAS v4u*)(Kp + t * LD + 16 * dg + 8) = p1;
                if (wave == 0) { const float F = Fp + FLOC1[(row0 + lane) * 8 + h]; const float Gl = IG1[(row0 + lane) * 8 + h] - F; const float M = fmaxf(Mc, scan_max(Gl, lane));
                    tb[T_G2 + lane] = Gl * LOG2E; tb[T_M2 + lane] = M * LOG2E; tb[T_WI + lane] = expf(Mc - M); tb[T_EDM + lane] = expf(-(F + M)); }
            }
            __syncthreads();
            f32x16 aH = {}, aNq = {};
            {
                const LAS bf16* qb = Ql + (ttile * 32 + r) * LD + 8 * hh;
                aH = mma_nt8(aH, Sl + (vth * 32 + r) * LD + 8 * hh, qb);
                if (wave < 4) { const int stile = wave >> 1; f32x16 aP = {}; aP = mma_nt8(aP, Kl + (stile * 32 + r) * LD + 8 * hh, qb);
                    const int tq = ttile * 32 + r; const float m2 = tb[T_M2 + tq];
#pragma unroll
                    for (int g = 0; g < 4; ++g) { const int s0 = stile * 32 + 8 * g + 4 * hh; const f32x4 gg = *(const LAS f32x4*)(tb + T_G2 + s0); float pv[4];
#pragma unroll
                        for (int i = 0; i < 4; ++i) pv[i] = (s0 + i <= tq) ? aP[4 * g + i] * __builtin_amdgcn_exp2f(gg[i] - m2) : 0.f;
                        st4(Pl + tq * LDP + s0, pv[0], pv[1], pv[2], pv[3]); }
                } else if (wave < 6) { aNq = mma_nt8(aNq, Sl + (128 + r) * LD + 8 * hh, qb); }
            }
            __syncthreads();
            {
                const float wi = tb[T_WI + ttile * 32 + r];
#pragma unroll
                for (int i = 0; i < 16; ++i) aH[i] *= wi;
                const LAS bf16* pb = Pl + (ttile * 32 + r) * LDP + 8 * hh;
#pragma unroll
                for (int ks = 0; ks < 4; ++ks) aH = mfma32(tr_frag(Vl, LDV, 16 * ks, vth * 32, lane), *(const LAS bf16x8*)(pb + 16 * ks), aH);
                if (wave >= 4 && wave < 6) {
#pragma unroll
                    for (int i = 0; i < 16; ++i) aNq[i] *= wi;
#pragma unroll
                    for (int ks = 0; ks < 4; ++ks) aNq = mfma32(tr_frag(Vl, LDV, 16 * ks, 128, lane), *(const LAS bf16x8*)(pb + 16 * ks), aNq);
                    if (hh == 0) tb[T_NQ + ttile * 32 + r] = aNq[0]; }
                const float dec = expf(Mc - Mc1);
#pragma unroll
                for (int i = 0; i < 16; ++i) { S0[i] *= dec; S1[i] *= dec; SN[i] *= dec; }
#pragma unroll
                for (int ks = 0; ks < 4; ++ks) { const bf16x8 bv = tr_frag(Vl, LDV, 16 * ks, vtile * 32, lane), a0 = tr_frag(Kp, LD, 16 * ks, kt0 * 32, lane), a1 = tr_frag(Kp, LD, 16 * ks, kt0 * 32 + 32, lane);
                    S0 = mfma32(a0, bv, S0); S1 = mfma32(a1, bv, S1); }
                if (wave < 4) {
#pragma unroll
                    for (int ks = 0; ks < 4; ++ks) { const bf16x8 bn = tr_frag(Vl, LDV, 16 * ks, 128, lane), a = tr_frag(Kp, LD, 16 * ks, wave * 32, lane); SN = mfma32(a, bn, SN); } }
                ML_WRITE_SL();
            }
            __syncthreads();
            {
                const int tq = ttile * 32 + r; const float inv = 1.0f / fmaxf(fabsf(tb[T_NQ + tq]), tb[T_EDM + tq]);
#pragma unroll
                for (int g = 0; g < 4; ++g) *(LAS f32x4*)(Hst + tq * LDH + vth * 32 + 8 * g + 4 * hh) = (f32x4){aH[4 * g] * inv, aH[4 * g + 1] * inv, aH[4 * g + 2] * inv, aH[4 * g + 3] * inv};
            }
            __syncthreads();
            {
                float hv[16];
#pragma unroll
                for (int g = 0; g < 4; ++g) { const f32x4 x = *(const LAS f32x4*)(Hst + t * LDH + 16 * dg + 4 * g); hv[4 * g] = x[0]; hv[4 * g + 1] = x[1]; hv[4 * g + 2] = x[2]; hv[4 * g + 3] = x[3]; }
                const bf16* os = P1 + (row0 + t) * N1 + 2048 + h * 128 + 16 * dg; float of[16]; unpack16(*(const GAS v4u*)os, *(const GAS v4u*)(os + 8), of);
                float ss = 0.f;
#pragma unroll
                for (int i = 0; i < 16; ++i) { hv[i] *= sigmoid_f(of[i]); ss += hv[i] * hv[i]; }
                ss += __shfl_xor(ss, 1); ss += __shfl_xor(ss, 2); ss += __shfl_xor(ss, 4);
                const float rstd = rsqrtf(ss * (1.f / 128.f) + EPS);
#pragma unroll
                for (int i = 0; i < 16; ++i) hv[i] = hv[i] * rstd * p->in[I_L1HG][h * 128 + 16 * dg + i];
                v4u o0, o1; pack16(hv, o0, o1); bf16* od = CAT + (row0 + t) * 1024 + h * 128 + 16 * dg; *(GAS v4u*)od = o0; *(GAS v4u*)(od + 8) = o1;
            }
            __syncthreads();
        }
#undef ML_WRITE_SL
    }
}
}
__global__ void __launch_bounds__(NTHR, 2) fwd_kernel(KP p_unused) {
    extern __shared__ __attribute__((aligned(16))) unsigned char lds_raw[];
    LAS unsigned char* lds = (LAS unsigned char*)lds_raw;
    volatile LAS unsigned* MISC = (volatile LAS unsigned*)(lds + MISC_OFF);
    const int G = gridDim.x;
#define PH_IDS int tid = threadIdx.x; asm volatile("" : "+v"(tid)); const int lane = tid & 63, wave = __builtin_amdgcn_readfirstlane(tid >> 6); (void)lane; (void)wave;
    KPp p = kp_get();
    unsigned char* ws = p->ws;
    gu32* ctl = (gu32*)(ws + WS_CTL);
    for (int u = threadIdx.x; u < (LDS_BYTES - MISC_OFF) / 4; u += NTHR) ((LAS unsigned*)(lds + MISC_OFF))[u] = 0u;
    __syncthreads();
    const int lo = p->ph_lo, hi = p->ph_hi;
    XcdBarrier bar; bar.bar = (unsigned*)(ctl + CW_BAR); bar.x = 0; bar.st = nullptr;
    if (hi - lo > 1) bar = xcd_barrier_post((unsigned*)(ctl + CW_BAR), MISC + 8);
#define IN(k) (lo <= (k) && (k) < hi && ((p = kp_get()), (ws = p->ws), true))
#define SEAM(k) do { if (IN(k) && IN((k) + 1)) xcd_barrier(bar); } while (0)
#define H ((bf16*)(ws + WS_H))

    if (IN(0)) { PH_IDS convert_weights(p, lds, blockIdx.x * NWAVES + wave, G * NWAVES, lane, wave, false); __syncthreads();
        norm_phase<1>(p, lds, tid, lane, wave, p->in[I_X], p->in[I_L0N1G], H); }
    SEAM(0);
    if (IN(1)) { pg8::Gemm g{H, (const bf16*)(ws + WS_W0IN), MROWS, N0, 1024}; pg8::StaticOrder S; S.init(MROWS, N0, G, (int)blockIdx.x);
        pg8::EpiBf16<0> E{(bf16*)(ws + WS_R), N0, nullptr, 512, 512, attn_body::C2};
        pg8::gemm_phase<pg8::EpiBf16<0>, pg8::StaticOrder, true, true>(lds, g, S, E); }
    SEAM(1);
    if (IN(2)) { const attn_body::bf16* P0 = (const attn_body::bf16*)(ws + WS_R);
        const attn_body::AttnTensors AT{P0, P0 + 512, P0 + 1024, (attn_body::bf16*)(ws + WS_CAT), (const float*)(ws + WS_FLOC0), (const float*)(ws + WS_FTOT0)};
        const attn_body::StaticOrder S(G, (int)blockIdx.x);
        attn_body::attn_phase<attn_body::StaticOrder>((char*)lds_raw, AT, S);
        __syncthreads();
        { PH_IDS conv_phase(p, lds, tid, lane, wave); } }
    SEAM(2);
    if (IN(3)) { pg8::Gemm g{(const bf16*)(ws + WS_CAT), (const bf16*)(ws + WS_W0OUT), MROWS, 1024, 1024}; pg8::StaticOrder S; S.init(MROWS, 1024, G, (int)blockIdx.x);
        pg8::EpiRes E{p->in[I_X], p->out, 1024};
        pg8::gemm_phase<pg8::EpiRes, pg8::StaticOrder, true, true>(lds, g, S, E); }
    SEAM(3);
    if (IN(4)) { PH_IDS norm_phase<0>(p, lds, tid, lane, wave, p->out, p->in[I_L0N2G], H); }
    SEAM(4);
    if (IN(5)) { pg8::Gemm g{H, (const bf16*)(ws + WS_W0GU), MROWS, 2 * DFF, 1024}; pg8::StaticOrder S; S.init(MROWS, 2 * DFF, G, (int)blockIdx.x);
        pg8::EpiSwiGLU E{(bf16*)(ws + WS_R), DFF};
        pg8::gemm_phase<pg8::EpiSwiGLU, pg8::StaticOrder, true, true>(lds, g, S, E); }
    SEAM(5);
    if (IN(6)) { pg8::Gemm g{(const bf16*)(ws + WS_R), (const bf16*)(ws + WS_W0D), MROWS, 1024, DFF}; pg8::StaticOrder S; S.init(MROWS, 1024, G, (int)blockIdx.x);
        pg8::EpiRes E{p->out, p->out, 1024};
        pg8::gemm_phase<pg8::EpiRes, pg8::StaticOrder, true, true>(lds, g, S, E); }
    SEAM(6);
    if (IN(7)) { PH_IDS norm_phase<2>(p, lds, tid, lane, wave, p->out, p->in[I_L1N1G], H); }
    SEAM(7);
    if (IN(8)) { pg8::Gemm g{H, (const bf16*)(ws + WS_W1IN), MROWS, N1, 1024}; pg8::StaticOrder S; S.init(MROWS, N1, G, (int)blockIdx.x);
        pg8::EpiBf16<0> E{(bf16*)(ws + WS_R), N1, nullptr, 0, 0, 1.f};
        pg8::gemm_phase<pg8::EpiBf16<0>, pg8::StaticOrder, true, true>(lds, g, S, E); }
    SEAM(8);
    if (IN(9)) { PH_IDS ml::pass_a(p, lds, tid, lane, wave); }
    SEAM(9);
    if (IN(10)) { PH_IDS ml::pass_b(p, lds, tid, lane, wave); }
    SEAM(10);
    if (IN(11)) { pg8::Gemm g{(const bf16*)(ws + WS_CAT), (const bf16*)(ws + WS_W1OUT), MROWS, 1024, 1024}; pg8::StaticOrder S; S.init(MROWS, 1024, G, (int)blockIdx.x);
        pg8::EpiRes E{p->out, p->out, 1024};
        pg8::gemm_phase<pg8::EpiRes, pg8::StaticOrder, true, true>(lds, g, S, E); }
    SEAM(11);
    if (IN(12)) { PH_IDS norm_phase<3>(p, lds, tid, lane, wave, p->out, p->in[I_L1N2G], H); }
    SEAM(12);
    if (IN(13)) { PH_IDS scatter_phase(p, lds, tid, lane, wave); }
    SEAM(13);
    if (IN(14)) { pg8::Gemm g{(const bf16*)(ws + WS_AG), (const bf16*)(ws + WS_EGU), MOE_ROWS, 2 * DFFE, 1024}; pg8::MoeOrder S; S.init((const int*)(ws + WS_META), 2 * DFFE / 256, G, (int)blockIdx.x);
        pg8::EpiSwiGLU E{(bf16*)(ws + WS_ACTM), DFFE};
        pg8::gemm_phase<pg8::EpiSwiGLU, pg8::MoeOrder, true, true>(lds, g, S, E); }
    SEAM(14);
    if (IN(15)) { PH_IDS convert_weights(p, lds, blockIdx.x * NWAVES + wave, G * NWAVES, lane, wave, true); }
    SEAM(15);
    if (IN(16)) { pg8::Gemm g{(const bf16*)(ws + WS_ACTM), (const bf16*)(ws + WS_ED), MOE_ROWS, 1024, DFFE}; pg8::MoeOrder S; S.init((const int*)(ws + WS_META), 4, G, (int)blockIdx.x);
        pg8::EpiRowScale E{(float*)(ws + WS_Y), 1024, (const float*)(ws + WS_SGATE)};
        pg8::gemm_phase<pg8::EpiRowScale, pg8::MoeOrder, true, true>(lds, g, S, E); }
    SEAM(16);
    if (IN(17)) { PH_IDS final_phase(p, lane, wave); }
#undef IN
#undef SEAM
#undef H
#undef PH_IDS
}

extern "C" void kernel_launch(void* const* d_in, const int* in_sizes, int n_in, void* d_out, int out_size, void* d_ws, size_t ws_size, hipStream_t stream) {
    static int grid = 0;
    if (grid == 0) {
        if (n_in != 29 || in_sizes[0] != MROWS * DMODEL || out_size != MROWS * DMODEL || ws_size < WS_END) { fprintf(stderr, "kernel_launch: unexpected problem (n_in %d, ws %zu < %zu?)\n", n_in, ws_size, (size_t)WS_END); grid = -1; return; }
        int dev = 0, cus = 0, per_cu = 0;
        if (hipGetDevice(&dev) != hipSuccess || hipDeviceGetAttribute(&cus, hipDeviceAttributeMultiprocessorCount, dev) != hipSuccess) { grid = -1; return; }
        if (hipFuncSetAttribute((const void*)fwd_kernel, hipFuncAttributeMaxDynamicSharedMemorySize, LDS_BYTES) != hipSuccess) { fprintf(stderr, "kernel_launch: hipFuncSetAttribute failed\n"); grid = -1; return; }
        if (hipOccupancyMaxActiveBlocksPerMultiprocessor(&per_cu, (const void*)fwd_kernel, NTHR, LDS_BYTES) != hipSuccess || per_cu < 1) { fprintf(stderr, "kernel_launch: occupancy query says %d\n", per_cu); }
        (void)hipGetLastError();
        grid = cus > 256 ? 256 : cus;
    }
    if (grid < 0) return;
    (void)hipMemsetAsync((char*)d_ws + WS_CTL, 0, CTL_ZERO_BYTES, stream);
    KP a{};
    for (int i = 0; i < 29; ++i) a.in[i] = (const float*)d_in[i];
    a.out = (float*)d_out; a.ws = (unsigned char*)d_ws;
#if MK_ONE_LAUNCH
    a.ph_lo = 0; a.ph_hi = NPHASE;
    hipLaunchKernelGGL(fwd_kernel, dim3(grid), dim3(NTHR), LDS_BYTES, stream, a);
#else
    for (int ph = 0; ph < NPHASE; ++ph) { a.ph_lo = ph; a.ph_hi = ph + 1; hipLaunchKernelGGL(fwd_kernel, dim3(grid), dim3(NTHR), LDS_BYTES, stream, a); }
#endif
}
```

```cpp
#include <hip/hip_runtime.h>
#include <cstdio>
#include <cstdint>
#include <cmath>
#ifndef WGM_D
#define WGM_D 2
#endif
#ifndef WGM_M
#define WGM_M 2
#endif
#ifndef MK_ONE_LAUNCH
#define MK_ONE_LAUNCH 1
#endif
namespace pg8 {
#define PG8_LAS __attribute__((address_space(3)))
typedef unsigned short bf16_t;
typedef short bf16x8 __attribute__((ext_vector_type(8)));
typedef float f32x4 __attribute__((ext_vector_type(4)));
typedef unsigned u32x4 __attribute__((ext_vector_type(4)));
constexpr int BM = 256, BK = 64, HALF = 128, HTB = HALF * BK * 2  , STAGE_BYTES = 8 * HTB, NXCD = 8, WGM = 8, WGM_DENSE = WGM_D, WGM_MOE = WGM_M;

__host__ __device__ __forceinline__ int lds_byte(int r, int c) { const int st = (r >> 4) * 2 + (c >> 5), rr = r & 15, cc = c & 31, ob = rr * 64 + cc * 2; return st * 1024 + (ob ^ (((ob >> 9) & 1) << 5)); }
__host__ __device__ __forceinline__ void stage_rc(int b, int& R, int& C) { const int st = b / 1024, sb = b % 1024, swz = sb ^ (((sb >> 9) & 1) << 5); R = (st >> 1) * 16 + swz / 64; C = (st & 1) * 32 + (swz % 64) / 2; }
__host__ __device__ __forceinline__ int perm32(int rho) { const int n = rho >> 4, i = rho & 15; return 8 * (i >> 2) + 4 * n + (i & 3); }

struct Unit { int pm, pn, pb, pa, ps, kt0, nkt, ys; };
struct Gemm { const bf16_t* A; const bf16_t* Bt; int M, N, K; };

struct StaticOrder {
    int nM, nN, nwg, G, c;
    __host__ __device__ void init(int M, int N, int G_, int c_) { nM = M / BM; nN = N / BM; nwg = nM * nN; G = G_; c = c_; }
    __host__ __device__ bool next(int i, Unit& u) const {
        const long L = (long)i * G + c; if (L >= nwg) return false;
        int wgid = (int)L; { const int q = nwg / NXCD, r = nwg % NXCD, xcd = wgid % NXCD, off = wgid / NXCD; wgid = (xcd < r ? xcd * (q + 1) : r * (q + 1) + (xcd - r) * q) + off; }
        const int nig = WGM_DENSE * nN, gid = wgid / nig, fm = gid * WGM_DENSE, gsz = (nM - fm) < WGM_DENSE ? (nM - fm) : WGM_DENSE;
        u.pm = fm + ((wgid % nig) % gsz); u.pn = (wgid % nig) / gsz; u.pb = u.pn; u.pa = u.pm; u.ps = u.pm; u.kt0 = 0; u.nkt = 0; u.ys = -1; return true;
    }
    __device__ __forceinline__ void a_ready(const Unit&) const {}
    __device__ __forceinline__ void done(const Unit&) const {}
};

__device__ __forceinline__ unsigned cvt_pk_bf16(float lo, float hi) { unsigned r; asm volatile("v_cvt_pk_bf16_f32 %0, %1, %2" : "=v"(r) : "v"(lo), "v"(hi)); return r; }
typedef float f32x2 __attribute__((ext_vector_type(2)));
__device__ __forceinline__ f32x2 gelu_pk(f32x2 v) {
    const f32x2 av = __builtin_elementwise_abs(v), d = av * 0.2316418882f + 1.0f;
    f32x2 t; t.x = __builtin_amdgcn_rcpf(d.x); t.y = __builtin_amdgcn_rcpf(d.y);
    f32x2 q = t * 0.5307027145f + (-0.7265760135f); q = q * t + 0.7107068705f; q = q * t + (-0.142248368f); q = q * t + 0.127414796f; q = q * t;
    const f32x2 s = (v * v) * (-0.72134752044f);
    f32x2 e; e.x = __builtin_amdgcn_exp2f(s.x); e.y = __builtin_amdgcn_exp2f(s.y);
    const f32x2 m = v * (q * e), r = v - m;
    f32x2 o; o.x = v.x < 0.f ? m.x : r.x; o.y = v.y < 0.f ? m.y : r.y; return o;
}

template <int ACT  > struct EpiBf16 {
    static constexpr bool PERM = true, AFTER_DRAIN = false; static_assert(ACT == 0 || ACT == 1, "EpiBf16: ACT is 0 (none) or 1 (gelu_pk)");
    bf16_t* O; int ldc; const float* bias; int split_cols; size_t split_stride; float scale0;
    __device__ __forceinline__ void operator()(const f32x4 (&acc)[2][2][4][2], const Unit& u, int wr, int wc, int fr, int fq) const {
        const int row0 = u.pm * BM + wr * 64 + fr; int colt = u.pn * BM; bf16_t* base = O;
        float sc = 1.f; if (split_cols) { const int t = colt / split_cols; base += (size_t)t * split_stride; colt -= t * split_cols; if (t == 0) sc = scale0; }
        const int col0 = colt + wc * 32 + 8 * fq, bcol0 = u.pn * BM + wc * 32 + 8 * fq;
        f32x4 bv[2][2];
#pragma unroll
        for (int bj = 0; bj < 2; ++bj)
#pragma unroll
            for (int n = 0; n < 2; ++n) bv[bj][n] = bias ? *(const f32x4*)(bias + bcol0 + bj * HALF + 4 * n) : (f32x4){0.f, 0.f, 0.f, 0.f};
#pragma unroll
        for (int ai = 0; ai < 2; ++ai)
#pragma unroll
            for (int m = 0; m < 4; ++m) { bf16_t* rowp = base + (size_t)(row0 + ai * HALF + m * 16) * ldc + col0;
#pragma unroll
                for (int bj = 0; bj < 2; ++bj) { f32x4 v0 = acc[ai][bj][m][0] + bv[bj][0], v1 = acc[ai][bj][m][1] + bv[bj][1];
                    if (ACT == 1) { f32x2 a = gelu_pk((f32x2){v0[0], v0[1]}), b = gelu_pk((f32x2){v0[2], v0[3]}), c = gelu_pk((f32x2){v1[0], v1[1]}), d = gelu_pk((f32x2){v1[2], v1[3]});
                        v0 = (f32x4){a.x, a.y, b.x, b.y}; v1 = (f32x4){c.x, c.y, d.x, d.y}; }
                    v0 = v0 * sc; v1 = v1 * sc; u32x4 w; w.x = cvt_pk_bf16(v0[0], v0[1]); w.y = cvt_pk_bf16(v0[2], v0[3]); w.z = cvt_pk_bf16(v1[0], v1[1]); w.w = cvt_pk_bf16(v1[2], v1[3]);
                    *(u32x4*)(rowp + bj * HALF) = w; } }
    }
};
__device__ __forceinline__ float silu_f(float g) { return g * __builtin_amdgcn_rcpf(1.0f + __builtin_amdgcn_exp2f(-1.4426950408889634f * g)); }
struct EpiL0In {
    static constexpr bool PERM = true, AFTER_DRAIN = false;
    bf16_t* O; int ldc; float scale0; float* qkn;
    __device__ __forceinline__ void operator()(const f32x4 (&acc)[2][2][4][2], const Unit& u, int wr, int wc, int fr, int fq) const {
        const int row0 = u.pm * BM + wr * 64 + fr, col0 = u.pn * BM + wc * 32 + 8 * fq; const float sc = u.pn < 2 ? scale0 : 1.f;
        float mx[2][2] = {{0.f, 0.f}, {0.f, 0.f}};
#pragma unroll
        for (int ai = 0; ai < 2; ++ai)
#pragma unroll
            for (int m = 0; m < 4; ++m) { bf16_t* rowp = O + (size_t)(row0 + ai * HALF + m * 16) * ldc + col0;
#pragma unroll
                for (int bj = 0; bj < 2; ++bj) { const f32x4 v0 = acc[ai][bj][m][0] * sc, v1 = acc[ai][bj][m][1] * sc;
                    u32x4 w; w.x = cvt_pk_bf16(v0[0], v0[1]); w.y = cvt_pk_bf16(v0[2], v0[3]); w.z = cvt_pk_bf16(v1[0], v1[1]); w.w = cvt_pk_bf16(v1[2], v1[3]);
                    *(u32x4*)(rowp + bj * HALF) = w;
                    if (u.pn < 4) { float s = 0.f;
#pragma unroll
                        for (int e = 0; e < 4; ++e) { const float lo = __uint_as_float(w[e] << 16), hi = __uint_as_float(w[e] & 0xffff0000u); s += lo * lo + hi * hi; }
                        s += __shfl_xor(s, 16); s += __shfl_xor(s, 32); mx[ai][bj] = fmaxf(mx[ai][bj], s); } } }
        if (u.pn < 4) {
#pragma unroll
            for (int ai = 0; ai < 2; ++ai)
#pragma unroll
                for (int bj = 0; bj < 2; ++bj) { float v = mx[ai][bj]; v = fmaxf(v, __shfl_xor(v, 1)); v = fmaxf(v, __shfl_xor(v, 2)); v = fmaxf(v, __shfl_xor(v, 4)); v = fmaxf(v, __shfl_xor(v, 8));
                    if (fr == 0 && fq == 0) qkn[(((size_t)(u.pn >> 1) * 256 + 4 * u.pm + 2 * ai + wr) * 8 + 4 * (u.pn & 1) + 2 * bj + (wc >> 1)) * 2 + (wc & 1)] = v; } }
    }
};
template <bool BASEF> struct EpiRes {
    static constexpr bool PERM = true, AFTER_DRAIN = false;
    const void* base; bf16_t* out; int ldc; float* rowss;
    __device__ __forceinline__ void operator()(const f32x4 (&acc)[2][2][4][2], const Unit& u, int wr, int wc, int fr, int fq) const {
        const int row0 = u.pm * BM + wr * 64 + fr, col0 = u.pn * BM + wc * 32 + 8 * fq;
#pragma unroll
        for (int ai = 0; ai < 2; ++ai)
#pragma unroll
            for (int m = 0; m < 4; ++m) { const size_t off = (size_t)(row0 + ai * HALF + m * 16) * ldc + col0; float ssq = 0.f;
#pragma unroll
                for (int bj = 0; bj < 2; ++bj) { f32x4 b0, b1;
                    if (BASEF) { b0 = *(const f32x4*)((const float*)base + off + bj * HALF); b1 = *(const f32x4*)((const float*)base + off + bj * HALF + 4); }
                    else { const u32x4 x = *(const u32x4*)((const bf16_t*)base + off + bj * HALF);
                        b0 = (f32x4){__uint_as_float(x.x << 16), __uint_as_float(x.x & 0xffff0000u), __uint_as_float(x.y << 16), __uint_as_float(x.y & 0xffff0000u)};
                        b1 = (f32x4){__uint_as_float(x.z << 16), __uint_as_float(x.z & 0xffff0000u), __uint_as_float(x.w << 16), __uint_as_float(x.w & 0xffff0000u)}; }
                    const f32x4 v0 = b0 + acc[ai][bj][m][0], v1 = b1 + acc[ai][bj][m][1];
                    u32x4 w; w.x = cvt_pk_bf16(v0[0], v0[1]); w.y = cvt_pk_bf16(v0[2], v0[3]); w.z = cvt_pk_bf16(v1[0], v1[1]); w.w = cvt_pk_bf16(v1[2], v1[3]);
                    *(u32x4*)(out + off + bj * HALF) = w;
                    if (rowss) {
#pragma unroll
                        for (int e = 0; e < 4; ++e) { const float lo = __uint_as_float(w[e] << 16), hi = __uint_as_float(w[e] & 0xffff0000u); ssq += lo * lo + hi * hi; } } }
                if (rowss) { ssq += __shfl_xor(ssq, 16); ssq += __shfl_xor(ssq, 32); if (fq == 0) rowss[(size_t)(row0 + ai * HALF + m * 16) * 16 + 4 * u.pn + wc] = ssq; } }
    }
};
struct EpiSwiGLU {
    static constexpr bool PERM = true, AFTER_DRAIN = false;
    bf16_t* O; int ldo; const float* rowss;
    __device__ __forceinline__ void operator()(const f32x4 (&acc)[2][2][4][2], const Unit& u, int wr, int wc, int fr, int fq) const {
        const int row0 = u.pm * BM + wr * 64 + fr, col0 = u.pn * HALF + wc * 32 + 8 * fq;
#pragma unroll
        for (int ai = 0; ai < 2; ++ai)
#pragma unroll
            for (int m = 0; m < 4; ++m) { bf16_t* rowp = O + (size_t)(row0 + ai * HALF + m * 16) * ldo + col0;
                float rs = 1.f; if (rowss) { const f32x4* q = (const f32x4*)(rowss + (size_t)(row0 + ai * HALF + m * 16) * 16); const f32x4 a = q[0], b = q[1], c = q[2], d = q[3];
                    rs = rsqrtf((((a[0] + a[1]) + (a[2] + a[3])) + ((b[0] + b[1]) + (b[2] + b[3])) + ((c[0] + c[1]) + (c[2] + c[3])) + ((d[0] + d[1]) + (d[2] + d[3]))) * (1.f / 1024.f) + 1e-6f); }
                const f32x4 g0 = acc[ai][0][m][0] * rs, g1 = acc[ai][0][m][1] * rs, u0 = acc[ai][1][m][0] * rs, u1 = acc[ai][1][m][1] * rs;
                u32x4 w; w.x = cvt_pk_bf16(silu_f(g0[0]) * u0[0], silu_f(g0[1]) * u0[1]); w.y = cvt_pk_bf16(silu_f(g0[2]) * u0[2], silu_f(g0[3]) * u0[3]);
                w.z = cvt_pk_bf16(silu_f(g1[0]) * u1[0], silu_f(g1[1]) * u1[1]); w.w = cvt_pk_bf16(silu_f(g1[2]) * u1[2], silu_f(g1[3]) * u1[3]);
                *(u32x4*)rowp = w; }
    }
};
__device__ __forceinline__ unsigned pk4_fp8(float a, float b, float c, float d) {
    a = __builtin_amdgcn_fmed3f(a, -448.f, 448.f); b = __builtin_amdgcn_fmed3f(b, -448.f, 448.f); c = __builtin_amdgcn_fmed3f(c, -448.f, 448.f); d = __builtin_amdgcn_fmed3f(d, -448.f, 448.f);
    unsigned w = 0u; w = __builtin_amdgcn_cvt_pk_fp8_f32(a, b, w, false); w = __builtin_amdgcn_cvt_pk_fp8_f32(c, d, w, true); return w;
}
struct EpiSwiGLU8 {
    static constexpr bool PERM = true, AFTER_DRAIN = false;
    unsigned char* O; int ldo; float si, so;
    __device__ __forceinline__ void operator()(const f32x4 (&acc)[2][2][4][2], const Unit& u, int wr, int wc, int fr, int fq) const {
        typedef unsigned u32x2 __attribute__((ext_vector_type(2)));
        const int row0 = u.pm * BM + wr * 64 + fr, col0 = u.pn * HALF + wc * 32 + 8 * fq; const float s2 = si * so;
#pragma unroll
        for (int ai = 0; ai < 2; ++ai)
#pragma unroll
            for (int m = 0; m < 4; ++m) { const unsigned off_ = (unsigned)((row0 + ai * HALF + m * 16) * ldo + col0);
                const f32x4 g0 = acc[ai][0][m][0] * si, g1 = acc[ai][0][m][1] * si, u0 = acc[ai][1][m][0] * s2, u1 = acc[ai][1][m][1] * s2;
                u32x2 w; w.x = pk4_fp8(silu_f(g0[0]) * u0[0], silu_f(g0[1]) * u0[1], silu_f(g0[2]) * u0[2], silu_f(g0[3]) * u0[3]);
                w.y = pk4_fp8(silu_f(g1[0]) * u1[0], silu_f(g1[1]) * u1[1], silu_f(g1[2]) * u1[2], silu_f(g1[3]) * u1[3]);
                asm volatile("global_store_dwordx2 %0, %1, %2 sc1" :: "v"(off_), "v"(w), "s"(O) : "memory"); }
    }
};
struct EpiRowScale {
    static constexpr bool PERM = true, AFTER_DRAIN = false;
    bf16_t* Y; int ldc; const float* rs; float mul; bf16_t* YS;
    __device__ __forceinline__ void operator()(const f32x4 (&acc)[2][2][4][2], const Unit& u, int wr, int wc, int fr, int fq) const {
        const int row0 = u.pm * BM + wr * 64 + fr, col0 = u.pn * BM + wc * 32 + 8 * fq;
        bf16_t* const yb = u.ys < 0 ? Y : YS + ((long)u.ys * 2048 - 128 * BM) * (long)ldc;
#pragma unroll
        for (int ai = 0; ai < 2; ++ai)
#pragma unroll
            for (int m = 0; m < 4; ++m) { const int row = row0 + ai * HALF + m * 16; const float s = rs[row + (u.ps - u.pm) * BM] * mul;
                bf16_t* rowp = yb + (size_t)row * ldc + col0;
#pragma unroll
                for (int bj = 0; bj < 2; ++bj) { const f32x4 v0 = acc[ai][bj][m][0] * s, v1 = acc[ai][bj][m][1] * s;
                    u32x4 w; w.x = cvt_pk_bf16(v0[0], v0[1]); w.y = cvt_pk_bf16(v0[2], v0[3]); w.z = cvt_pk_bf16(v1[0], v1[1]); w.w = cvt_pk_bf16(v1[2], v1[3]);
                    *(u32x4*)(rowp + bj * HALF) = w; } }
    }
};
struct MoeOrder {
    int nM, nN, nwg, G, c; int ct[9]; bool sparseA; mutable int prev = -1; unsigned* ready;
    __device__ __forceinline__ void init(const unsigned* cnt, int nN_, int G_, int c_, bool sparseA_, unsigned* ready_ = nullptr) { int acc = 0; ready = ready_;
#pragma unroll
        for (int e = 0; e < 8; ++e) { ct[e] = acc; acc += (int)((__builtin_amdgcn_readfirstlane((int)cnt[32 * e]) + 255) >> 8); }
        ct[8] = acc; nM = acc; nN = nN_; nwg = nM * nN; G = G_; c = c_; sparseA = sparseA_; }
    __device__ bool next(int i, Unit& u) const {
        const long L = (long)i * G + c; if (L >= nwg) return false;
        int wgid = (int)L; { const int q = nwg / NXCD, r = nwg % NXCD, xcd = wgid % NXCD, off = wgid / NXCD; wgid = (xcd < r ? xcd * (q + 1) : r * (q + 1) + (xcd - r) * q) + off; }
        const int nig = WGM_MOE * nN, gid = wgid / nig, fm = gid * WGM_MOE, gsz = (nM - fm) < WGM_MOE ? (nM - fm) : WGM_MOE;
        int pm = fm + ((wgid % nig) % gsz), pn = (wgid % nig) / gsz;
        pm = __builtin_amdgcn_readfirstlane(pm); pn = __builtin_amdgcn_readfirstlane(pn);
        int e = 0, cte = 0;
#pragma unroll
        for (int k = 1; k < 8; ++k) if (pm >= ct[k]) { e = k; cte = ct[k]; }
        u.pm = pm; u.pn = pn; u.pb = e * nN + pn; u.ps = 64 * e + (pm - cte); u.pa = sparseA ? u.ps : pm; u.kt0 = 0; u.nkt = 0; u.ys = -1; return true;
    }
    __device__ __forceinline__ void a_ready(const Unit&, bool) const {}
    __device__ __forceinline__ void publish(int pm) const { unsigned* const a = ready + 32 * pm; unsigned long long sv; unsigned t0, t1;
        asm volatile("s_mov_b64 %0, exec\n\ts_mov_b64 exec, 1\n\tv_mov_b32 %1, 0\n\tv_mov_b32 %2, 1\n\tglobal_atomic_add %1, %2, %3 sc1\n\ts_mov_b64 exec, %0" : "=&s"(sv), "=&v"(t0), "=&v"(t1) : "s"(a) : "memory"); }
    __device__ __forceinline__ void done(const Unit& u) const { if (ready) { if (prev >= 0) publish(prev); prev = u.pm; } }
    __device__ __forceinline__ void flush() const { if (ready && prev >= 0) { publish(prev); prev = -1; } }
};
struct MoeDownOrder {
    int nM, nF, G, c, r12, E, Sl, F, myfull; int ct[9]; const unsigned* ready;
    __device__ __forceinline__ void init(const unsigned* cnt, int G_, int c_, const unsigned* ready_) { int acc = 0;
#pragma unroll
        for (int e = 0; e < 8; ++e) { ct[e] = acc; acc += (int)((__builtin_amdgcn_readfirstlane((int)cnt[32 * e]) + 255) >> 8); }
        ct[8] = acc; nM = acc; nF = nM < 128 ? nM : 128; G = G_; c = c_; ready = ready_;
        int cv = c_, Gv = G_, nv = nM * 28, Fv = nF * 4; asm volatile("" : "+v"(cv), "+v"(Gv), "+v"(nv), "+v"(Fv));
        r12 = ready_ ? __builtin_amdgcn_readfirstlane(nv % Gv) : 0; E = G - r12; Sl = (nM - nF) * 28; F = nF * 4; myfull = __builtin_amdgcn_readfirstlane(cv < Fv ? (Fv - cv + Gv - 1) / Gv : 0); }
    __device__ __forceinline__ bool next(int i, Unit& u) const {
        int pm, pn, kt0 = 0, nkt = 0, ys = -1;
        if (i < myfull) { const int L = i * G + c; const int nwg = F; int wgid = L; { const int q = nwg / NXCD, r = nwg % NXCD, xcd = wgid % NXCD, off = wgid / NXCD; wgid = (xcd < r ? xcd * (q + 1) : r * (q + 1) + (xcd - r) * q) + off; }
            const int nig = WGM_MOE * 4, gid = wgid / nig, fm = gid * WGM_MOE, gsz = (nF - fm) < WGM_MOE ? (nF - fm) : WGM_MOE;
            pm = fm + ((wgid % nig) % gsz); pn = (wgid % nig) / gsz; }
        else { const int j = i - myfull; int s;
            if (c >= r12) s = j == 0 ? c - r12 : E + (j - 1) * G + c; else s = E + j * G + c;
            if (s >= Sl) return false; const int rem = s % 28; pm = nF + s / 28; pn = rem / 7; ys = rem % 7; kt0 = 4 * ys; nkt = 4; }
        pm = __builtin_amdgcn_readfirstlane(pm); pn = __builtin_amdgcn_readfirstlane(pn);
        int e = 0, cte = 0;
#pragma unroll
        for (int k = 1; k < 8; ++k) if (pm >= ct[k]) { e = k; cte = ct[k]; }
        Unit r; r.pm = pm; r.pn = pn; r.pb = e * 4 + pn; r.ps = 64 * e + (pm - cte); r.pa = pm;
        r.kt0 = __builtin_amdgcn_readfirstlane(kt0); r.nkt = __builtin_amdgcn_readfirstlane(nkt); r.ys = __builtin_amdgcn_readfirstlane(ys); u = r; return true;
    }
    __device__ __forceinline__ void a_ready(const Unit& u, bool w0) const {
        if (ready) {
            if (w0) { unsigned sp = 0u;
                while ((unsigned)__builtin_amdgcn_readfirstlane((int)__hip_atomic_load(ready + 32 * u.pm, __ATOMIC_RELAXED, __HIP_MEMORY_SCOPE_AGENT)) < 224u) { __builtin_amdgcn_s_sleep(2); if (++sp > (1u << 21)) break; }
            }
            asm volatile("" ::: "memory"); __builtin_amdgcn_s_barrier(); asm volatile("" ::: "memory");
        }
    }
    __device__ __forceinline__ void flush() const {}
    __device__ __forceinline__ void done(const Unit&) const {}
};
template <class Epi, class Sched, bool ALIGN_EPI = false, bool SP2 = false>
__device__ __forceinline__ void gemm_phase(PG8_LAS unsigned char* lds, const Gemm g, const Sched& S, const Epi& E) {
    int tid = threadIdx.x; asm volatile("" : "+v"(tid));
    const int wid = __builtin_amdgcn_readfirstlane(tid >> 6), lane = tid & 63, wr = wid >> 2, wc = wid & 3, fr = lane & 15, fq = lane >> 4;
    const int K = g.K, nt = K / BK;
    unsigned voffA[2], voffB[2];
#pragma unroll
    for (int i = 0; i < 2; ++i) { int R, C; stage_rc(tid * 16 + i * 8192, R, C); const int Rb = Epi::PERM ? ((R & ~31) + perm32(R & 31)) : R;
        voffA[i] = (unsigned)(R * K + C) * 2u; voffB[i] = (unsigned)(Rb * K + C) * 2u; }
    const size_t kstep = (size_t)(BK * 2);
    const size_t hstep = (size_t)HALF * K * 2;
    const size_t tstep = 2 * hstep;
    const unsigned ldsw = (unsigned)wid * 1024u; const unsigned ldsbase = (unsigned)__builtin_amdgcn_readfirstlane((int)((unsigned)(uintptr_t)lds + ldsw));
    const int aoff = lds_byte(wr * 64 + fr, fq * 8), boff = lds_byte(wc * 32 + fr, fq * 8);
#define PG8_SA(b, h) (((b) * 2 + (h)) * HTB)
#define PG8_SB(b, h) ((4 + (b) * 2 + (h)) * HTB)
#define PG8_STAGE(bufoff, gbase, voff) do { _Pragma("unroll") for (int _i = 0; _i < 2; ++_i) { unsigned keep_; \
        asm volatile("s_mov_b32 %0, m0\n\ts_mov_b32 m0, %3\n\ts_nop 0\n\tglobal_load_lds_dwordx4 %1, %2\n\ts_mov_b32 m0, %0" : "=&s"(keep_) : "v"((voff)[_i]), "s"((const char*)(gbase)), "s"(ldsbase + (unsigned)((bufoff) + _i * 8192)) : "memory"); } } while (0)
#define PG8_LDA(dst, b, h) do { _Pragma("unroll") for (int m = 0; m < 4; ++m) _Pragma("unroll") for (int k = 0; k < 2; ++k) dst[m][k] = *(const PG8_LAS bf16x8*)(lds + PG8_SA(b, h) + aoff + m * 2048 + k * 1024); } while (0)
#define PG8_LDB(dst, b, h) do { _Pragma("unroll") for (int n = 0; n < 2; ++n) _Pragma("unroll") for (int k = 0; k < 2; ++k) dst[n][k] = *(const PG8_LAS bf16x8*)(lds + PG8_SB(b, h) + boff + n * 2048 + k * 1024); } while (0)
#define PG8_MMA(ai, bj, At, Bt) do { __builtin_amdgcn_s_setprio(1); _Pragma("unroll") for (int m = 0; m < 4; ++m) _Pragma("unroll") for (int n = 0; n < 2; ++n) _Pragma("unroll") for (int k = 0; k < 2; ++k) \
        acc[ai][bj][m][n] = __builtin_amdgcn_mfma_f32_16x16x32_bf16(Bt[n][k], At[m][k], acc[ai][bj][m][n], 0, 0, 0); __builtin_amdgcn_s_setprio(0); } while (0)
#define PG8_WAIT_V(n) asm volatile("s_waitcnt vmcnt(" #n ")" ::: "memory")
#define PG8_WAIT_L(n) asm volatile("s_waitcnt lgkmcnt(" #n ")" ::: "memory")
#define PG8_BAR __builtin_amdgcn_s_barrier()
#define PG8_SCHED __builtin_amdgcn_sched_barrier(0)
    Unit cur, nxt; int ui = 0;
    if (!S.next(0, cur)) return;
    f32x4 acc[2][2][4][2];
#pragma unroll
    for (int a = 0; a < 2; ++a)
#pragma unroll
        for (int b = 0; b < 2; ++b)
#pragma unroll
            for (int m = 0; m < 4; ++m)
#pragma unroll
                for (int n = 0; n < 2; ++n) acc[a][b][m][n] = (f32x4){0.f, 0.f, 0.f, 0.f};
    bf16x8 At[4][2], B0[2][2], B1[2][2];
    const char* cA = (const char*)g.A + (size_t)cur.pa * tstep; const char* cB = (const char*)g.Bt + (size_t)cur.pb * tstep;
    S.a_ready(cur);
    if constexpr (SP2) {
        PG8_STAGE(PG8_SB(0, 0), cB, voffB); PG8_STAGE(PG8_SB(0, 1), cB + hstep, voffB); PG8_STAGE(PG8_SA(0, 0), cA, voffA); PG8_STAGE(PG8_SA(0, 1), cA + hstep, voffA);
        if (wr == 1) PG8_BAR;
        PG8_WAIT_V(2); PG8_BAR;
        PG8_STAGE(PG8_SB(1, 0), cB + kstep, voffB); PG8_STAGE(PG8_SA(1, 0), cA + kstep, voffA); PG8_STAGE(PG8_SB(1, 1), cB + hstep + kstep, voffB);
        PG8_WAIT_V(6); PG8_BAR;
    } else {
        PG8_STAGE(PG8_SB(0, 0), cB, voffB); PG8_STAGE(PG8_SA(0, 0), cA, voffA); PG8_STAGE(PG8_SB(0, 1), cB + hstep, voffB); PG8_STAGE(PG8_SA(0, 1), cA + hstep, voffA);
        if (wr == 1) PG8_BAR;
        PG8_WAIT_V(4); PG8_BAR;
        PG8_STAGE(PG8_SB(1, 0), cB + kstep, voffB); PG8_STAGE(PG8_SA(1, 0), cA + kstep, voffA); PG8_STAGE(PG8_SB(1, 1), cB + hstep + kstep, voffB);
        PG8_WAIT_V(6); PG8_BAR;
    }
    for (;;) {
        const bool has_next = S.next(ui + 1, nxt);
        const char* nA = has_next ? (const char*)g.A + (size_t)nxt.pa * tstep : cA; const char* nB = has_next ? (const char*)g.Bt + (size_t)nxt.pb * tstep : cB;
        for (int t = 0; t < nt; t += 2) {
            const bool last = (t == nt - 2);
            const char* a1 = cA + (size_t)(t + 1) * kstep;
            const char* a2 = last ? nA : cA + (size_t)(t + 2) * kstep; const char* b2 = last ? nB : cB + (size_t)(t + 2) * kstep;
            const char* a3 = a2 + kstep; const char* b3 = b2 + kstep;
            if (last && has_next) S.a_ready(nxt);
            if constexpr (SP2) {
            PG8_LDB(B0, 0, 0); PG8_LDB(B1, 0, 1); PG8_SCHED; PG8_LDA(At, 0, 0); PG8_STAGE(PG8_SA(1, 1), a1 + hstep, voffA);
            PG8_WAIT_V(8); PG8_WAIT_L(0); PG8_BAR; PG8_MMA(0, 0, At, B0); PG8_MMA(0, 1, At, B1); PG8_BAR; PG8_SCHED;
            PG8_LDA(At, 0, 1); PG8_STAGE(PG8_SB(0, 0), b2, voffB); PG8_STAGE(PG8_SB(0, 1), b2 + hstep, voffB); PG8_STAGE(PG8_SA(0, 0), a2, voffA);
            PG8_WAIT_V(8); PG8_WAIT_L(0); PG8_BAR; PG8_MMA(1, 0, At, B0); PG8_MMA(1, 1, At, B1); PG8_BAR; PG8_SCHED;
            PG8_LDB(B0, 1, 0); PG8_LDB(B1, 1, 1); PG8_SCHED; PG8_LDA(At, 1, 0); PG8_STAGE(PG8_SA(0, 1), a2 + hstep, voffA);
            PG8_WAIT_V(8); PG8_WAIT_L(0); PG8_BAR; PG8_MMA(0, 0, At, B0); PG8_MMA(0, 1, At, B1); PG8_BAR; PG8_SCHED;
            PG8_LDA(At, 1, 1); PG8_STAGE(PG8_SB(1, 0), b3, voffB); PG8_STAGE(PG8_SB(1, 1), b3 + hstep, voffB); PG8_STAGE(PG8_SA(1, 0), a3, voffA);
            PG8_WAIT_V(8); PG8_WAIT_L(0); PG8_BAR; PG8_MMA(1, 0, At, B0); PG8_MMA(1, 1, At, B1); PG8_BAR; PG8_SCHED;
            } else {
            PG8_LDB(B0, 0, 0); PG8_SCHED; PG8_LDA(At, 0, 0); PG8_STAGE(PG8_SA(1, 1), a1 + hstep, voffA);
            PG8_WAIT_L(8); PG8_BAR; PG8_WAIT_L(0); PG8_MMA(0, 0, At, B0); PG8_BAR; PG8_SCHED;
            PG8_LDB(B1, 0, 1); PG8_STAGE(PG8_SB(0, 0), b2, voffB);
            PG8_BAR; PG8_WAIT_L(0); PG8_MMA(0, 1, At, B1); PG8_BAR;
            PG8_LDA(At, 0, 1); PG8_STAGE(PG8_SA(0, 0), a2, voffA);
            PG8_BAR; PG8_WAIT_L(0); PG8_MMA(1, 0, At, B0); PG8_BAR; PG8_SCHED;
            PG8_STAGE(PG8_SB(0, 1), b2 + hstep, voffB);
            PG8_WAIT_V(6); PG8_BAR; PG8_MMA(1, 1, At, B1); PG8_BAR;
            PG8_LDB(B0, 1, 0); PG8_SCHED; PG8_LDA(At, 1, 0); PG8_STAGE(PG8_SA(0, 1), a2 + hstep, voffA);
            PG8_WAIT_L(8); PG8_BAR; PG8_WAIT_L(0); PG8_MMA(0, 0, At, B0); PG8_BAR; PG8_SCHED;
            PG8_LDB(B1, 1, 1); PG8_STAGE(PG8_SB(1, 0), b3, voffB);
            PG8_BAR; PG8_WAIT_L(0); PG8_MMA(0, 1, At, B1); PG8_BAR;
            PG8_LDA(At, 1, 1); PG8_STAGE(PG8_SA(1, 0), a3, voffA);
            PG8_BAR; PG8_WAIT_L(0); PG8_MMA(1, 0, At, B0); PG8_BAR; PG8_SCHED;
            PG8_STAGE(PG8_SB(1, 1), b3 + hstep, voffB);
            PG8_WAIT_V(6); PG8_BAR; PG8_MMA(1, 1, At, B1); PG8_BAR;
            }
        }
        if constexpr (ALIGN_EPI) { if (wr == 0) PG8_BAR; }
        if constexpr (!Epi::AFTER_DRAIN) { E(acc, cur, wr, wc, fr, fq); S.done(cur); }
        if (!has_next) break;
#pragma unroll
        for (int a = 0; a < 2; ++a)
#pragma unroll
            for (int b = 0; b < 2; ++b)
#pragma unroll
                for (int m = 0; m < 4; ++m)
#pragma unroll
                    for (int n = 0; n < 2; ++n) acc[a][b][m][n] = (f32x4){0.f, 0.f, 0.f, 0.f};
        cur = nxt; cA = nA; cB = nB; ++ui;
        if constexpr (ALIGN_EPI) { if (wr == 1) PG8_BAR; }
    }
    PG8_WAIT_V(0);
    if constexpr (!ALIGN_EPI) { if (wr == 0) PG8_BAR; }
    PG8_BAR;
    if constexpr (Epi::AFTER_DRAIN) { E.fused(acc, cur, wr, wc, fr, fq, lds, wid, lane); S.done(cur); }
#undef PG8_SA
#undef PG8_SB
#undef PG8_STAGE
#undef PG8_LDA
#undef PG8_LDB
#undef PG8_MMA
#undef PG8_WAIT_V
#undef PG8_WAIT_L
#undef PG8_BAR
#undef PG8_SCHED
}
typedef int i32x4 __attribute__((ext_vector_type(4)));
typedef int i32x8 __attribute__((ext_vector_type(8)));
struct Gemm8 { const unsigned char* A; const unsigned char* Bt; int M, N, K; };
template <class Epi, class Sched, bool ALIGN_EPI = false, bool SP2 = false>
__device__ __forceinline__ void gemm_phase_f8(PG8_LAS unsigned char* lds, const Gemm8 g, const Sched& S, const Epi& E) {
    int tid = threadIdx.x; asm volatile("" : "+v"(tid));
    const int wid = __builtin_amdgcn_readfirstlane(tid >> 6), lane = tid & 63, wr = wid >> 2, wc = wid & 3, fr = lane & 15, fq = lane >> 4;
    const int K = g.K, nt = K / 128;
    unsigned voffA[2], voffB[2];
#pragma unroll
    for (int i = 0; i < 2; ++i) { int R, C; stage_rc(tid * 16 + i * 8192, R, C); const int Rb = Epi::PERM ? ((R & ~31) + perm32(R & 31)) : R;
        voffA[i] = (unsigned)(R * K + 2 * C); voffB[i] = (unsigned)(Rb * K + 2 * C); }
    const size_t kstep = (size_t)(BK * 2);
    const size_t hstep = (size_t)HALF * K;
    const size_t tstep = 2 * hstep;
    const unsigned ldsw = (unsigned)wid * 1024u; const unsigned ldsbase = (unsigned)__builtin_amdgcn_readfirstlane((int)((unsigned)(uintptr_t)lds + ldsw));
    const int aoff0 = lds_byte(wr * 64 + fr, fq * 8), boff0 = lds_byte(wc * 32 + fr, fq * 8);
#define PG8_SA(b, h) (((b) * 2 + (h)) * HTB)
#define PG8_SB(b, h) ((4 + (b) * 2 + (h)) * HTB)
#define PG8_STAGE(bufoff, gbase, voff) do { _Pragma("unroll") for (int _i = 0; _i < 2; ++_i) { unsigned keep_; \
        asm volatile("s_mov_b32 %0, m0\n\ts_mov_b32 m0, %3\n\ts_nop 0\n\tglobal_load_lds_dwordx4 %1, %2\n\ts_mov_b32 m0, %0" : "=&s"(keep_) : "v"((voff)[_i]), "s"((const char*)(gbase)), "s"(ldsbase + (unsigned)((bufoff) + _i * 8192)) : "memory"); } } while (0)
#define PG8_LD8(dst, off) do { const i32x4 lo_ = *(const PG8_LAS i32x4*)(lds + (off)), hi_ = *(const PG8_LAS i32x4*)(lds + (off) + 1024); dst = __builtin_shufflevector(lo_, hi_, 0, 1, 2, 3, 4, 5, 6, 7); } while (0)
#define PG8_LDA(dst, b, h) do { _Pragma("unroll") for (int m = 0; m < 4; ++m) PG8_LD8(dst[m], PG8_SA(b, h) + aoff + m * 2048); } while (0)
#define PG8_LDB(dst, b, h) do { _Pragma("unroll") for (int n = 0; n < 2; ++n) PG8_LD8(dst[n], PG8_SB(b, h) + boff + n * 2048); } while (0)
#define PG8_MMA(ai, bj, At, Bt) do { __builtin_amdgcn_s_setprio(1); _Pragma("unroll") for (int m = 0; m < 4; ++m) { \
        f32x4 c0_ = __builtin_shufflevector(acc8[ai][bj][m], acc8[ai][bj][m], 0, 1, 2, 3), c1_ = __builtin_shufflevector(acc8[ai][bj][m], acc8[ai][bj][m], 4, 5, 6, 7); \
        c0_ = __builtin_amdgcn_mfma_scale_f32_16x16x128_f8f6f4(Bt[0], At[m], c0_, 0, 0, 0, 0x7F7F7F7F, 0, 0x7F7F7F7F); c1_ = __builtin_amdgcn_mfma_scale_f32_16x16x128_f8f6f4(Bt[1], At[m], c1_, 0, 0, 0, 0x7F7F7F7F, 0, 0x7F7F7F7F); \
        acc8[ai][bj][m] = __builtin_shufflevector(c0_, c1_, 0, 1, 2, 3, 4, 5, 6, 7); } __builtin_amdgcn_s_setprio(0); } while (0)
#define PG8_WAIT_V(n) asm volatile("s_waitcnt vmcnt(" #n ")" ::: "memory")
#define PG8_WAIT_L(n) asm volatile("s_waitcnt lgkmcnt(" #n ")" ::: "memory")
#define PG8_BAR __builtin_amdgcn_s_barrier()
#define PG8_SCHED __builtin_amdgcn_sched_barrier(0)
    Unit cur, nxt; int ui = 0;
    if (!S.next(0, cur)) return;
    typedef float f32x8 __attribute__((ext_vector_type(8)));
    f32x8 acc8[2][2][4];
#pragma unroll
    for (int a = 0; a < 2; ++a)
#pragma unroll
        for (int b = 0; b < 2; ++b)
#pragma unroll
            for (int m = 0; m < 4; ++m) acc8[a][b][m] = (f32x8){0.f, 0.f, 0.f, 0.f, 0.f, 0.f, 0.f, 0.f};
    i32x8 At[4], B0[2], B1[2];
    const char* cA = (const char*)g.A + (size_t)cur.pa * tstep + (size_t)__builtin_amdgcn_readfirstlane(cur.kt0) * kstep; const char* cB = (const char*)g.Bt + (size_t)cur.pb * tstep + (size_t)__builtin_amdgcn_readfirstlane(cur.kt0) * kstep;
    S.a_ready(cur, wid == 0);
    if constexpr (SP2) {
        PG8_STAGE(PG8_SB(0, 0), cB, voffB); PG8_STAGE(PG8_SB(0, 1), cB + hstep, voffB); PG8_STAGE(PG8_SA(0, 0), cA, voffA); PG8_STAGE(PG8_SA(0, 1), cA + hstep, voffA);
        if (wr == 1) PG8_BAR;
        PG8_WAIT_V(2); PG8_BAR;
        PG8_STAGE(PG8_SB(1, 0), cB + kstep, voffB); PG8_STAGE(PG8_SA(1, 0), cA + kstep, voffA); PG8_STAGE(PG8_SB(1, 1), cB + hstep + kstep, voffB);
        PG8_WAIT_V(6); PG8_BAR;
    } else {
        PG8_STAGE(PG8_SB(0, 0), cB, voffB); PG8_STAGE(PG8_SA(0, 0), cA, voffA); PG8_STAGE(PG8_SB(0, 1), cB + hstep, voffB); PG8_STAGE(PG8_SA(0, 1), cA + hstep, voffA);
        if (wr == 1) PG8_BAR;
        PG8_WAIT_V(4); PG8_BAR;
        PG8_STAGE(PG8_SB(1, 0), cB + kstep, voffB); PG8_STAGE(PG8_SA(1, 0), cA + kstep, voffA); PG8_STAGE(PG8_SB(1, 1), cB + hstep + kstep, voffB);
        PG8_WAIT_V(6); PG8_BAR;
    }
    for (;;) {
        const bool has_next = S.next(ui + 1, nxt);
        const char* nA = has_next ? (const char*)g.A + (size_t)nxt.pa * tstep + (size_t)__builtin_amdgcn_readfirstlane(nxt.kt0) * kstep : cA; const char* nB = has_next ? (const char*)g.Bt + (size_t)nxt.pb * tstep + (size_t)__builtin_amdgcn_readfirstlane(nxt.kt0) * kstep : cB;
        const int ntc = __builtin_amdgcn_readfirstlane(cur.nkt ? cur.nkt : nt);
#pragma unroll 1
        for (int t = 0; t < ntc; t += 2) {
            int aoff = aoff0, boff = boff0; asm volatile("" : "+v"(aoff), "+v"(boff));
            const bool last = (t == ntc - 2);
            const char* a1 = cA + (size_t)(t + 1) * kstep;
            const char* a2 = last ? nA : cA + (size_t)(t + 2) * kstep; const char* b2 = last ? nB : cB + (size_t)(t + 2) * kstep;
            const char* a3 = a2 + kstep; const char* b3 = b2 + kstep;
            if (last && has_next) S.a_ready(nxt, wid == 0);
            if constexpr (SP2) {
            PG8_LDB(B0, 0, 0); PG8_LDB(B1, 0, 1); PG8_SCHED; PG8_LDA(At, 0, 0); PG8_STAGE(PG8_SA(1, 1), a1 + hstep, voffA);
            PG8_WAIT_V(8); PG8_WAIT_L(0); PG8_BAR; PG8_MMA(0, 0, At, B0); PG8_MMA(0, 1, At, B1); PG8_BAR; PG8_SCHED;
            PG8_LDA(At, 0, 1); PG8_STAGE(PG8_SB(0, 0), b2, voffB); PG8_STAGE(PG8_SB(0, 1), b2 + hstep, voffB); PG8_STAGE(PG8_SA(0, 0), a2, voffA);
            PG8_WAIT_V(8); PG8_WAIT_L(0); PG8_BAR; PG8_MMA(1, 0, At, B0); PG8_MMA(1, 1, At, B1); PG8_BAR; PG8_SCHED;
            PG8_LDB(B0, 1, 0); PG8_LDB(B1, 1, 1); PG8_SCHED; PG8_LDA(At, 1, 0); PG8_STAGE(PG8_SA(0, 1), a2 + hstep, voffA);
            PG8_WAIT_V(8); PG8_WAIT_L(0); PG8_BAR; PG8_MMA(0, 0, At, B0); PG8_MMA(0, 1, At, B1); PG8_BAR; PG8_SCHED;
            PG8_LDA(At, 1, 1); PG8_STAGE(PG8_SB(1, 0), b3, voffB); PG8_STAGE(PG8_SB(1, 1), b3 + hstep, voffB); PG8_STAGE(PG8_SA(1, 0), a3, voffA);
            PG8_WAIT_V(8); PG8_WAIT_L(0); PG8_BAR; PG8_MMA(1, 0, At, B0); PG8_MMA(1, 1, At, B1); PG8_BAR; PG8_SCHED;
            } else {
            PG8_LDB(B0, 0, 0); PG8_SCHED; PG8_LDA(At, 0, 0); PG8_STAGE(PG8_SA(1, 1), a1 + hstep, voffA);
            PG8_WAIT_L(8); PG8_BAR; PG8_WAIT_L(0); PG8_MMA(0, 0, At, B0); PG8_BAR; PG8_SCHED;
            PG8_LDB(B1, 0, 1); PG8_STAGE(PG8_SB(0, 0), b2, voffB);
            PG8_BAR; PG8_WAIT_L(0); PG8_MMA(0, 1, At, B1); PG8_BAR;
            PG8_LDA(At, 0, 1); PG8_STAGE(PG8_SA(0, 0), a2, voffA);
            PG8_BAR; PG8_WAIT_L(0); PG8_MMA(1, 0, At, B0); PG8_BAR; PG8_SCHED;
            PG8_STAGE(PG8_SB(0, 1), b2 + hstep, voffB);
            PG8_WAIT_V(6); PG8_BAR; PG8_MMA(1, 1, At, B1); PG8_BAR;
            PG8_LDB(B0, 1, 0); PG8_SCHED; PG8_LDA(At, 1, 0); PG8_STAGE(PG8_SA(0, 1), a2 + hstep, voffA);
            PG8_WAIT_L(8); PG8_BAR; PG8_WAIT_L(0); PG8_MMA(0, 0, At, B0); PG8_BAR; PG8_SCHED;
            PG8_LDB(B1, 1, 1); PG8_STAGE(PG8_SB(1, 0), b3, voffB);
            PG8_BAR; PG8_WAIT_L(0); PG8_MMA(0, 1, At, B1); PG8_BAR;
            PG8_LDA(At, 1, 1); PG8_STAGE(PG8_SA(1, 0), a3, voffA);
            PG8_BAR; PG8_WAIT_L(0); PG8_MMA(1, 0, At, B0); PG8_BAR; PG8_SCHED;
            PG8_STAGE(PG8_SB(1, 1), b3 + hstep, voffB);
            PG8_WAIT_V(6); PG8_BAR; PG8_MMA(1, 1, At, B1); PG8_BAR;
            }
        }
        if constexpr (ALIGN_EPI) { if (wr == 0) PG8_BAR; }
        if constexpr (!Epi::AFTER_DRAIN) { f32x4 acc[2][2][4][2];
#pragma unroll
            for (int a = 0; a < 2; ++a)
#pragma unroll
                for (int b = 0; b < 2; ++b)
#pragma unroll
                    for (int m = 0; m < 4; ++m) { acc[a][b][m][0] = __builtin_shufflevector(acc8[a][b][m], acc8[a][b][m], 0, 1, 2, 3); acc[a][b][m][1] = __builtin_shufflevector(acc8[a][b][m], acc8[a][b][m], 4, 5, 6, 7); }
            E(acc, cur, wr, wc, fr, fq); S.done(cur); }
        if (!has_next) break;
#pragma unroll
        for (int a = 0; a < 2; ++a)
#pragma unroll
            for (int b = 0; b < 2; ++b)
#pragma unroll
                for (int m = 0; m < 4; ++m) acc8[a][b][m] = (f32x8){0.f, 0.f, 0.f, 0.f, 0.f, 0.f, 0.f, 0.f};
        cur = nxt; cA = nA; cB = nB; ++ui;
        if constexpr (ALIGN_EPI) { if (wr == 1) PG8_BAR; }
    }
    PG8_WAIT_V(0); S.flush();
    if constexpr (!ALIGN_EPI) { if (wr == 0) PG8_BAR; }
    PG8_BAR;
    static_assert(!Epi::AFTER_DRAIN, "fp8 body: plain epilogues only");
#undef PG8_SA
#undef PG8_SB
#undef PG8_STAGE
#undef PG8_LDA
#undef PG8_LDB
#undef PG8_MMA
#undef PG8_LD8
#undef PG8_WAIT_V
#undef PG8_WAIT_L
#undef PG8_BAR
#undef PG8_SCHED
}
}
#include <hip/hip_bf16.h>
#include <cmath>
namespace attn_body {
using bf16=__hip_bfloat16;
using bf16x8=__attribute__((ext_vector_type(8)))short;
using s16x4=__attribute__((ext_vector_type(4)))short;
using f32x16=__attribute__((ext_vector_type(16)))float;
using u32x4=__attribute__((ext_vector_type(4)))unsigned;
constexpr int BATCH=2,NHEAD=8,SEQ=8192,D=64,DM=2560,OPITCH=1024;
constexpr int NW=8,QBLK=32,QB=QBLK*NW,KVBLK=64,NQB=SEQ/QB;
constexpr int ATTN_PITCH=DM, ATTN_UNIT_ROWS=QB;
__device__ __forceinline__ int crow(int r,int hi){return (r&3)+8*(r>>2)+4*hi;}
#define SBAR() __builtin_amdgcn_sched_barrier(0)
__device__ __forceinline__ void cmask(f32x16&p0,f32x16&p1,int jb,int qrel,int hi){
  const float NEG=-INFINITY; int kb=64*jb+4*hi;
  #pragma unroll
  for(int r=0;r<16;++r){int kv=kb+(r&3)+8*(r>>2); if(kv>qrel)p0[r]=NEG; if(kv+32>qrel)p1[r]=NEG;}
}

constexpr int NSLOT=3, SLOTB=8192;
constexpr int LDS_K=0, LDS_V=NSLOT*SLOTB, LDS_WS=2*NSLOT*SLOTB, LDS_OST=LDS_WS+NW*64*4, LDS_BIAS=LDS_OST+NW*4096, LDS_PRE=LDS_BIAS+SEQ*4, LDS_BYTES=LDS_PRE+1024;
constexpr float C2=0.125f*1.4426950408889634f;
__device__ __forceinline__ void glds16(const void*gsrc,unsigned lds_dst){unsigned keep;
  asm volatile("s_mov_b32 %0, m0\n\ts_mov_b32 m0, %2\n\ts_nop 0\n\tglobal_load_lds_dwordx4 %1, off\n\ts_mov_b32 m0, %0":"=&s"(keep):"v"(gsrc),"s"(lds_dst):"memory");}
__device__ __forceinline__ float max3f(float a,float b,float c){float r;asm("v_max3_f32 %0, %1, %2, %3":"=v"(r):"v"(a),"v"(b),"v"(c));return r;}
__device__ __forceinline__ float max2f(float a,float b){float r;asm("v_max_f32_e32 %0, %1, %2":"=v"(r):"v"(a),"v"(b));return r;}
__device__ __forceinline__ float fadd_s(float a,float b){float r;asm("v_add_f32_e32 %0, %1, %2":"=v"(r):"v"(a),"v"(b));return r;}
__device__ __forceinline__ float fsub_s(float a,float b){float r;asm("v_sub_f32_e32 %0, %1, %2":"=v"(r):"v"(a),"v"(b));return r;}
typedef float f32x2_t __attribute__((ext_vector_type(2))); typedef __bf16 bf16x2_t __attribute__((ext_vector_type(2)));
__device__ __forceinline__ unsigned cvtpk_s(float lo,float hi){f32x2_t v={lo,hi};bf16x2_t b=__builtin_convertvector(v,bf16x2_t);return __builtin_bit_cast(unsigned,b);}
#define WAIT_BAR(N) asm volatile("s_waitcnt vmcnt(" #N ") lgkmcnt(0)\n\ts_barrier":::"memory")

__device__ __forceinline__ void qkt(f32x16&p0,f32x16&p1,const char*Kslot,const bf16x8*qr,int r32,int hi){
  const char*kb=Kslot+hi*1024+r32*16;
  #pragma unroll
  for(int d0=0;d0<4;++d0){
    const bf16x8 b0=*reinterpret_cast<const bf16x8*>(kb+d0*2048);
    const bf16x8 b1=*reinterpret_cast<const bf16x8*>(kb+d0*2048+512);
    p0=__builtin_amdgcn_mfma_f32_32x32x16_bf16(b0,qr[d0],p0,0,0,0);p1=__builtin_amdgcn_mfma_f32_32x32x16_bf16(b1,qr[d0],p1,0,0,0);}
}
typedef __attribute__((address_space(3))) const char* lds_cptr;
typedef short v4i16_t __attribute__((ext_vector_type(4)));
__device__ __forceinline__ void kload8(bf16x8*kf,lds_cptr kp){
  kf[0]=*(const __attribute__((address_space(3))) bf16x8*)(kp);      kf[1]=*(const __attribute__((address_space(3))) bf16x8*)(kp+512);
  kf[2]=*(const __attribute__((address_space(3))) bf16x8*)(kp+2048); kf[3]=*(const __attribute__((address_space(3))) bf16x8*)(kp+2560);
  kf[4]=*(const __attribute__((address_space(3))) bf16x8*)(kp+4096); kf[5]=*(const __attribute__((address_space(3))) bf16x8*)(kp+4608);
  kf[6]=*(const __attribute__((address_space(3))) bf16x8*)(kp+6144); kf[7]=*(const __attribute__((address_space(3))) bf16x8*)(kp+6656);
}
__device__ __forceinline__ void kload2(bf16x8*kf,lds_cptr kp,int j){ kf[2*j]=*(const __attribute__((address_space(3))) bf16x8*)(kp+j*2048); kf[2*j+1]=*(const __attribute__((address_space(3))) bf16x8*)(kp+j*2048+512); }
__device__ __forceinline__ s16x4 vtr(lds_cptr p){ return __builtin_bit_cast(s16x4,__builtin_amdgcn_ds_read_tr16_b64_v4i16((__attribute__((address_space(3))) v4i16_t*)p)); }
__device__ __forceinline__ float rowmax(const f32x16&p0,const f32x16&p1){
  float a=max3f(p0[0],p0[1],p1[0]),b=max3f(p0[2],p0[3],p1[1]);a=max3f(a,p1[2],p1[3]);
  #pragma unroll
  for(int r=4;r<16;r+=4){a=max3f(a,p0[r],p0[r+1]);b=max3f(b,p0[r+2],p0[r+3]);a=max3f(a,p1[r],p1[r+1]);b=max3f(b,p1[r+2],p1[r+3]);}
  const float m=max2f(a,b);
  auto rr=__builtin_amdgcn_permlane32_swap(__float_as_uint(m),__float_as_uint(m),false,false);
  return max2f(__uint_as_float(rr[0]),__uint_as_float(rr[1]));
}
__device__ __forceinline__ void pv(f32x16*o,int vb,bf16x8 pa0,bf16x8 pa1,bf16x8 pa2,bf16x8 pa3){
  #pragma unroll
  for(int d0=0;d0<2;++d0){s16x4 lo[4],hi[4];
    #pragma unroll
    for(int ks=0;ks<4;++ks){
      asm volatile("ds_read_b64_tr_b16 %0,%1 offset:%c2":"=&v"(lo[ks]):"v"(vb),"i"(d0*4096+ks*1024):"memory");
      asm volatile("ds_read_b64_tr_b16 %0,%1 offset:%c2":"=&v"(hi[ks]):"v"(vb),"i"(d0*4096+ks*1024+512):"memory");}
    asm volatile("s_waitcnt lgkmcnt(0)":::"memory");SBAR();
    #define PK(k) (bf16x8){lo[k][0],lo[k][1],lo[k][2],lo[k][3],hi[k][0],hi[k][1],hi[k][2],hi[k][3]}
    o[d0]=__builtin_amdgcn_mfma_f32_32x32x16_bf16(pa0,PK(0),o[d0],0,0,0);
    o[d0]=__builtin_amdgcn_mfma_f32_32x32x16_bf16(pa1,PK(1),o[d0],0,0,0);
    o[d0]=__builtin_amdgcn_mfma_f32_32x32x16_bf16(pa2,PK(2),o[d0],0,0,0);
    o[d0]=__builtin_amdgcn_mfma_f32_32x32x16_bf16(pa3,PK(3),o[d0],0,0,0);
    #undef PK
  }
}

#ifndef ATTN_STORE16
#define ATTN_STORE16(p,v) (*(u32x4*)(p)=(v))
#endif
typedef float f32x4b __attribute__((ext_vector_type(4)));
template<int THRL> __device__ __forceinline__ void attn_unit(int b,int h,int qb,const bf16*Q,const bf16*__restrict__ K,const bf16*__restrict__ V,bf16*O,const float*__restrict__ floc,const float*__restrict__ ftot,const float*__restrict__ qkn,char*shm){
  int tid=threadIdx.x; asm volatile("":"+v"(tid)); const int lane=tid&63,r32=lane&31,hi=lane>>5; const int wid=__builtin_amdgcn_readfirstlane(tid>>6);
  const long rowbase=(long)b*SEQ; const int q0=qb*QB;
  typedef __attribute__((address_space(3))) float* lds_fptr;
  const lds_fptr prel=(lds_fptr)((lds_cptr)shm+LDS_PRE); const lds_fptr biasl=(lds_fptr)((lds_cptr)shm+LDS_BIAS);
  { const int nblk=4*(qb+1);
    if(wid==0){ int pl_=lane; asm volatile("":"+v"(pl_));
      float a0=(pl_<nblk)?ftot[(b*128+pl_)*8+h]:0.f, a1=(pl_+64<nblk)?ftot[(b*128+64+pl_)*8+h]:0.f; float s0=a0,s1=a1;
      #pragma unroll
      for(int o_=1;o_<64;o_<<=1){ const float t0_=__shfl_up(s0,o_),t1_=__shfl_up(s1,o_); if(pl_>=o_){s0+=t0_;s1+=t1_;} }
      s1+=__shfl(s0,63); const float p0_=s0-a0,p1_=s1-a1;
      prel[pl_]=p0_; prel[pl_+64]=p1_;
      const float*kn_=qkn+(size_t)(256+b*128)*16+h*2; const float*qn_=qkn+(size_t)(b*128)*16+h*2;
      float k2=(pl_<nblk)?(kn_[pl_*16]+kn_[pl_*16+1]):0.f; { const float k2b=(pl_+64<nblk)?(kn_[(pl_+64)*16]+kn_[(pl_+64)*16+1]):0.f; k2=fmaxf(k2,k2b); }
      float q2=(pl_<4)?(qn_[(4*qb+pl_)*16]+qn_[(4*qb+pl_)*16+1]):0.f;
      #pragma unroll
      for(int o_=1;o_<64;o_<<=1){ k2=fmaxf(k2,__shfl_xor(k2,o_)); q2=fmaxf(q2,__shfl_xor(q2,o_)); }
      const float need=30.f+2.04f*sqrtf(k2*q2);
      const float cu=__shfl(qb<16?p0_:p1_,(4*qb)&63);
      const bool c0_=((pl_&1)==0)&&(pl_<=4*qb)&&((p0_-cu)*1.4426950408889634f>=need);
      const bool c1_=((pl_&1)==0)&&(pl_+64<=4*qb)&&((p1_-cu)*1.4426950408889634f>=need);
      const unsigned long long m0_=__ballot(c0_),m1_=__ballot(c1_);
      const int ts_=m1_?(127-__builtin_clzll(m1_)):(m0_?(63-__builtin_clzll(m0_)):0);
      if(pl_==0)prel[128]=__int_as_float(ts_); }
    asm volatile("s_waitcnt vmcnt(0) lgkmcnt(0)\n\ts_barrier":::"memory"); }
  const int tstart=__builtin_amdgcn_readfirstlane(__float_as_int(prel[128]));
  const bf16*Qw=Q+(rowbase+q0+wid*QBLK)*DM+h*D;
  const bf16*Kh=K+(rowbase+(long)tstart*KVBLK)*DM+h*D,*Vh=V+(rowbase+(long)tstart*KVBLK)*DM+h*D;
  const lds_cptr shm3=(lds_cptr)shm;
  const unsigned lds0=(unsigned)(uintptr_t)shm;
  float*wsf=(float*)(shm+LDS_WS)+wid*64;
  const bf16*ksrc=Kh+(long)lane*DM+wid*8;
  const bf16*vsrc=Vh+(long)(16*(wid&3)+(lane>>2))*DM+(wid>>2)*32+(lane&3)*8;
  const unsigned kdst=lds0+LDS_K+wid*1024, vdst=lds0+LDS_V+wid*1024;
  #define DMA_K(t,slot) glds16(ksrc+(long)(t)*KVBLK*DM,(unsigned)__builtin_amdgcn_readfirstlane(kdst+(slot)))
  #define DMA_V(t,slot) glds16(vsrc+(long)(t)*KVBLK*DM,(unsigned)__builtin_amdgcn_readfirstlane(vdst+(slot)))
  const int vb0=(int)(lds0+LDS_V)+((lane>>4)&1)*32+(lane&3)*8+(4*hi+((lane&15)>>2))*64;
  const char*Kbase=shm+LDS_K; bf16x8 kf[8];
  const lds_cptr kp0=shm3+LDS_K+hi*1024+r32*16; const lds_cptr vp0=shm3+LDS_V+((lane>>4)&1)*32+(lane&3)*8+(4*hi+((lane&15)>>2))*64;
  const int NT=(q0+QB)/KVBLK-tstart;
  { const float cref=prel[4*qb];
    for(int s_=64*tstart+tid;s_<256*(qb+1);s_+=NW*64) biasl[s_-64*tstart]=(cref-(prel[s_>>6]+floc[(rowbase+s_)*8+h]))*1.4426950408889634f;
    asm volatile("s_waitcnt vmcnt(0) lgkmcnt(0)\n\ts_barrier":::"memory"); }
  #define BIASINIT(P0,P1,t) do{ const __attribute__((address_space(3))) f32x4b* bq_=(const __attribute__((address_space(3))) f32x4b*)(biasl+64*(t)+4*hi); \
    _Pragma("unroll") for(int g_=0;g_<4;++g_){ const f32x4b x0_=bq_[2*g_],x1_=bq_[8+2*g_]; \
      P0[4*g_]=x0_[0]-mhat;P0[4*g_+1]=x0_[1]-mhat;P0[4*g_+2]=x0_[2]-mhat;P0[4*g_+3]=x0_[3]-mhat; P1[4*g_]=x1_[0]-mhat;P1[4*g_+1]=x1_[1]-mhat;P1[4*g_+2]=x1_[2]-mhat;P1[4*g_+3]=x1_[3]-mhat; } }while(0)
  DMA_K(0,0);DMA_V(0,0);DMA_K(1,SLOTB);
  bf16x8 qr[4];
  #pragma unroll
  for(int d0=0;d0<4;++d0)qr[d0]=*reinterpret_cast<const bf16x8*>(&Qw[(long)r32*DM+d0*16+hi*8]);
  float mhat=0.f,l_reg=0.f;f32x16 o[2];o[0]=f32x16{};o[1]=f32x16{};
  const int qrel=wid*QBLK+r32;
  #define CMASK(P0,P1,t) do{int jb_=(t)-(NT-4); if(jb_>=0)cmask(P0,P1,jb_,qrel,hi);}while(0)
  bool resc=false;
  #define START(P0,P1) do{ const float rm=rowmax(P0,P1); resc=false; \
    { const float dl=rm; mhat=fadd_s(mhat,dl); \
      _Pragma("unroll") for(int r=0;r<16;++r){P0[r]=fsub_s(P0[r],dl);P1[r]=fsub_s(P1[r],dl);} } \
    _Pragma("unroll") for(int r=0;r<16;++r)P0[r]=__builtin_amdgcn_exp2f(P0[r]); }while(0)
  #define RESC() do{ if(resc){ asm volatile("s_waitcnt lgkmcnt(0)":::"memory"); \
      _Pragma("unroll") for(int d_=0;d_<2;++d_) _Pragma("unroll") for(int r=0;r<16;++r)o[d_][r]*=wsf[crow(r,hi)]; } }while(0)
  f32x16 pA0,pA1,pB0,pB1;
  int sl_prev=0,sl_cur=0,sl_next=SLOTB;
  #define ROT() do{sl_prev=sl_cur;sl_cur=sl_next;sl_next=(sl_next==(NSLOT-1)*SLOTB)?0:sl_next+SLOTB;}while(0)
  DMA_K(2,2*SLOTB);
  WAIT_BAR(3);
  BIASINIT(pA0,pA1,0);qkt(pA0,pA1,Kbase,qr,r32,hi);asm volatile("s_nop 15\n\ts_nop 7":"+v"(pA0),"+v"(pA1));CMASK(pA0,pA1,0);
  START(pA0,pA1);
  _Pragma("unroll") for(int r=0;r<16;++r)pA1[r]=__builtin_amdgcn_exp2f(pA1[r]);
  WAIT_BAR(0);
  DMA_K(3,0);DMA_V(1,SLOTB);
  ROT();
  kload8(kf,kp0+sl_cur);
  WAIT_BAR(2);
  s16x4 vlo[8],vhi[8]; u32x4 pw0,pw1,pw2,pw3;
  #define PKW(P,B) cvtpk_s(P[B],P[B+1])
  #define PAF(k) __builtin_bit_cast(bf16x8,pw##k)
  #define VFR(i) (bf16x8){vlo[i][0],vlo[i][1],vlo[i][2],vlo[i][3],vhi[i][0],vhi[i][1],vhi[i][2],vhi[i][3]}
  #define PIN(x) asm volatile("":"+v"(x))
  #define MX3(a,b,c) __builtin_fmaxf(__builtin_fmaxf((a),(b)),(c))
  #define GAPA(MF,A0,A1,A2,A3,W0,W1,PW) do{ MF; sacc+=A0; sacc+=A1; sacc+=A2; sacc+=A3; PIN(sacc); W0; W1; PIN(PW); SBAR(); }while(0)
  #define EX(v) __builtin_amdgcn_exp2f(v)
  #define GAPB(MF,X,B) do{ MF; X[B]=EX(X[B]); X[B+1]=EX(X[B+1]); X[B+2]=EX(X[B+2]); X[B+3]=EX(X[B+3]); PIN(X); SBAR(); }while(0)
  #define VRD(i) do{ vlo[i]=vtr(vp_+(((i)>>2)*4096+((i)&3)*1024)); vhi[i]=vtr(vp_+(((i)>>2)*4096+((i)&3)*1024+512)); }while(0)
  #define KRD(G,j) do{ if(G){ kload2(kf,kp0+sl_next,j); SBAR(); } }while(0)
  #define STEP(C0,C1,P0,P1,t,GK,GV,GL) do{ SBAR(); BIASINIT(C0,C1,t); SBAR(); \
    const lds_cptr vp_=vp0+sl_prev; \
    VRD(0); SBAR(); float sacc=(P0[0]+P0[1]); \
    GAPA(C0=__builtin_amdgcn_mfma_f32_32x32x16_bf16(kf[0],qr[0],C0,0,0,0), P0[2],P0[3],P0[4],P0[5],     pw0[0]=PKW(P0,0), pw0[1]=PKW(P0,2), pw0); \
    VRD(4); SBAR(); GAPA(C1=__builtin_amdgcn_mfma_f32_32x32x16_bf16(kf[1],qr[0],C1,0,0,0), P0[6],P0[7],P0[8],P0[9],     pw0[2]=PKW(P0,4), pw0[3]=PKW(P0,6), pw0); \
    VRD(1); SBAR(); GAPA(C0=__builtin_amdgcn_mfma_f32_32x32x16_bf16(kf[2],qr[1],C0,0,0,0),   P0[10],P0[11],P0[12],P0[13], pw1[0]=PKW(P0,8), pw1[1]=PKW(P0,10), pw1); \
    VRD(5); SBAR(); GAPA(C1=__builtin_amdgcn_mfma_f32_32x32x16_bf16(kf[3],qr[1],C1,0,0,0),   P0[14],P0[15],P1[0],P1[1],   pw1[2]=PKW(P0,12),pw1[3]=PKW(P0,14), pw1); \
    VRD(2); SBAR(); GAPA(C0=__builtin_amdgcn_mfma_f32_32x32x16_bf16(kf[4],qr[2],C0,0,0,0),   P1[2],P1[3],P1[4],P1[5],     pw2[0]=PKW(P1,0), pw2[1]=PKW(P1,2), pw2); \
    VRD(6); SBAR(); GAPA(C1=__builtin_amdgcn_mfma_f32_32x32x16_bf16(kf[5],qr[2],C1,0,0,0),   P1[6],P1[7],P1[8],P1[9],     pw2[2]=PKW(P1,4), pw2[3]=PKW(P1,6), pw2); \
    VRD(3); SBAR(); GAPA(C0=__builtin_amdgcn_mfma_f32_32x32x16_bf16(kf[6],qr[3],C0,0,0,0),   P1[10],P1[11],P1[12],P1[13], pw3[0]=PKW(P1,8), pw3[1]=PKW(P1,10), pw3); \
    VRD(7); SBAR(); GAPA(C1=__builtin_amdgcn_mfma_f32_32x32x16_bf16(kf[7],qr[3],C1,0,0,0),   P1[14],P1[15],0.f,0.f,       pw3[2]=PKW(P1,12),pw3[3]=PKW(P1,14), pw3); \
    l_reg+=sacc; \
    if(GK){DMA_K((t)+3,sl_cur);} if(GV){DMA_V((t)+1,sl_next);} \
    CMASK(C0,C1,t); \
    { float a=MX3(C0[0],C0[1],C1[0]),b=MX3(C0[2],C0[3],C1[1]); a=MX3(a,C1[2],C1[3]); \
      _Pragma("unroll") for(int r=4;r<16;r+=4){a=MX3(a,C0[r],C0[r+1]);b=MX3(b,C0[r+2],C0[r+3]);a=MX3(a,C1[r],C1[r+1]);b=MX3(b,C1[r+2],C1[r+3]);} \
      float rm=__builtin_fmaxf(a,b); { auto rr=__builtin_amdgcn_permlane32_swap(__float_as_uint(rm),__float_as_uint(rm),false,false); rm=__builtin_fmaxf(__uint_as_float(rr[0]),__uint_as_float(rr[1])); } \
      resc=false; \
      if(__builtin_expect(__any(rm>(float)THRL),0)){ const float dl=__builtin_fmaxf(rm,0.f); mhat+=dl; \
        _Pragma("unroll") for(int r=0;r<16;++r){C0[r]-=dl;C1[r]-=dl;} \
        const float f=__builtin_amdgcn_exp2f(-dl); l_reg*=f; if(hi==0)wsf[r32]=f; resc=true; } } \
    SBAR(); \
    GAPB(o[0]=__builtin_amdgcn_mfma_f32_32x32x16_bf16(PAF(0),VFR(0),o[0],0,0,0), C0,0); \
    GAPB(o[1]=__builtin_amdgcn_mfma_f32_32x32x16_bf16(PAF(0),VFR(4),o[1],0,0,0), C0,4); \
    KRD(GL,0); GAPB(o[0]=__builtin_amdgcn_mfma_f32_32x32x16_bf16(PAF(1),VFR(1),o[0],0,0,0), C0,8); \
    KRD(GL,1); GAPB(o[1]=__builtin_amdgcn_mfma_f32_32x32x16_bf16(PAF(1),VFR(5),o[1],0,0,0), C0,12); \
    KRD(GL,2); GAPB(o[0]=__builtin_amdgcn_mfma_f32_32x32x16_bf16(PAF(2),VFR(2),o[0],0,0,0), C1,0); \
    KRD(GL,3); GAPB(o[1]=__builtin_amdgcn_mfma_f32_32x32x16_bf16(PAF(2),VFR(6),o[1],0,0,0), C1,4); \
    GAPB(o[0]=__builtin_amdgcn_mfma_f32_32x32x16_bf16(PAF(3),VFR(3),o[0],0,0,0), C1,8); \
    GAPB(o[1]=__builtin_amdgcn_mfma_f32_32x32x16_bf16(PAF(3),VFR(7),o[1],0,0,0), C1,12); \
    }while(0)
  int t=1;
  #undef CMASK
  #define CMASK(P0,P1,t) do{}while(0)
  for(;t+5<NT;t+=2){
    STEP(pB0,pB1,pA0,pA1,t,true,true,true);     WAIT_BAR(2); RESC(); ROT();
    STEP(pA0,pA1,pB0,pB1,t+1,true,true,true);   WAIT_BAR(2); RESC(); ROT();
  }
  #undef CMASK
  #define CMASK(P0,P1,t) do{int jb_=(t)-(NT-4); if(jb_>=0)cmask(P0,P1,jb_,qrel,hi);}while(0)
  #define ENDW(tt) do{ if((tt)+3<NT){WAIT_BAR(2);} else if((tt)+2<NT){WAIT_BAR(1);} else {WAIT_BAR(0);} }while(0)
  for(;t+1<NT;t+=2){
    STEP(pB0,pB1,pA0,pA1,t,(t+3<NT),(t+1<NT),(t+1<NT));       ENDW(t);   RESC(); ROT();
    STEP(pA0,pA1,pB0,pB1,t+1,(t+4<NT),(t+2<NT),(t+2<NT));     ENDW(t+1); RESC(); ROT();
  }
  STEP(pB0,pB1,pA0,pA1,NT-1,false,false,false); RESC();
  { float sacc=pB0[0]+pB0[1]; _Pragma("unroll") for(int r=2;r<16;++r)sacc+=pB0[r]; _Pragma("unroll") for(int r=0;r<16;++r)sacc+=pB1[r]; l_reg+=sacc;
    pw0=(u32x4){PKW(pB0,0),PKW(pB0,2),PKW(pB0,4),PKW(pB0,6)};pw1=(u32x4){PKW(pB0,8),PKW(pB0,10),PKW(pB0,12),PKW(pB0,14)};pw2=(u32x4){PKW(pB1,0),PKW(pB1,2),PKW(pB1,4),PKW(pB1,6)};pw3=(u32x4){PKW(pB1,8),PKW(pB1,10),PKW(pB1,12),PKW(pB1,14)};
    SBAR(); pv(o,vb0+sl_cur,PAF(0),PAF(1),PAF(2),PAF(3)); }
  #undef PKW
  #undef PAF
  #undef VFR
  #undef PIN
  #undef MX3
  #undef GAPA
  #undef GAPB
  #undef EX
  #undef VRD
  #undef KRD
  #undef STEP
  #undef ENDW
  {auto rr=__builtin_amdgcn_permlane32_swap(__float_as_uint(l_reg),__float_as_uint(l_reg),false,false);l_reg=__uint_as_float(rr[0])+__uint_as_float(rr[1]);}
  if(hi==0)wsf[32+r32]=l_reg;asm volatile("s_waitcnt lgkmcnt(0)":::"memory");
  float rli[16];
  #pragma unroll
  for(int r=0;r<16;++r)rli[r]=__builtin_amdgcn_rcpf(wsf[32+crow(r,hi)]);
  bf16*Ow=O+(rowbase+q0+wid*QBLK)*OPITCH+h*D;
  { bf16*stg=(bf16*)(shm+LDS_OST)+wid*2048;
    #pragma unroll
    for(int r=0;r<16;++r){const int orow=crow(r,hi);
      #pragma unroll
      for(int d0=0;d0<2;++d0)stg[orow*64+d0*32+r32]=__float2bfloat16(o[d0][r]*rli[r]);}
    asm volatile("s_waitcnt lgkmcnt(0)":::"memory");
    #pragma unroll
    for(int i=0;i<4;++i){const int row=i*8+(lane>>3),ch=lane&7; const u32x4 v=*(const u32x4*)(stg+row*64+ch*8); ATTN_STORE16(Ow+(long)row*OPITCH+ch*8,v);} }
  asm volatile("s_waitcnt lgkmcnt(0)\n\ts_barrier":::"memory");
  #undef DMA_K
  #undef DMA_V
  #undef BIASINIT
  #undef CMASK
  #undef START
  #undef RESC
  #undef ROT
}
constexpr int ATTN_LDS_BYTES=LDS_BYTES;
struct AttnTensors { const bf16* Q; const bf16* K; const bf16* V; bf16* O; const float* floc; const float* ftot; const float* qkn; };
struct AttnUnit { int bh; int qb; };
struct StaticOrder {
  int vcu, G;
  __device__ __forceinline__ explicit StaticOrder(int grid,int block):vcu((grid%8==0)?(block%8)*(grid/8)+block/8:block),G(grid){}
  __device__ __forceinline__ bool next(int i,AttnUnit&u)const{ const int pair=vcu+(i>>1)*G; if(pair>=256)return false; const int s=pair&15; u.bh=pair>>4; u.qb=(i&1)?s:31-s; return true; }
  __device__ __forceinline__ void a_ready(const AttnUnit&)const{}
  __device__ __forceinline__ void done(const AttnUnit&)const{}
};
template<class Sched,int THRL=8> __device__ __forceinline__ void attn_phase(char*lds,const AttnTensors&T,const Sched&S){
  AttnUnit u;
  for(int i=0;S.next(i,u);++i){ S.a_ready(u); attn_unit<THRL>(u.bh/NHEAD,u.bh%NHEAD,u.qb,T.Q,T.K,T.V,T.O,T.floc,T.ftot,T.qkn,lds); S.done(u); }
}
#undef SBAR
#undef WAIT_BAR
}
#define GAS __attribute__((address_space(1)))
#define LAS __attribute__((address_space(3)))
typedef unsigned short bf16;
typedef unsigned v4u __attribute__((ext_vector_type(4)));
typedef float f32x4 __attribute__((ext_vector_type(4)));
typedef short bf16x8 __attribute__((ext_vector_type(8)));
typedef GAS unsigned gu32;
typedef GAS unsigned long long gu64;
#define RLX_AGENT __ATOMIC_RELAXED, __HIP_MEMORY_SCOPE_AGENT
#define LDS_WAIT() asm volatile("s_waitcnt lgkmcnt(0)" ::: "memory")
#define VM_WAIT() asm volatile("s_waitcnt vmcnt(0)" ::: "memory")
__device__ __forceinline__ unsigned long long rt() { return __builtin_amdgcn_s_memrealtime(); }
__device__ __forceinline__ unsigned f2bf(float f) { unsigned u = __builtin_bit_cast(unsigned, f); return (u + 0x7fffu + ((u >> 16) & 1u)) >> 16; }
__device__ __forceinline__ unsigned pk2(float lo, float hi) { return f2bf(lo) | (f2bf(hi) << 16); }

#define XB_TMO      128
#define XB_XCNT(j)  (256  + 64 * (j))
#define XB_XSUB(j)  (1280 + 64 * (j))
#define XB_XGEN(j)  (2304 + 64 * (j))
#define XB_TOP      3328
#define XB_TOPGEN   3392
#define XCD_BAR_WORDS 3456
#define XB_SPIN_CAP (1u << 18)

__device__ __forceinline__ unsigned xb_ld(unsigned* p)              { return __hip_atomic_load(p, __ATOMIC_RELAXED, __HIP_MEMORY_SCOPE_AGENT); }
__device__ __forceinline__ unsigned xb_add(unsigned* p, unsigned v) { return __hip_atomic_fetch_add(p, v, __ATOMIC_RELAXED, __HIP_MEMORY_SCOPE_AGENT); }
__device__ __forceinline__ unsigned xb_xcc_id() { return (unsigned)__builtin_amdgcn_s_getreg((3 << 11) | 20) & 0xFu; }
#define XB_SPIN(cond, bar) do { unsigned _sp = 0; while (cond) { __builtin_amdgcn_s_sleep(1); \
    if ((++_sp & 255u) == 0u) { if (xb_ld(&(bar)[XB_TMO])) break; if (_sp > XB_SPIN_CAP) { atomicAdd(&(bar)[XB_TMO], 1u); break; } } } } while (0)

struct XcdBarrier {
    unsigned* bar; unsigned x;
    volatile LAS unsigned* st;
};

__device__ __forceinline__ XcdBarrier xcd_barrier_post(unsigned* bar, volatile LAS unsigned* st) {
    XcdBarrier b; b.bar = bar; b.x = xb_xcc_id(); b.st = st;
    if (threadIdx.x == 0) (void)xb_add(&bar[XB_XCNT(b.x)], 1u);
    return b;
}
__device__ __forceinline__ void xcd_barrier_complete(unsigned* bar, unsigned x, unsigned& nloc, unsigned& nx) {
    const unsigned G = gridDim.x * gridDim.y * gridDim.z;
    unsigned sum, cnt, mine, sp = 0u;
    for (;;) {
        sum = 0u; cnt = 0u; mine = 0u;
#pragma unroll
        for (unsigned j = 0; j < 16; ++j) { const unsigned c = xb_ld(&bar[XB_XCNT(j)]); sum += c; cnt += (c > 0u) ? 1u : 0u; mine = (j == x) ? c : mine; }
        if (sum == G) break;
        __builtin_amdgcn_s_sleep(1);
        if ((++sp & 255u) == 0u) { if (xb_ld(&bar[XB_TMO])) break; if (sp > XB_SPIN_CAP) { atomicAdd(&bar[XB_TMO], 1u); break; } }
    }
    nloc = mine > 0u ? mine : 1u; nx = cnt > 0u ? cnt : 1u;
}

__device__ __forceinline__ void xcd_barrier(const XcdBarrier& b) {
    asm volatile("s_waitcnt vmcnt(0)" ::: "memory");
    __syncthreads();
    if (threadIdx.x == 0) {
        unsigned* bar = b.bar;
        __builtin_amdgcn_s_waitcnt(0);
        unsigned nloc = b.st[0], nx = b.st[1];
        if (nloc == 0u) { xcd_barrier_complete(bar, b.x, nloc, nx); b.st[0] = nloc; b.st[1] = nx; }
        const unsigned old = xb_add(&bar[XB_XSUB(b.x)], 1u);
        const unsigned gen = old / nloc;
        if (old + 1u == (gen + 1u) * nloc) {
            __builtin_amdgcn_fence(__ATOMIC_RELEASE, "agent");
            asm volatile("s_waitcnt vmcnt(0)" ::: "memory");
            const unsigned og = xb_add(&bar[XB_TOP], 1u);
            const unsigned tg = og / nx;
            if (og + 1u == (tg + 1u) * nx) xb_add(&bar[XB_TOPGEN], 1u);
            else XB_SPIN(xb_ld(&bar[XB_TOPGEN]) == tg, bar);
            __builtin_amdgcn_fence(__ATOMIC_ACQUIRE, "agent");
            xb_add(&bar[XB_XGEN(b.x)], 1u);
            asm volatile("s_waitcnt vmcnt(0)" ::: "memory");
        } else {
            XB_SPIN(xb_ld(&bar[XB_XGEN(b.x)]) == gen, bar);
            __builtin_amdgcn_fence(__ATOMIC_ACQUIRE, "agent");
            asm volatile("s_waitcnt vmcnt(0)" ::: "memory");
        }
    }
    __syncthreads();
}
constexpr int NWAVES = 8, NTHR = 512;
constexpr int BATCH = 2, SEQ = 8192, DMODEL = 1024, MROWS = BATCH * SEQ;
constexpr int N0 = 2560, N0SRC = 2568, DFF = 2816, N1 = 3072, N1SRC = 3088, NEXP = 8, DFFE = 3584;
constexpr int MOE_TILES = 136, MOE_ROWS = MOE_TILES * 256;
constexpr float EPS = 1e-6f, LOG2E = 1.4426950408889634f;
constexpr int NPHASE = 15;
#ifndef MK_ONE_LAUNCH
#define MK_ONE_LAUNCH 1
#endif
constexpr size_t MiB = 1u << 20;
constexpr size_t WS_CTL = 0, CTL_ZERO_BYTES = 65536;
constexpr size_t WS_FLOC0 = 1 * MiB, WS_FLOC1 = WS_FLOC0 + 512 * 1024, WS_IG1 = WS_FLOC1 + 512 * 1024;
constexpr size_t WS_TOKS = WS_IG1 + 512 * 1024;
constexpr size_t WS_SGATE2 = WS_TOKS + 128 * 1024;
constexpr size_t WS_FTOT0 = WS_SGATE2 + 512 * 1024, WS_FTOT1 = WS_FTOT0 + 8192, WS_GMAX1 = WS_FTOT1 + 8192, WS_HIST = WS_GMAX1 + 8192, WS_META = WS_HIST + 8192, WS_QKN = WS_META + 4096;
static_assert(WS_QKN + 32768 <= 4 * MiB, "small arrays");
constexpr size_t WS_EGU8 = 4 * MiB;
constexpr size_t WS_ED8 = 60 * MiB;
constexpr size_t WS_H = 116 * MiB;
constexpr size_t WS_W0IN = 148 * MiB, WS_W0OUT = WS_W0IN + 5 * MiB, WS_W0GU = WS_W0OUT + 2 * MiB, WS_W0D = WS_W0GU + 11 * MiB, WS_W1IN = WS_W0D + 5632 * 1024,
                 WS_WQ = WS_W1IN + 6 * MiB, WS_WK = WS_WQ + 256 * 1024, WS_W1OUT = WS_WK + 256 * 1024;
static_assert(WS_W1OUT + 2 * MiB == 180 * MiB, "dense weights");
constexpr size_t WS_R = 180 * MiB;
constexpr size_t WS_CAT = 276 * MiB, WS_Q1 = 308 * MiB, WS_K1 = 340 * MiB, WS_TST = 372 * MiB;
constexpr size_t WS_X = 392 * MiB;
constexpr size_t WS_ROWSS = 424 * MiB;
constexpr size_t WS_AG8 = 88 * MiB;
constexpr size_t WS_YS = 160 * MiB;
constexpr size_t WS_ACTM8 = 232 * MiB;
constexpr size_t WS_Y = 88 * MiB;
constexpr size_t WS_END = WS_ROWSS + (size_t)MROWS * 64;
static_assert(WS_AG8 + (size_t)8 * 16384 * 1024 <= WS_ACTM8 && WS_Y + (size_t)MOE_ROWS * 1024 * 4 <= WS_ACTM8 && WS_ED8 + (size_t)8 * 1024 * DFFE <= WS_Y && WS_EGU8 + (size_t)8 * 7168 * 1024 <= WS_ED8 && WS_ACTM8 + (size_t)MOE_ROWS * DFFE <= WS_X && WS_TST + (size_t)256 * 160 * 128 * 4 <= WS_X && WS_END <= 455 * MiB, "moe map");
constexpr int CW_TMO = 0, CW_BAR = 4096, CW_CNT = 13056, CW_Q2 = 8256, CW_Q1 = 8320, CW_RDY = 8448;
constexpr int SCR_BYTES = 155648, MISC_OFF = SCR_BYTES, LDS_BYTES = 159744;
__device__ __forceinline__ float bf2f(unsigned short b) { return __uint_as_float((unsigned)b << 16); }
__device__ __forceinline__ float bflo(unsigned w) { return __uint_as_float(w << 16); }
__device__ __forceinline__ float bfhi(unsigned w) { return __uint_as_float(w & 0xffff0000u); }
__device__ __forceinline__ float wave_sum(float v) {
#pragma unroll
    for (int o = 1; o < 64; o <<= 1) v += __shfl_xor(v, o);
    return v;
}
__device__ __forceinline__ float wave_max(float v) {
#pragma unroll
    for (int o = 1; o < 64; o <<= 1) v = fmaxf(v, __shfl_xor(v, o));
    return v;
}
__device__ __forceinline__ float scan_add(float v, int lane) {
#pragma unroll
    for (int o = 1; o < 64; o <<= 1) { const float t = __shfl_up(v, o); if (lane >= o) v += t; }
    return v;
}
__device__ __forceinline__ float scan_max(float v, int lane) {
#pragma unroll
    for (int o = 1; o < 64; o <<= 1) { const float t = __shfl_up(v, o); if (lane >= o) v = fmaxf(v, t); }
    return v;
}
__device__ __forceinline__ float log_sigmoid(float z) { return fminf(z, 0.f) - log1pf(expf(-fabsf(z))); }
__device__ __forceinline__ float sigmoid_f(float z) { return 1.0f / (1.0f + expf(-z)); }

struct KP {
    const float* in[29]; float* out; unsigned char* ws; int ph_lo, ph_hi;
};
typedef const __attribute__((address_space(4))) KP* KPp;
__device__ __forceinline__ KPp kp_get() { KPp q = (KPp)__builtin_amdgcn_kernarg_segment_ptr(); asm volatile("" : "+s"(q)); return q; }
enum { I_X = 0, I_L0N1G, I_L0WIN, I_L0BF, I_L0DWW, I_L0DWB, I_L0CLNG, I_L0CLNB, I_L0WOUT, I_L0N2G, I_L0WG, I_L0WU, I_L0WD,
       I_L1N1G, I_L1WIN, I_L1BI, I_L1BF, I_L1CW, I_L1CB, I_L1WQ, I_L1WK, I_L1HG, I_L1WOUT, I_L1N2G, I_L1RT, I_L1EG, I_L1EU, I_L1ED, I_FNG };

__device__ __forceinline__ void cvt_item(const float* src, int ld, int c0, int k0, bf16* dst, int K, int r0, float scale, LAS float* scr, int lane, const float* ksc = nullptr) {
    const GAS float* s = (const GAS float*)src + (size_t)k0 * ld + c0;
    f32x4 v[16];
#pragma unroll
    for (int i = 0; i < 16; ++i) v[i] = __builtin_nontemporal_load((const GAS f32x4*)(s + (size_t)(4 * i + (lane >> 4)) * ld + 4 * (lane & 15)));
#pragma unroll
    for (int i = 0; i < 16; ++i) { LAS float* p = scr + (4 * i + (lane >> 4)) * 65 + 4 * (lane & 15); p[0] = v[i][0]; p[1] = v[i][1]; p[2] = v[i][2]; p[3] = v[i][3]; }
    LDS_WAIT(); asm volatile("" ::: "memory");
    const int c = lane & 7;
    float ks[8];
#pragma unroll
    for (int i = 0; i < 8; ++i) ks[i] = ksc ? scale * ksc[k0 + 8 * c + i] : scale;
#pragma unroll
    for (int j = 0; j < 8; ++j) { const int n = (lane >> 3) + 8 * j; const LAS float* q = scr + (8 * c) * 65 + n;
        v4u o; o.x = pk2(q[0] * ks[0], q[65] * ks[1]); o.y = pk2(q[130] * ks[2], q[195] * ks[3]); o.z = pk2(q[260] * ks[4], q[325] * ks[5]); o.w = pk2(q[390] * ks[6], q[455] * ks[7]);
        __builtin_nontemporal_store(o, (GAS v4u*)(dst + (size_t)(r0 + n) * K + k0 + 8 * c)); }
    LDS_WAIT(); asm volatile("" ::: "memory");
}
__device__ __forceinline__ void cvt_item8(const float* src, int ld, int c0, int k0, unsigned char* dst, int K, int r0, float scale, LAS float* scr, int lane) {
    const GAS float* s = (const GAS float*)src + (size_t)k0 * ld + c0;
    f32x4 v[16];
#pragma unroll
    for (int i = 0; i < 16; ++i) v[i] = __builtin_nontemporal_load((const GAS f32x4*)(s + (size_t)(4 * i + (lane >> 4)) * ld + 4 * (lane & 15)));
#pragma unroll
    for (int i = 0; i < 16; ++i) { LAS float* p = scr + (4 * i + (lane >> 4)) * 65 + 4 * (lane & 15); p[0] = v[i][0]; p[1] = v[i][1]; p[2] = v[i][2]; p[3] = v[i][3]; }
    LDS_WAIT(); asm volatile("" ::: "memory");
    const int c = lane & 3;
#pragma unroll
    for (int j = 0; j < 4; ++j) { const int n = (lane >> 2) + 16 * j; const LAS float* q = scr + (16 * c) * 65 + n;
        v4u o; o.x = pg8::pk4_fp8(q[0] * scale, q[65] * scale, q[130] * scale, q[195] * scale); o.y = pg8::pk4_fp8(q[260] * scale, q[325] * scale, q[390] * scale, q[455] * scale);
        o.z = pg8::pk4_fp8(q[520] * scale, q[585] * scale, q[650] * scale, q[715] * scale); o.w = pg8::pk4_fp8(q[780] * scale, q[845] * scale, q[910] * scale, q[975] * scale);
        __builtin_nontemporal_store(o, (GAS v4u*)(dst + (size_t)(r0 + n) * K + k0 + 16 * c)); }
    LDS_WAIT(); asm volatile("" ::: "memory");
}
constexpr int CV_DENSE = 16 * 40 + 256 + 16 * 88 + 44 * 16 + 16 * 48 + 32 + 32 + 256, CV_EXP = 8 * 16 * 112 + 8 * 56 * 16, CV_ALL = CV_DENSE + CV_EXP;
constexpr int CV_FIRST = 16 * 40;
constexpr int CV_GEMM1 = 160;
constexpr int CV_TAIL2 = 3072, CV_Q2 = 3072;
__device__ __forceinline__ void convert_weights(KPp p, LAS unsigned char* lds, int it_lo, int it_hi, int gw, int ngw, int lane, int wave) {
    LAS float* scr = (LAS float*)(lds + wave * 16640);
    unsigned char* ws = p->ws;
    constexpr int J0 = 16 * 40, J1 = 256, J2 = 16 * 88, J3 = 44 * 16, J4 = 16 * 48, J5 = 32, J6 = 32, J7 = 256, J8 = 8 * 16 * 112;
    for (int it = it_lo + gw; it < it_hi; it += ngw) {
        const float* src; int ld, c0, k0, K, r0; size_t dsto; float scale = 1.f; bool f8 = false; const float* ksc = nullptr;
        int r = it;
        if (r < J0) { const int kb = r / 40, nb = r % 40, n0 = nb * 64; src = p->in[I_L0WIN]; ld = N0SRC; c0 = n0 < 1536 ? n0 : n0 + 8; k0 = kb * 64; dsto = WS_W0IN; K = 1024; r0 = n0; }
        else if ((r -= J0) < J1) { const int kb = r / 16, nb = r % 16; src = p->in[I_L0WOUT]; ld = 1024; c0 = nb * 64; k0 = kb * 64; dsto = WS_W0OUT; K = 1024; r0 = nb * 64; }
        else if ((r -= J1) < J2) { const int kb = r / 88, nb = r % 88, n0 = nb * 64, pn = n0 >> 8, j = n0 & 255; src = j < 128 ? p->in[I_L0WG] : p->in[I_L0WU]; ld = DFF; c0 = 128 * pn + (j & 127); k0 = kb * 64; dsto = WS_W0GU; K = 1024; r0 = n0; ksc = p->in[I_L0N2G]; }
        else if ((r -= J2) < J3) { const int kb = r / 16, nb = r % 16; src = p->in[I_L0WD]; ld = 1024; c0 = nb * 64; k0 = kb * 64; dsto = WS_W0D; K = DFF; r0 = nb * 64; }
        else if ((r -= J3) < J4) { const int kb = r / 48, nb = r % 48; src = p->in[I_L1WIN]; ld = N1SRC; c0 = nb * 64; k0 = kb * 64; dsto = WS_W1IN; K = 1024; r0 = nb * 64; }
        else if ((r -= J4) < J5) { const int h = r >> 2, kb = (r >> 1) & 1, nb = r & 1; src = p->in[I_L1WQ] + (size_t)h * 16384; ld = 128; c0 = nb * 64; k0 = kb * 64; dsto = WS_WQ + (size_t)h * 32768; K = 128; r0 = nb * 64; }
        else if ((r -= J5) < J6) { const int h = r >> 2, kb = (r >> 1) & 1, nb = r & 1; src = p->in[I_L1WK] + (size_t)h * 16384; ld = 128; c0 = nb * 64; k0 = kb * 64; dsto = WS_WK + (size_t)h * 32768; K = 128; r0 = nb * 64; scale = 0.08838834764831845f; }
        else if ((r -= J6) < J7) { const int kb = r / 16, nb = r % 16; src = p->in[I_L1WOUT]; ld = 1024; c0 = nb * 64; k0 = kb * 64; dsto = WS_W1OUT; K = 1024; r0 = nb * 64; }
        else if ((r -= J7) < J8) { const int e = r / (16 * 112), q = r % (16 * 112), kb = q / 112, nb = q % 112, n0 = nb * 64, pn = n0 >> 8, j = n0 & 255;
            src = (j < 128 ? p->in[I_L1EG] : p->in[I_L1EU]) + (size_t)e * 1024 * DFFE; ld = DFFE; c0 = 128 * pn + (j & 127); k0 = kb * 64; dsto = WS_EGU8 + (size_t)e * 7168 * 1024; K = 1024; r0 = n0; f8 = true; scale = 32.f; }
        else { r -= J8; const int e = r / (56 * 16), q = r % (56 * 16), kb = q / 16, nb = q % 16;
            src = p->in[I_L1ED] + (size_t)e * DFFE * 1024; ld = 1024; c0 = nb * 64; k0 = kb * 64; dsto = WS_ED8 + (size_t)e * 1024 * DFFE; K = DFFE; r0 = nb * 64; f8 = true; scale = 64.f; }
        if (f8) cvt_item8(src, ld, c0, k0, ws + dsto, K, r0, scale, scr, lane);
        else cvt_item(src, ld, c0, k0, (bf16*)(ws + dsto), K, r0, scale, scr, lane, ksc);
    }
}

struct CvDesc { const float* src; const float* ksc; size_t dsto; int ld, c0, k0, K, r0, f8; float scale; int pad_; };
__device__ __forceinline__ void cv_decode(KPp p, int it, CvDesc& d) {
    constexpr int J0 = 16 * 40, J1 = 256, J2 = 16 * 88, J3 = 44 * 16, J4 = 16 * 48, J5 = 32, J6 = 32, J7 = 256, J8 = 8 * 16 * 112;
    const float* src; int ld, c0, k0, K, r0; size_t dsto; float scale = 1.f; bool f8 = false; const float* ksc = nullptr;
    int r = it;
    if (r < J0) { const int kb = r / 40, nb = r % 40, n0 = nb * 64; src = p->in[I_L0WIN]; ld = N0SRC; c0 = n0 < 1536 ? n0 : n0 + 8; k0 = kb * 64; dsto = WS_W0IN; K = 1024; r0 = n0; }
    else if ((r -= J0) < J1) { const int kb = r / 16, nb = r % 16; src = p->in[I_L0WOUT]; ld = 1024; c0 = nb * 64; k0 = kb * 64; dsto = WS_W0OUT; K = 1024; r0 = nb * 64; }
    else if ((r -= J1) < J2) { const int kb = r / 88, nb = r % 88, n0 = nb * 64, pn = n0 >> 8, j = n0 & 255; src = j < 128 ? p->in[I_L0WG] : p->in[I_L0WU]; ld = DFF; c0 = 128 * pn + (j & 127); k0 = kb * 64; dsto = WS_W0GU; K = 1024; r0 = n0; ksc = p->in[I_L0N2G]; }
    else if ((r -= J2) < J3) { const int kb = r / 16, nb = r % 16; src = p->in[I_L0WD]; ld = 1024; c0 = nb * 64; k0 = kb * 64; dsto = WS_W0D; K = DFF; r0 = nb * 64; }
    else if ((r -= J3) < J4) { const int kb = r / 48, nb = r % 48; src = p->in[I_L1WIN]; ld = N1SRC; c0 = nb * 64; k0 = kb * 64; dsto = WS_W1IN; K = 1024; r0 = nb * 64; }
    else if ((r -= J4) < J5) { const int h = r >> 2, kb = (r >> 1) & 1, nb = r & 1; src = p->in[I_L1WQ] + (size_t)h * 16384; ld = 128; c0 = nb * 64; k0 = kb * 64; dsto = WS_WQ + (size_t)h * 32768; K = 128; r0 = nb * 64; }
    else if ((r -= J5) < J6) { const int h = r >> 2, kb = (r >> 1) & 1, nb = r & 1; src = p->in[I_L1WK] + (size_t)h * 16384; ld = 128; c0 = nb * 64; k0 = kb * 64; dsto = WS_WK + (size_t)h * 32768; K = 128; r0 = nb * 64; scale = 0.08838834764831845f; }
    else if ((r -= J6) < J7) { const int kb = r / 16, nb = r % 16; src = p->in[I_L1WOUT]; ld = 1024; c0 = nb * 64; k0 = kb * 64; dsto = WS_W1OUT; K = 1024; r0 = nb * 64; }
    else if ((r -= J7) < J8) { const int e = r / (16 * 112), q = r % (16 * 112), kb = q / 112, nb = q % 112, n0 = nb * 64, pn = n0 >> 8, j = n0 & 255;
        src = (j < 128 ? p->in[I_L1EG] : p->in[I_L1EU]) + (size_t)e * 1024 * DFFE; ld = DFFE; c0 = 128 * pn + (j & 127); k0 = kb * 64; dsto = WS_EGU8 + (size_t)e * 7168 * 1024; K = 1024; r0 = n0; f8 = true; scale = 32.f; }
    else { r -= J8; const int e = r / (56 * 16), q = r % (56 * 16), kb = q / 16, nb = q % 16;
        src = p->in[I_L1ED] + (size_t)e * DFFE * 1024; ld = 1024; c0 = nb * 64; k0 = kb * 64; dsto = WS_ED8 + (size_t)e * 1024 * DFFE; K = DFFE; r0 = nb * 64; f8 = true; scale = 64.f; }
    d.src = src; d.ld = ld; d.c0 = c0; d.k0 = k0; d.K = K; d.r0 = r0; d.dsto = dsto; d.scale = scale; d.f8 = f8 ? 1 : 0; d.ksc = ksc; d.pad_ = 0;
}
__device__ __forceinline__ void cv_load(const CvDesc& d, f32x4 (&v)[16], int lane) {
    const GAS float* s = (const GAS float*)d.src + (size_t)d.k0 * d.ld + d.c0;
#pragma unroll
    for (int i = 0; i < 16; ++i) v[i] = __builtin_nontemporal_load((const GAS f32x4*)(s + (size_t)(4 * i + (lane >> 4)) * d.ld + 4 * (lane & 15)));
}
__device__ __forceinline__ void cv_finish(const CvDesc& d, unsigned char* ws, const f32x4 (&v)[16], LAS float* scr, int lane) {
#pragma unroll
    for (int i = 0; i < 16; ++i) { LAS float* q = scr + (4 * i + (lane >> 4)) * 65 + 4 * (lane & 15); q[0] = v[i][0]; q[1] = v[i][1]; q[2] = v[i][2]; q[3] = v[i][3]; }
    LDS_WAIT(); asm volatile("" ::: "memory");
    if (d.f8) { unsigned char* dst = ws + d.dsto; const float scale = d.scale; const int c = lane & 3;
#pragma unroll
        for (int j = 0; j < 4; ++j) { const int n = (lane >> 2) + 16 * j; const LAS float* q = scr + (16 * c) * 65 + n;
            v4u o; o.x = pg8::pk4_fp8(q[0] * scale, q[65] * scale, q[130] * scale, q[195] * scale); o.y = pg8::pk4_fp8(q[260] * scale, q[325] * scale, q[390] * scale, q[455] * scale);
            o.z = pg8::pk4_fp8(q[520] * scale, q[585] * scale, q[650] * scale, q[715] * scale); o.w = pg8::pk4_fp8(q[780] * scale, q[845] * scale, q[910] * scale, q[975] * scale);
            __builtin_nontemporal_store(o, (GAS v4u*)(dst + (size_t)(d.r0 + n) * d.K + d.k0 + 16 * c)); }
    } else { bf16* dst = (bf16*)(ws + d.dsto); const int c = lane & 7; float ks[8];
#pragma unroll
        for (int i = 0; i < 8; ++i) ks[i] = d.ksc ? d.scale * d.ksc[d.k0 + 8 * c + i] : d.scale;
#pragma unroll
        for (int j = 0; j < 8; ++j) { const int n = (lane >> 3) + 8 * j; const LAS float* q = scr + (8 * c) * 65 + n;
            v4u o; o.x = pk2(q[0] * ks[0], q[65] * ks[1]); o.y = pk2(q[130] * ks[2], q[195] * ks[3]); o.z = pk2(q[260] * ks[4], q[325] * ks[5]); o.w = pk2(q[390] * ks[6], q[455] * ks[7]);
            __builtin_nontemporal_store(o, (GAS v4u*)(dst + (size_t)(d.r0 + n) * d.K + d.k0 + 8 * c)); }
    }
    LDS_WAIT(); asm volatile("" ::: "memory");
}
__device__ __forceinline__ void convert_queue(KPp p, LAS unsigned char* lds, unsigned* ctr, int it_lo, int n, int tid, int lane, int wave) {
    LAS int* slot = (LAS int*)(lds + 135168);
    LAS float* scr = (LAS float*)(lds + wave * 16640);
    unsigned char* ws = p->ws;
    int b0 = 0, b1 = 0; if (tid == 0) { b0 = (int)atomicAdd(ctr, 8u); b1 = (int)atomicAdd(ctr, 8u); }
    if (tid == 0) slot[0] = b0;
    __syncthreads();
    const int base0 = slot[0];
    __syncthreads();
    if (base0 >= n) return;
    bool hasc = base0 + wave < n;
    CvDesc dc; cv_decode(p, it_lo + (hasc ? base0 + wave : base0), dc);
    f32x4 va[16]; if (hasc) cv_load(dc, va, lane);
#pragma unroll 1
    for (;;) {
        if (tid == 0) { slot[0] = b1; b1 = (int)atomicAdd(ctr, 8u); }
        __syncthreads();
        const int nbase = slot[0];
        __syncthreads();
        const bool more = nbase < n, hasn = more && (nbase + wave < n);
        CvDesc dn = dc; f32x4 vb[16];
        if (hasn) { cv_decode(p, it_lo + nbase + wave, dn); cv_load(dn, vb, lane); }
        if (hasc) cv_finish(dc, ws, va, scr, lane);
        if (!more) break;
        dc = dn; hasc = hasn;
#pragma unroll
        for (int i = 0; i < 16; ++i) va[i] = vb[i];
    }
}

template <int MODE, bool SRCB> __device__ __forceinline__ void norm_phase(KPp p, LAS unsigned char* lds, int tid, int lane, int wave, const void* src, const float* gain, bf16* dst) {
    constexpr int NC = MODE == 0 ? 0 : (MODE == 2 ? 16 : 8);
    unsigned char* ws = p->ws;
    LAS float* wt = (LAS float*)lds;
    LAS float* gt = (LAS float*)(lds + 65536);
    LAS int* et = (LAS int*)(lds + 65536 + 4096);
    LAS int* lr = et + 128; LAS float* gl = (LAS float*)(et + 256); LAS int* eb = et + 384;
    LAS unsigned char* rc = lds + 73728;
    v4u cb[4][2], nb[4][2]; f32x4 cf[4][2][2], nf[4][2][2];
#define NP_LOAD(RB, RF, BLK, BT) do { const int row0_ = (BLK) * 64 + wave * 8 + (BT) * 4; \
        _Pragma("unroll") for (int r_ = 0; r_ < 4; ++r_) _Pragma("unroll") for (int j_ = 0; j_ < 2; ++j_) { \
            if (SRCB) RB[r_][j_] = *(const GAS v4u*)((const bf16*)src + (size_t)(row0_ + r_) * DMODEL + 8 * lane + 512 * j_); \
            else { const GAS f32x4* xr_ = (const GAS f32x4*)((const float*)src + (size_t)(row0_ + r_) * DMODEL + 8 * lane + 512 * j_); RF[r_][j_][0] = xr_[0]; RF[r_][j_][1] = xr_[1]; } } } while (0)
    if ((int)blockIdx.x < MROWS / 64) NP_LOAD(cb, cf, (int)blockIdx.x, 0);
    if (NC) {
        const float* wsrc = MODE == 1 ? p->in[I_L0WIN] + 1536 : MODE == 2 ? p->in[I_L1WIN] + 3072 : p->in[I_L1RT];
        const int wld = MODE == 1 ? N0SRC : MODE == 2 ? N1SRC : 8;
        for (int k = tid; k < 1024; k += NTHR) {
#pragma unroll
            for (int c4 = 0; c4 < NC / 4; ++c4) { const f32x4 w = *(const GAS f32x4*)(wsrc + (size_t)k * wld + 4 * c4);
                wt[(4 * c4 + 0) * 1024 + k] = w[0]; wt[(4 * c4 + 1) * 1024 + k] = w[1]; wt[(4 * c4 + 2) * 1024 + k] = w[2]; wt[(4 * c4 + 3) * 1024 + k] = w[3]; }
        }
        __syncthreads();
    }
    float g[2][8];
#pragma unroll
    for (int j = 0; j < 2; ++j) { const f32x4 a = *(const GAS f32x4*)(gain + 8 * lane + 512 * j), c = *(const GAS f32x4*)(gain + 8 * lane + 512 * j + 4);
        g[j][0] = a[0]; g[j][1] = a[1]; g[j][2] = a[2]; g[j][3] = a[3]; g[j][4] = c[0]; g[j][5] = c[1]; g[j][6] = c[2]; g[j][7] = c[3]; }
    for (int blk = blockIdx.x; blk < MROWS / 64; blk += gridDim.x) {
#pragma unroll 1
        for (int bt = 0; bt < 2; ++bt) {
            const int rl0 = wave * 8 + bt * 4;
            { const int nblk = bt ? blk + (int)gridDim.x : blk; if (nblk < MROWS / 64) NP_LOAD(nb, nf, nblk, bt ^ 1); }
            float v[4][2][8];
#pragma unroll
            for (int r = 0; r < 4; ++r) { const int row = blk * 64 + rl0 + r; float ss = 0.f;
#pragma unroll
                for (int j = 0; j < 2; ++j) {
                    if (SRCB) { const v4u x = cb[r][j];
                        v[r][j][0] = bflo(x.x); v[r][j][1] = bfhi(x.x); v[r][j][2] = bflo(x.y); v[r][j][3] = bfhi(x.y); v[r][j][4] = bflo(x.z); v[r][j][5] = bfhi(x.z); v[r][j][6] = bflo(x.w); v[r][j][7] = bfhi(x.w); }
                    else { const f32x4 a = cf[r][j][0], c = cf[r][j][1];
                        v[r][j][0] = a[0]; v[r][j][1] = a[1]; v[r][j][2] = a[2]; v[r][j][3] = a[3]; v[r][j][4] = c[0]; v[r][j][5] = c[1]; v[r][j][6] = c[2]; v[r][j][7] = c[3]; }
#pragma unroll
                    for (int e = 0; e < 8; ++e) ss += v[r][j][e] * v[r][j][e]; }
                const float rstd = rsqrtf(wave_sum(ss) * (1.f / DMODEL) + EPS);
#pragma unroll
                for (int j = 0; j < 2; ++j) {
#pragma unroll
                    for (int e = 0; e < 8; ++e) v[r][j][e] = v[r][j][e] * rstd * g[j][e];
                    v4u o; o.x = pk2(v[r][j][0], v[r][j][1]); o.y = pk2(v[r][j][2], v[r][j][3]); o.z = pk2(v[r][j][4], v[r][j][5]); o.w = pk2(v[r][j][6], v[r][j][7]);
                    if (MODE != 3) *(GAS v4u*)(dst + (size_t)row * DMODEL + 8 * lane + 512 * j) = o;
                    else { typedef unsigned u32x2 __attribute__((ext_vector_type(2))); *(LAS u32x2*)(rc + (rl0 + r) * 1024 + 8 * lane + 512 * j) = (u32x2){pg8::pk4_fp8(4.f * v[r][j][0], 4.f * v[r][j][1], 4.f * v[r][j][2], 4.f * v[r][j][3]), pg8::pk4_fp8(4.f * v[r][j][4], 4.f * v[r][j][5], 4.f * v[r][j][6], 4.f * v[r][j][7])}; } } }
            if (NC) {
                constexpr int NP = 4 * (NC ? NC : 1);
                float pt[NP];
#pragma unroll
                for (int c = 0; c < NC; ++c) {
                    f32x4 w[2][2];
#pragma unroll
                    for (int j = 0; j < 2; ++j) { w[j][0] = *(const LAS f32x4*)(wt + c * 1024 + 8 * lane + 512 * j); w[j][1] = *(const LAS f32x4*)(wt + c * 1024 + 8 * lane + 512 * j + 4); }
#pragma unroll
                    for (int r = 0; r < 4; ++r) { float s = 0.f;
#pragma unroll
                        for (int j = 0; j < 2; ++j) s += (v[r][j][0] * w[j][0][0] + v[r][j][1] * w[j][0][1]) + (v[r][j][2] * w[j][0][2] + v[r][j][3] * w[j][0][3]) + (v[r][j][4] * w[j][1][0] + v[r][j][5] * w[j][1][1]) + (v[r][j][6] * w[j][1][2] + v[r][j][7] * w[j][1][3]);
                        pt[r * NC + c] = s; } }
                if (NP == 32) {
#pragma unroll
                    for (int i = 0; i < NP; ++i) pt[i] += __shfl_xor(pt[i], 32); }
#pragma unroll
                for (int hh = NP / 2, mask = (NP == 64 ? 32 : 16); hh >= 1; hh >>= 1, mask >>= 1) { const bool up = (lane & mask) != 0;
#pragma unroll
                    for (int i = 0; i < hh; ++i) { const float keep = up ? pt[i + hh] : pt[i], send = up ? pt[i] : pt[i + hh]; pt[i] = keep + __shfl_xor(send, mask); } }
                const int pi = lane & (NP - 1);
                if (lane < NP) gt[(rl0 + pi / NC) * 16 + (pi % NC)] = pt[0];
            }
#pragma unroll
            for (int r = 0; r < 4; ++r)
#pragma unroll
                for (int j = 0; j < 2; ++j) { if (SRCB) cb[r][j] = nb[r][j]; else { cf[r][j][0] = nf[r][j][0]; cf[r][j][1] = nf[r][j][1]; } }
        }
        if (MODE == 3) {
            __syncthreads();
            if (wave == 0) { float a[8];
#pragma unroll
                for (int c = 0; c < 8; ++c) a[c] = gt[lane * 16 + c];
                int e1 = 0; float l1 = a[0];
#pragma unroll
                for (int c = 1; c < 8; ++c) if (a[c] > l1) { l1 = a[c]; e1 = c; }
                int e2 = -1; float l2 = -INFINITY;
#pragma unroll
                for (int c = 0; c < 8; ++c) if (c != e1 && a[c] > l2) { l2 = a[c]; e2 = c; }
                const float g1 = 1.f / (1.f + expf(l2 - l1)), g2 = 1.f - g1;
                int r1 = 0, r2 = 0, mycnt = 0;
#pragma unroll
                for (int e = 0; e < 8; ++e) { const unsigned long long m = __ballot(e1 == e || e2 == e);
                    const int before = (int)__builtin_amdgcn_mbcnt_hi((unsigned)(m >> 32), __builtin_amdgcn_mbcnt_lo((unsigned)m, 0u));
                    if (e1 == e) r1 = before; if (e2 == e) r2 = before; if (lane == e) mycnt = __popcll(m); }
                et[lane * 2] = e1; et[lane * 2 + 1] = e2; gl[lane * 2] = g1; gl[lane * 2 + 1] = g2; lr[lane * 2] = r1; lr[lane * 2 + 1] = r2;
                if (lane < 8) eb[lane] = (int)atomicAdd((unsigned*)(ws + WS_CTL) + CW_CNT + 32 * lane, (unsigned)mycnt); }
        }
        if (NC) {
            __syncthreads();
            const int row = blk * 64 + lane, h = wave;
            if (MODE == 1) {
                const float lf = log_sigmoid(gt[lane * 16 + h] + p->in[I_L0BF][h]); const float cs = scan_add(lf, lane);
                ((float*)(ws + WS_FLOC0))[row * 8 + h] = cs; if (lane == 63) ((float*)(ws + WS_FTOT0))[blk * 8 + h] = cs;
            } else if (MODE == 2) {
                const float li = gt[lane * 16 + h] + p->in[I_L1BI][h]; const float lf = log_sigmoid(gt[lane * 16 + 8 + h] + p->in[I_L1BF][h]); const float cs = scan_add(lf, lane);
                ((float*)(ws + WS_FLOC1))[row * 8 + h] = cs; ((float*)(ws + WS_IG1))[row * 8 + h] = li;
                const float gm = wave_max(li - cs);
                if (lane == 63) { ((float*)(ws + WS_FTOT1))[blk * 8 + h] = cs; ((float*)(ws + WS_GMAX1))[blk * 8 + h] = gm; }
            } else if (MODE == 3) {
                for (int rr = 0; rr < 8; ++rr) { const int rl = wave * 8 + rr; const v4u rowv = *(const LAS v4u*)(rc + rl * 1024 + lane * 16);
#pragma unroll
                    for (int k = 0; k < 2; ++k) { const int e = et[rl * 2 + k]; const int sr = e * 16384 + eb[e] + lr[rl * 2 + k];
                        if (lane == 0) { ((int*)(ws + WS_TOKS))[(blk * 64 + rl) * 2 + k] = sr; ((float*)(ws + WS_SGATE2))[sr] = gl[rl * 2 + k]; }
                        *(GAS v4u*)(ws + WS_AG8 + (size_t)sr * 1024 + lane * 16) = rowv; } }
            }
            __syncthreads();
        }
    }
}

__device__ __forceinline__ void final_phase(KPp p, int lane, int wave) {
    unsigned char* ws = p->ws; const bf16* Y = (const bf16*)(ws + WS_Y); const bf16* X = (const bf16*)(ws + WS_X);
    float g[2][8];
#pragma unroll
    for (int j = 0; j < 2; ++j) { const f32x4 a = *(const GAS f32x4*)(p->in[I_FNG] + 8 * lane + 512 * j), c = *(const GAS f32x4*)(p->in[I_FNG] + 8 * lane + 512 * j + 4);
        g[j][0] = a[0]; g[j][1] = a[1]; g[j][2] = a[2]; g[j][3] = a[3]; g[j][4] = c[0]; g[j][5] = c[1]; g[j][6] = c[2]; g[j][7] = c[3]; }
    int ct[8]; { int acc = 0;
#pragma unroll
        for (int e = 0; e < 8; ++e) { ct[e] = acc; acc += (int)((((const unsigned*)(ws + WS_CTL))[CW_CNT + 32 * e] + 255) >> 8); } }
    for (int row = blockIdx.x * NWAVES + wave; row < MROWS; row += gridDim.x * NWAVES) {
        const int r1 = ((const int*)(ws + WS_TOKS))[row * 2], r2 = ((const int*)(ws + WS_TOKS))[row * 2 + 1];
        int c1 = 0, c2 = 0;
#pragma unroll
        for (int k = 1; k < 8; ++k) { if ((r1 >> 14) >= k) c1 = ct[k]; if ((r2 >> 14) >= k) c2 = ct[k]; }
        const int s1 = c1 * 256 + (r1 & 16383), s2 = c2 * 256 + (r2 & 16383);
        float v[2][8]; float ss = 0.f; const bf16* YS = (const bf16*)(ws + WS_YS);
#pragma unroll
        for (int j = 0; j < 2; ++j) { const int c0 = 8 * lane + 512 * j; const v4u zz = {0u, 0u, 0u, 0u}; const v4u x = *(const GAS v4u*)(X + (size_t)row * DMODEL + c0), y1 = s1 < 32768 ? *(const GAS v4u*)(Y + (size_t)s1 * DMODEL + c0) : zz, y2 = s2 < 32768 ? *(const GAS v4u*)(Y + (size_t)s2 * DMODEL + c0) : zz;
            v[j][0] = bflo(x.x) + bflo(y1.x) + bflo(y2.x); v[j][1] = bfhi(x.x) + bfhi(y1.x) + bfhi(y2.x); v[j][2] = bflo(x.y) + bflo(y1.y) + bflo(y2.y); v[j][3] = bfhi(x.y) + bfhi(y1.y) + bfhi(y2.y);
            v[j][4] = bflo(x.z) + bflo(y1.z) + bflo(y2.z); v[j][5] = bfhi(x.z) + bfhi(y1.z) + bfhi(y2.z); v[j][6] = bflo(x.w) + bflo(y1.w) + bflo(y2.w); v[j][7] = bfhi(x.w) + bfhi(y1.w) + bfhi(y2.w);
#pragma unroll
            for (int q = 0; q < 2; ++q) { const int sq = q ? s2 : s1; if (sq >= 32768) {
                for (int ks = 0; ks < 7; ++ks) { const v4u y = *(const GAS v4u*)(YS + ((size_t)ks * 2048 + (sq - 32768)) * DMODEL + c0);
                    v[j][0] += bflo(y.x); v[j][1] += bfhi(y.x); v[j][2] += bflo(y.y); v[j][3] += bfhi(y.y); v[j][4] += bflo(y.z); v[j][5] += bfhi(y.z); v[j][6] += bflo(y.w); v[j][7] += bfhi(y.w); } } }
#pragma unroll
            for (int e = 0; e < 8; ++e) ss += v[j][e] * v[j][e]; }
        const float rstd = rsqrtf(wave_sum(ss) * (1.f / DMODEL) + EPS);
#pragma unroll
        for (int j = 0; j < 2; ++j) { GAS f32x4* o = (GAS f32x4*)(p->out + (size_t)row * DMODEL + 8 * lane + 512 * j);
            o[0] = (f32x4){v[j][0] * rstd * g[j][0], v[j][1] * rstd * g[j][1], v[j][2] * rstd * g[j][2], v[j][3] * rstd * g[j][3]};
            o[1] = (f32x4){v[j][4] * rstd * g[j][4], v[j][5] * rstd * g[j][5], v[j][6] * rstd * g[j][6], v[j][7] * rstd * g[j][7]}; }
    }
}

__device__ __forceinline__ float fast_sigmoid(float z) { return __builtin_amdgcn_rcpf(1.0f + __builtin_amdgcn_exp2f(-1.4426950408889634f * z)); }
__device__ __forceinline__ void conv_phase(KPp p, LAS unsigned char* lds, int tid, int lane, int wave) {
    unsigned char* ws = p->ws; const bf16* P0 = (const bf16*)(ws + WS_R); bf16* CAT = (bf16*)(ws + WS_CAT);
    LAS bf16* ub = (LAS bf16*)lds;
    LAS float* yt = (LAS float*)(lds + 96256);
    const int c = tid;
    float w[31];
#pragma unroll
    for (int j = 0; j < 31; ++j) w[j] = p->in[I_L0DWW][j * 512 + c];
    const float bias = p->in[I_L0DWB][c];
    const f32x4 ga = *(const GAS f32x4*)(p->in[I_L0CLNG] + lane * 8), gb = *(const GAS f32x4*)(p->in[I_L0CLNG] + lane * 8 + 4), ba = *(const GAS f32x4*)(p->in[I_L0CLNB] + lane * 8), bb = *(const GAS f32x4*)(p->in[I_L0CLNB] + lane * 8 + 4);
    for (int u = blockIdx.x; u < MROWS / 64; u += gridDim.x) {
        const int row0 = u * 64, b = row0 / SEQ, t0 = row0 % SEQ;
        {
            v4u av[12], gv[12];
#pragma unroll
            for (int i = 0; i < 12; ++i) { const int q = tid + NTHR * i, r = q >> 6, ch = q & 63, t = t0 - 30 + r; av[i] = (v4u){0u, 0u, 0u, 0u}; gv[i] = av[i];
                if (r < 94 && t >= 0) { const bf16* s = P0 + (size_t)(b * SEQ + t) * N0 + 1536 + 8 * ch; av[i] = *(const GAS v4u*)s; gv[i] = *(const GAS v4u*)(s + 512); } }
#pragma unroll
            for (int i = 0; i < 12; ++i) { const int q = tid + NTHR * i, r = q >> 6, ch = q & 63;
                if (r < 94) { v4u o;
                    o.x = pk2(bflo(av[i].x) * fast_sigmoid(bflo(gv[i].x)), bfhi(av[i].x) * fast_sigmoid(bfhi(gv[i].x))); o.y = pk2(bflo(av[i].y) * fast_sigmoid(bflo(gv[i].y)), bfhi(av[i].y) * fast_sigmoid(bfhi(gv[i].y)));
                    o.z = pk2(bflo(av[i].z) * fast_sigmoid(bflo(gv[i].z)), bfhi(av[i].z) * fast_sigmoid(bfhi(gv[i].z))); o.w = pk2(bflo(av[i].w) * fast_sigmoid(bflo(gv[i].w)), bfhi(av[i].w) * fast_sigmoid(bfhi(gv[i].w)));
                    *(LAS v4u*)(ub + r * 512 + 8 * ch) = o; } }
        }
        __syncthreads();
        for (int sub = 0; sub < 4; ++sub) {
            float y[16];
#pragma unroll
            for (int i = 0; i < 16; ++i) y[i] = bias;
            const LAS bf16* ucol = ub + (sub * 16) * 512 + c;
#pragma unroll
            for (int r = 0; r < 46; ++r) { const float uv = bf2f(ucol[r * 512]);
#pragma unroll
                for (int i = 0; i < 16; ++i) { const int j = r - i; if (j >= 0 && j <= 30) y[i] += w[j] * uv; } }
#pragma unroll
            for (int i = 0; i < 16; ++i) yt[i * 512 + c] = y[i];
            __syncthreads();
#pragma unroll
            for (int k = 0; k < 2; ++k) { const int i = wave * 2 + k;
                const f32x4 v0 = *(const LAS f32x4*)(yt + i * 512 + lane * 8), v1 = *(const LAS f32x4*)(yt + i * 512 + lane * 8 + 4);
                const float mu = wave_sum((v0[0] + v0[1]) + (v0[2] + v0[3]) + (v1[0] + v1[1]) + (v1[2] + v1[3])) * (1.f / 512.f);
                const f32x4 d0 = v0 - mu, d1 = v1 - mu;
                const float var = wave_sum((d0[0] * d0[0] + d0[1] * d0[1]) + (d0[2] * d0[2] + d0[3] * d0[3]) + (d1[0] * d1[0] + d1[1] * d1[1]) + (d1[2] * d1[2] + d1[3] * d1[3])) * (1.f / 512.f);
                const float rstd = rsqrtf(var + EPS);
                f32x4 o0 = d0 * rstd * ga + ba, o1 = d1 * rstd * gb + bb;
#pragma unroll
                for (int e = 0; e < 4; ++e) { o0[e] = o0[e] * fast_sigmoid(o0[e]); o1[e] = o1[e] * fast_sigmoid(o1[e]); }
                v4u o; o.x = pk2(o0[0], o0[1]); o.y = pk2(o0[2], o0[3]); o.z = pk2(o1[0], o1[1]); o.w = pk2(o1[2], o1[3]);
                *(GAS v4u*)(CAT + (size_t)(row0 + sub * 16 + i) * 1024 + 512 + lane * 8) = o; }
            __syncthreads();
        }
    }
}
namespace ml {
typedef float f32x16 __attribute__((ext_vector_type(16)));
typedef short s16x4 __attribute__((ext_vector_type(4)));
typedef unsigned u32x2 __attribute__((ext_vector_type(2)));
constexpr int LD = 136, LDV = 160, LDK = 160, LDP = 72, LDH = 132;
constexpr int O_QL = 0, O_KL = 17408, O_KP = 34816, O_VL = 55296, O_PL = 75776, O_SL = 93184, O_TB = 136704;
constexpr int O_PLB = 75776, O_HSB = 84992, O_SLB = 102400, O_TBB = 145920;
constexpr int T_FPRE = 0, T_MST = 128, T_G2 = 272, T_M2 = 336, T_WI = 400, T_EDM = 464, T_NQ = 528, T_WS = 592, T_CW = 656, T_HG = 1296, T_END = 1296 + 128, T_DB2 = T_END;
static_assert(O_TB + T_END * 4 <= SCR_BYTES && O_TBB + (T_DB2 + 320) * 4 <= SCR_BYTES, "mlstm lds");
__device__ __forceinline__ f32x16 mfma32(bf16x8 a, bf16x8 b, f32x16 c) { return __builtin_amdgcn_mfma_f32_32x32x16_bf16(a, b, c, 0, 0, 0); }
__device__ __forceinline__ const LAS bf16* tr_lane(const LAS bf16* X, int ldx, int lane) { const int g4 = lane >> 4, hh = g4 >> 1, cg = g4 & 1, i = lane & 15, q = i >> 2, pp = i & 3; return X + (8 * hh + q) * ldx + 16 * cg + 4 * pp; }
__device__ __forceinline__ bf16x8 tr_frag(const LAS bf16* a, int ldx, int off) {
    const s16x4 lo = __builtin_bit_cast(s16x4, __builtin_amdgcn_ds_read_tr16_b64_v4i16((LAS s16x4*)(a + off)));
    const s16x4 hi = __builtin_bit_cast(s16x4, __builtin_amdgcn_ds_read_tr16_b64_v4i16((LAS s16x4*)(a + off + 4 * ldx)));
    return (bf16x8){lo[0], lo[1], lo[2], lo[3], hi[0], hi[1], hi[2], hi[3]};
}
#define ML_BAR() asm volatile("s_waitcnt lgkmcnt(0)\n\ts_barrier" ::: "memory")
#define ML_LAUNDER(ptr) asm volatile("" : "+v"(ptr))
__device__ __forceinline__ f32x16 mma_nt8(f32x16 acc, const LAS bf16* a, const LAS bf16* b) {
#pragma unroll
    for (int ks = 0; ks < 8; ++ks) acc = mfma32(*(const LAS bf16x8*)(a + 16 * ks), *(const LAS bf16x8*)(b + 16 * ks), acc);
    return acc;
}
__device__ __forceinline__ void st4(LAS bf16* d, float a, float b, float c, float e) { *(LAS u32x2*)d = (u32x2){pk2(a, b), pk2(c, e)}; }
__device__ __forceinline__ void gate_setup(const unsigned char* ws, LAS float* tb, int b, int h, int lane, int wave) {
    if (wave == 0) {
        const float* ft = (const float*)(ws + WS_FTOT1); const float* gm = (const float*)(ws + WS_GMAX1);
        const float a0 = ft[(b * 128 + lane) * 8 + h], a1 = ft[(b * 128 + 64 + lane) * 8 + h];
        const float s0 = scan_add(a0, lane), s1 = scan_add(a1, lane) + __shfl(s0, 63);
        const float f0 = s0 - a0, f1 = s1 - a1;
        tb[T_FPRE + lane] = f0; tb[T_FPRE + 64 + lane] = f1;
        const float m0 = scan_max(gm[(b * 128 + lane) * 8 + h] - f0, lane); const float m1 = fmaxf(scan_max(gm[(b * 128 + 64 + lane) * 8 + h] - f1, lane), __shfl(m0, 63));
        tb[T_MST + 1 + lane] = fmaxf(m0, 0.f); tb[T_MST + 65 + lane] = fmaxf(m1, 0.f); if (lane == 0) tb[T_MST] = 0.f;
    }
}
__device__ __forceinline__ void unpack16(const v4u x0, const v4u x1, float (&f)[16]) {
    f[0] = bflo(x0.x); f[1] = bfhi(x0.x); f[2] = bflo(x0.y); f[3] = bfhi(x0.y); f[4] = bflo(x0.z); f[5] = bfhi(x0.z); f[6] = bflo(x0.w); f[7] = bfhi(x0.w);
    f[8] = bflo(x1.x); f[9] = bfhi(x1.x); f[10] = bflo(x1.y); f[11] = bfhi(x1.y); f[12] = bflo(x1.z); f[13] = bfhi(x1.z); f[14] = bflo(x1.w); f[15] = bfhi(x1.w);
}
__device__ __forceinline__ void pack16(const float (&f)[16], v4u& x0, v4u& x1) {
    x0.x = pk2(f[0], f[1]); x0.y = pk2(f[2], f[3]); x0.z = pk2(f[4], f[5]); x0.w = pk2(f[6], f[7]); x1.x = pk2(f[8], f[9]); x1.y = pk2(f[10], f[11]); x1.z = pk2(f[12], f[13]); x1.w = pk2(f[14], f[15]);
}

__device__ __forceinline__ void pass_a(KPp p, LAS unsigned char* lds, int tid, int lane, int wave) {
    unsigned char* ws = p->ws;
    const bf16* P1 = (const bf16*)(ws + WS_R); bf16* Q1 = (bf16*)(ws + WS_Q1); bf16* K1 = (bf16*)(ws + WS_K1); float* TST = (float*)(ws + WS_TST);
    const float* FLOC1 = (const float*)(ws + WS_FLOC1); const float* IG1 = (const float*)(ws + WS_IG1);
    LAS bf16* Ql = (LAS bf16*)(lds + O_QL); LAS bf16* Kl = (LAS bf16*)(lds + O_KL); LAS bf16* Kp = (LAS bf16*)(lds + O_KP); LAS bf16* Vl = (LAS bf16*)(lds + O_VL); LAS bf16* Ul = (LAS bf16*)(lds + O_PL);
    LAS bf16* Xl0 = (LAS bf16*)(lds + O_SL);
    LAS float* tb = (LAS float*)(lds + O_TB);
    const int r = lane & 31, hh = lane >> 5, vtile = wave & 3, kt0 = 2 * (wave >> 2), t = tid >> 3, dg = tid & 7;
    const unsigned voffX = (unsigned)(t * N1 + 16 * dg), voffQ = (unsigned)(t * 1024 + 16 * dg), voffG = (unsigned)(t * 8);
    const LAS bf16* const trV = tr_lane(Vl, LDV, lane); const LAS bf16* const trK = tr_lane(Kp, LDK, lane);
#define ML_XLOAD(cidx, x0_, x1_, h0_, h1_) do { const bf16* xs_ = P1 + ((size_t)b * SEQ + (size_t)(cidx) * 64) * N1 + h * 128; x0_ = *(const GAS v4u*)(xs_ + voffX); x1_ = *(const GAS v4u*)(xs_ + voffX + 8); \
        h0_ = (v4u){0u, 0u, 0u, 0u}; h1_ = h0_; if (t < 3 && (cidx) > 0) { const bf16* hs_ = xs_ - (size_t)3 * N1; h0_ = *(const GAS v4u*)(hs_ + voffX); h1_ = *(const GAS v4u*)(hs_ + voffX + 8); } } while (0)
#define ML_XSTORE(xb, x0_, x1_, h0_, h1_) do { *(LAS v4u*)((xb) + (t + 3) * LD + 16 * dg) = x0_; *(LAS v4u*)((xb) + (t + 3) * LD + 16 * dg + 8) = x1_; \
        if (t < 3) { *(LAS v4u*)((xb) + t * LD + 16 * dg) = h0_; *(LAS v4u*)((xb) + t * LD + 16 * dg + 8) = h1_; } } while (0)
    for (int unit = blockIdx.x; unit < 256; unit += gridDim.x) {
        const int b = unit >> 7, h = (unit >> 4) & 7, j = unit & 15;
        { v4u x0, x1, h0, h1; ML_XLOAD(8 * j, x0, x1, h0, h1); ML_XSTORE(Xl0, x0, x1, h0, h1); }
        gate_setup(ws, tb, b, h, lane, wave);
        for (int idx = tid; idx < 640; idx += NTHR) { const int jj = idx >> 7, d = idx & 127; tb[T_CW + idx] = jj < 4 ? p->in[I_L1CW][jj * 1024 + h * 128 + d] : p->in[I_L1CB][h * 128 + d]; }
        *(LAS u32x2*)(Vl + t * LDV + 128 + 4 * dg) = (u32x2){dg == 0 ? 0x3F80u : 0u, 0u};
        bf16x8 wf[8];
        { const bf16* wsrc = (const bf16*)(ws + (wave < 4 ? WS_WQ : WS_WK)) + (size_t)(h * 128 + (wave & 3) * 32 + r) * 128 + 8 * hh;
#pragma unroll
          for (int ks = 0; ks < 8; ++ks) wf[ks] = *(const GAS bf16x8*)(wsrc + 16 * ks); }
        f32x16 aT0 = {}, aT1 = {}, aN = {};
        ML_BAR();
        const float Mend = tb[T_MST + 8 * j + 8];
#pragma unroll 1
        for (int cc = 0; cc < 8; ++cc) {
            const int c = 8 * j + cc; const size_t row0 = (size_t)b * SEQ + c * 64;
            const LAS bf16* Xl = Xl0 + (cc & 1) * (67 * LD); LAS bf16* Xn = Xl0 + ((cc & 1) ^ 1) * (67 * LD);
            const LAS bf16* tV = trV; const LAS bf16* tK = trK; ML_LAUNDER(tV); ML_LAUNDER(tK);
            const LAS bf16* tVv = tV + vtile * 32; const LAS bf16* tKk = tK + kt0 * 32; const LAS bf16* tKw = tK + wave * 32;
            {
                const bf16* vs = P1 + row0 * N1 + 1024 + h * 128; const v4u v0 = *(const GAS v4u*)(vs + voffX), v1 = *(const GAS v4u*)(vs + voffX + 8);
                const float gi = (IG1 + row0 * 8 + h)[voffG], fl = (FLOC1 + row0 * 8 + h)[voffG];
                float yv[16];
#pragma unroll
                for (int i = 0; i < 16; ++i) yv[i] = tb[T_CW + 512 + 16 * dg + i];
#pragma unroll
                for (int jj = 0; jj < 4; ++jj) { float xf[16]; unpack16(*(const LAS v4u*)(Xl + (t + jj) * LD + 16 * dg), *(const LAS v4u*)(Xl + (t + jj) * LD + 16 * dg + 8), xf);
#pragma unroll
                    for (int i = 0; i < 16; ++i) yv[i] += tb[T_CW + jj * 128 + 16 * dg + i] * xf[i]; }
#pragma unroll
                for (int i = 0; i < 16; ++i) yv[i] = yv[i] * fast_sigmoid(yv[i]);
                v4u u0, u1; pack16(yv, u0, u1); *(LAS v4u*)(Ul + t * LD + 16 * dg) = u0; *(LAS v4u*)(Ul + t * LD + 16 * dg + 8) = u1;
                *(LAS v4u*)(Vl + t * LDV + 16 * dg) = v0; *(LAS v4u*)(Vl + t * LDV + 16 * dg + 8) = v1;
                if (dg == 0) tb[T_WS + t] = expf(gi - (tb[T_FPRE + c] + fl) - Mend);
            }
            ML_BAR();
            {
                f32x16 a0 = {}, a1 = {}; const LAS bf16* ub = Ul + r * LD + 8 * hh; const int et = wave & 3;
#pragma unroll
                for (int ks = 0; ks < 8; ++ks) { a0 = mfma32(wf[ks], *(const LAS bf16x8*)(ub + 16 * ks), a0); a1 = mfma32(wf[ks], *(const LAS bf16x8*)(ub + 32 * LD + 16 * ks), a1); }
                if (wave < 4) {
#pragma unroll
                    for (int g = 0; g < 4; ++g) { const int e0 = et * 32 + 8 * g + 4 * hh;
                        st4(Ql + r * LD + e0, a0[4 * g], a0[4 * g + 1], a0[4 * g + 2], a0[4 * g + 3]); st4(Ql + (32 + r) * LD + e0, a1[4 * g], a1[4 * g + 1], a1[4 * g + 2], a1[4 * g + 3]); }
                } else { const float w0 = tb[T_WS + r], w1 = tb[T_WS + 32 + r];
#pragma unroll
                    for (int g = 0; g < 4; ++g) { const int e0 = et * 32 + 8 * g + 4 * hh;
                        st4(Kl + r * LD + e0, a0[4 * g], a0[4 * g + 1], a0[4 * g + 2], a0[4 * g + 3]); st4(Kl + (32 + r) * LD + e0, a1[4 * g], a1[4 * g + 1], a1[4 * g + 2], a1[4 * g + 3]);
                        st4(Kp + r * LDK + e0, a0[4 * g] * w0, a0[4 * g + 1] * w0, a0[4 * g + 2] * w0, a0[4 * g + 3] * w0); st4(Kp + (32 + r) * LDK + e0, a1[4 * g] * w1, a1[4 * g + 1] * w1, a1[4 * g + 2] * w1, a1[4 * g + 3] * w1); } }
            }
            ML_BAR();
            {
                v4u x0 = {}, x1 = {}, h0 = {}, h1 = {};
                if (cc < 7) ML_XLOAD(c + 1, x0, x1, h0, h1);
                bf16* qd = Q1 + row0 * 1024 + h * 128; bf16* kd = K1 + row0 * 1024 + h * 128;
                *(GAS v4u*)(qd + voffQ) = *(const LAS v4u*)(Ql + t * LD + 16 * dg); *(GAS v4u*)(qd + voffQ + 8) = *(const LAS v4u*)(Ql + t * LD + 16 * dg + 8);
                *(GAS v4u*)(kd + voffQ) = *(const LAS v4u*)(Kl + t * LD + 16 * dg); *(GAS v4u*)(kd + voffQ + 8) = *(const LAS v4u*)(Kl + t * LD + 16 * dg + 8);
#pragma unroll
                for (int ks = 0; ks < 4; ++ks) { const bf16x8 bv = tr_frag(tVv, LDV, 16 * ks * LDV), a0 = tr_frag(tKk, LDK, 16 * ks * LDK), a1 = tr_frag(tKk, LDK, 16 * ks * LDK + 32);
                    aT0 = mfma32(a0, bv, aT0); aT1 = mfma32(a1, bv, aT1); }
                if (wave < 4) {
#pragma unroll
                    for (int ks = 0; ks < 4; ++ks) { const bf16x8 bn = tr_frag(tV, LDV, 16 * ks * LDV + 128), a = tr_frag(tKw, LDK, 16 * ks * LDK); aN = mfma32(a, bn, aN); } }
                if (cc < 7) ML_XSTORE(Xn, x0, x1, h0, h1);
            }
            ML_BAR();
        }
        {
            bf16* T = (bf16*)TST + ((size_t)unit * 8 + wave) * (12 * 64 * 4) + lane * 4;
#pragma unroll
            for (int g = 0; g < 4; ++g) { *(GAS u32x2*)(T + g * 256) = (u32x2){pk2(aT0[4 * g], aT0[4 * g + 1]), pk2(aT0[4 * g + 2], aT0[4 * g + 3])};
                *(GAS u32x2*)(T + (4 + g) * 256) = (u32x2){pk2(aT1[4 * g], aT1[4 * g + 1]), pk2(aT1[4 * g + 2], aT1[4 * g + 3])};
                if (wave < 4) *(GAS u32x2*)(T + (8 + g) * 256) = (u32x2){pk2(aN[4 * g], aN[4 * g + 1]), pk2(aN[4 * g + 2], aN[4 * g + 3])}; }
        }
    }
#undef ML_XLOAD
#undef ML_XSTORE
}

__device__ __forceinline__ void pass_b(KPp p, LAS unsigned char* lds, int tid, int lane, int wave) {
    unsigned char* ws = p->ws;
    const bf16* P1 = (const bf16*)(ws + WS_R); const bf16* Q1 = (const bf16*)(ws + WS_Q1); const bf16* K1 = (const bf16*)(ws + WS_K1); const float* TST = (const float*)(ws + WS_TST); bf16* CAT = (bf16*)(ws + WS_CAT);
    const float* FLOC1 = (const float*)(ws + WS_FLOC1); const float* IG1 = (const float*)(ws + WS_IG1);
    LAS bf16* Ql = (LAS bf16*)(lds + O_QL); LAS bf16* Kl = (LAS bf16*)(lds + O_KL); LAS bf16* Kp = (LAS bf16*)(lds + O_KP); LAS bf16* Vl = (LAS bf16*)(lds + O_VL); LAS bf16* Pl = (LAS bf16*)(lds + O_PLB);
    LAS bf16* Sl = (LAS bf16*)(lds + O_SLB); LAS bf16* Hst = (LAS bf16*)(lds + O_HSB); LAS float* tb = (LAS float*)(lds + O_TBB);
    const int r = lane & 31, hh = lane >> 5, vth = wave >> 1, ttile = wave & 1, vtile = wave & 3, kt0 = 2 * (wave >> 2), t = tid >> 3, dg = tid & 7;
    const unsigned voffX = (unsigned)(t * N1 + 16 * dg), voffQ = (unsigned)(t * 1024 + 16 * dg), voffG = (unsigned)(t * 8);
    const LAS bf16* const trV = tr_lane(Vl, LDV, lane); const LAS bf16* const trK = tr_lane(Kp, LDK, lane);
    for (int unit = blockIdx.x; unit < 256; unit += gridDim.x) {
        const int b = unit >> 7, h = (unit >> 4) & 7, j = unit & 15;
        v4u nq0, nq1, nk0, nk1, nv0, nv1; float ngi, nfl, ngil = 0.f, nfll = 0.f;
#define ML_LOAD_B(cidx) do { const size_t rw_ = (size_t)b * SEQ + (size_t)(cidx) * 64; const bf16* qs_ = Q1 + rw_ * 1024 + h * 128; const bf16* ks2_ = K1 + rw_ * 1024 + h * 128; const bf16* vs_ = P1 + rw_ * N1 + 1024 + h * 128; \
            nq0 = *(const GAS v4u*)(qs_ + voffQ); nq1 = *(const GAS v4u*)(qs_ + voffQ + 8); nk0 = *(const GAS v4u*)(ks2_ + voffQ); nk1 = *(const GAS v4u*)(ks2_ + voffQ + 8); nv0 = *(const GAS v4u*)(vs_ + voffX); nv1 = *(const GAS v4u*)(vs_ + voffX + 8); \
            ngi = (IG1 + rw_ * 8 + h)[voffG]; nfl = (FLOC1 + rw_ * 8 + h)[voffG]; if (wave == 0) { ngil = (IG1 + rw_ * 8 + h)[lane * 8]; nfll = (FLOC1 + rw_ * 8 + h)[lane * 8]; } } while (0)
        ML_LOAD_B(8 * j);
        gate_setup(ws, tb, b, h, lane, wave);
        if (tid < 128) tb[T_HG + tid] = p->in[I_L1HG][h * 128 + tid];
        *(LAS u32x2*)(Vl + t * LDV + 128 + 4 * dg) = (u32x2){dg == 0 ? 0x3F80u : 0u, 0u};
        ML_BAR();
        f32x16 S0 = {}, S1 = {}, SN = {};
        { const float Mstart = tb[T_MST + 8 * j];
#pragma unroll 4
          for (int jp = 0; jp < j; ++jp) { const float wgt = expf(tb[T_MST + 8 * jp + 8] - Mstart); const bf16* T = (const bf16*)TST + ((size_t)(unit - j + jp) * 8 + wave) * (12 * 64 * 4) + lane * 4;
#pragma unroll
              for (int g = 0; g < 4; ++g) { const u32x2 x0 = *(const GAS u32x2*)(T + g * 256), x1 = *(const GAS u32x2*)(T + (4 + g) * 256);
                  S0[4 * g] += wgt * bflo(x0.x); S0[4 * g + 1] += wgt * bfhi(x0.x); S0[4 * g + 2] += wgt * bflo(x0.y); S0[4 * g + 3] += wgt * bfhi(x0.y);
                  S1[4 * g] += wgt * bflo(x1.x); S1[4 * g + 1] += wgt * bfhi(x1.x); S1[4 * g + 2] += wgt * bflo(x1.y); S1[4 * g + 3] += wgt * bfhi(x1.y);
                  if (wave < 4) { const u32x2 xn = *(const GAS u32x2*)(T + (8 + g) * 256);
                      SN[4 * g] += wgt * bflo(xn.x); SN[4 * g + 1] += wgt * bfhi(xn.x); SN[4 * g + 2] += wgt * bflo(xn.y); SN[4 * g + 3] += wgt * bfhi(xn.y); } } } }
#define ML_WRITE_SL() do { _Pragma("unroll") for (int g = 0; g < 4; ++g) { const int k0 = kt0 * 32 + 8 * g + 4 * hh; \
            st4(Sl + (vtile * 32 + r) * LD + k0, S0[4 * g], S0[4 * g + 1], S0[4 * g + 2], S0[4 * g + 3]); st4(Sl + (vtile * 32 + r) * LD + k0 + 32, S1[4 * g], S1[4 * g + 1], S1[4 * g + 2], S1[4 * g + 3]); \
            if (wave < 4) st4(Sl + (128 + r) * LD + wave * 32 + 8 * g + 4 * hh, SN[4 * g], SN[4 * g + 1], SN[4 * g + 2], SN[4 * g + 3]); } } while (0)
        ML_WRITE_SL();
        v4u oc0, oc1;
#define ML_STEP1(cidx, par_, more_) do { const int c_ = (cidx); const float Mc_ = tb[T_MST + c_], Mc1_ = tb[T_MST + c_ + 1], Fp_ = tb[T_FPRE + c_]; const int to_ = (par_) ? (T_DB2 - T_G2) : 0; \
            const bf16* os_ = P1 + ((size_t)b * SEQ + (size_t)c_ * 64) * N1 + 2048 + h * 128; oc0 = *(const GAS v4u*)(os_ + voffX); oc1 = *(const GAS v4u*)(os_ + voffX + 8); \
            const float w_ = expf(ngi - (Fp_ + nfl) - Mc1_); \
            *(LAS v4u*)(Ql + t * LD + 16 * dg) = nq0; *(LAS v4u*)(Ql + t * LD + 16 * dg + 8) = nq1; *(LAS v4u*)(Kl + t * LD + 16 * dg) = nk0; *(LAS v4u*)(Kl + t * LD + 16 * dg + 8) = nk1; \
            *(LAS v4u*)(Vl + t * LDV + 16 * dg) = nv0; *(LAS v4u*)(Vl + t * LDV + 16 * dg + 8) = nv1; \
            float kf_[16]; unpack16(nk0, nk1, kf_); _Pragma("unroll") for (int i = 0; i < 16; ++i) kf_[i] *= w_; \
            v4u p0_, p1_; pack16(kf_, p0_, p1_); *(LAS v4u*)(Kp + t * LDK + 16 * dg) = p0_; *(LAS v4u*)(Kp + t * LDK + 16 * dg + 8) = p1_; \
            if (wave == 0) { const float F_ = Fp_ + nfll; const float Gl_ = ngil - F_; const float M_ = fmaxf(Mc_, scan_max(Gl_, lane)); \
                tb[T_G2 + to_ + lane] = Gl_ * LOG2E; tb[T_M2 + to_ + lane] = M_ * LOG2E; tb[T_WI + to_ + lane] = expf(Mc_ - M_); tb[T_EDM + to_ + lane] = expf(-(F_ + M_)); } \
            if (more_) ML_LOAD_B(c_ + 1); } while (0)
        ML_STEP1(8 * j, 0, true);
        ML_BAR();
#pragma unroll 1
        for (int cc = 0; cc < 8; ++cc) {
            const int c = 8 * j + cc; const size_t row0 = (size_t)b * SEQ + c * 64; const int to = (cc & 1) ? (T_DB2 - T_G2) : 0;
            const float Mc = tb[T_MST + c], Mc1 = tb[T_MST + c + 1];
            const LAS bf16* tV = trV; const LAS bf16* tK = trK; ML_LAUNDER(tV); ML_LAUNDER(tK);
            const LAS bf16* tVv = tV + vtile * 32; const LAS bf16* tVh = tV + vth * 32; const LAS bf16* tKk = tK + kt0 * 32; const LAS bf16* tKw = tK + wave * 32;
            f32x16 aH = {}, aNq = {};
            {
                const LAS bf16* qb = Ql + (ttile * 32 + r) * LD + 8 * hh;
                aH = mma_nt8(aH, Sl + (vth * 32 + r) * LD + 8 * hh, qb);
                if (wave < 4) { const int stile = wave >> 1; f32x16 aP = {}; aP = mma_nt8(aP, Kl + (stile * 32 + r) * LD + 8 * hh, qb);
                    const int tq = ttile * 32 + r; const float m2 = tb[T_M2 + to + tq];
#pragma unroll
                    for (int g = 0; g < 4; ++g) { const int s0 = stile * 32 + 8 * g + 4 * hh; const f32x4 gg = *(const LAS f32x4*)(tb + T_G2 + to + s0); float pv[4];
#pragma unroll
                        for (int i = 0; i < 4; ++i) pv[i] = (s0 + i <= tq) ? aP[4 * g + i] * __builtin_amdgcn_exp2f(gg[i] - m2) : 0.f;
                        st4(Pl + tq * LDP + s0, pv[0], pv[1], pv[2], pv[3]); }
                } else if (wave < 6) { aNq = mma_nt8(aNq, Sl + (128 + r) * LD + 8 * hh, qb); }
            }
            ML_BAR();
            {
                const float wi = tb[T_WI + to + ttile * 32 + r];
#pragma unroll
                for (int i = 0; i < 16; ++i) aH[i] *= wi;
                const LAS bf16* pb = Pl + (ttile * 32 + r) * LDP + 8 * hh;
#pragma unroll
                for (int ks = 0; ks < 4; ++ks) aH = mfma32(tr_frag(tVh, LDV, 16 * ks * LDV), *(const LAS bf16x8*)(pb + 16 * ks), aH);
                if (wave >= 4 && wave < 6) {
#pragma unroll
                    for (int i = 0; i < 16; ++i) aNq[i] *= wi;
#pragma unroll
                    for (int ks = 0; ks < 4; ++ks) aNq = mfma32(tr_frag(tV, LDV, 16 * ks * LDV + 128), *(const LAS bf16x8*)(pb + 16 * ks), aNq);
                    if (hh == 0) tb[T_NQ + to + ttile * 32 + r] = aNq[0]; }
                { const int tq = ttile * 32 + r;
#pragma unroll
                  for (int g = 0; g < 4; ++g) st4(Hst + tq * LD + vth * 32 + 8 * g + 4 * hh, aH[4 * g], aH[4 * g + 1], aH[4 * g + 2], aH[4 * g + 3]); }
                const float dec = expf(Mc - Mc1);
#pragma unroll
                for (int i = 0; i < 16; ++i) { S0[i] *= dec; S1[i] *= dec; SN[i] *= dec; }
#pragma unroll
                for (int ks = 0; ks < 4; ++ks) { const bf16x8 bv = tr_frag(tVv, LDV, 16 * ks * LDV), a0 = tr_frag(tKk, LDK, 16 * ks * LDK), a1 = tr_frag(tKk, LDK, 16 * ks * LDK + 32);
                    S0 = mfma32(a0, bv, S0); S1 = mfma32(a1, bv, S1); }
                if (wave < 4) {
#pragma unroll
                    for (int ks = 0; ks < 4; ++ks) { const bf16x8 bn = tr_frag(tV, LDV, 16 * ks * LDV + 128), a = tr_frag(tKw, LDK, 16 * ks * LDK); SN = mfma32(a, bn, SN); } }
                ML_WRITE_SL();
            }
            ML_BAR();
            {
                float hv[16]; unpack16(*(const LAS v4u*)(Hst + t * LD + 16 * dg), *(const LAS v4u*)(Hst + t * LD + 16 * dg + 8), hv);
                const float inv = 1.0f / fmaxf(fabsf(tb[T_NQ + to + t]), tb[T_EDM + to + t]);
                float of[16]; unpack16(oc0, oc1, of);
                float ss = 0.f;
#pragma unroll
                for (int i = 0; i < 16; ++i) { hv[i] *= inv * fast_sigmoid(of[i]); ss += hv[i] * hv[i]; }
                ss += __shfl_xor(ss, 1); ss += __shfl_xor(ss, 2); ss += __shfl_xor(ss, 4);
                const float rstd = rsqrtf(ss * (1.f / 128.f) + EPS);
#pragma unroll
                for (int i = 0; i < 16; ++i) hv[i] = hv[i] * rstd * tb[T_HG + 16 * dg + i];
                v4u o0, o1; pack16(hv, o0, o1); bf16* od = CAT + row0 * 1024 + h * 128; *(GAS v4u*)(od + voffQ) = o0; *(GAS v4u*)(od + voffQ + 8) = o1;
            }
            if (cc < 7) ML_STEP1(c + 1, (cc + 1) & 1, cc < 6);
            ML_BAR();
        }
#undef ML_STEP1
#undef ML_WRITE_SL
#undef ML_LOAD_B
    }
}
}
__global__ void __launch_bounds__(NTHR, 2) fwd_kernel(KP p_unused) {
    extern __shared__ __attribute__((aligned(16))) unsigned char lds_raw[];
    LAS unsigned char* lds = (LAS unsigned char*)lds_raw;
    volatile LAS unsigned* MISC = (volatile LAS unsigned*)(lds + MISC_OFF);
    const int G = gridDim.x;
#define PH_IDS int tid = threadIdx.x; asm volatile("" : "+v"(tid)); const int lane = tid & 63, wave = __builtin_amdgcn_readfirstlane(tid >> 6); (void)lane; (void)wave;
    KPp p = kp_get();
    unsigned char* ws = p->ws;
    gu32* ctl = (gu32*)(ws + WS_CTL);
    { int t0 = threadIdx.x; asm volatile("" : "+v"(t0)); for (int u = t0; u < (LDS_BYTES - MISC_OFF) / 4; u += NTHR) ((LAS unsigned*)(lds + MISC_OFF))[u] = 0u; }
    __syncthreads();
    { const int lo0 = p->ph_lo, hi0 = p->ph_hi;
      if (hi0 - lo0 > 1) (void)xcd_barrier_post((unsigned*)(ctl + CW_BAR), MISC + 8); }
#define IN(k) (((p = kp_get()), (ws = p->ws), true) && p->ph_lo <= (k) && (k) < p->ph_hi)
#define SEAM(k) do { if (IN(k) && IN((k) + 1)) { XcdBarrier bar_; bar_.bar = (unsigned*)((gu32*)(ws + WS_CTL) + CW_BAR); bar_.x = xb_xcc_id(); bar_.st = (volatile LAS unsigned*)((LAS unsigned char*)lds_raw + MISC_OFF) + 8; xcd_barrier(bar_); } } while (0)
#define H ((bf16*)(ws + WS_H))
#define SEAMX() do { XcdBarrier bar_; bar_.bar = (unsigned*)((gu32*)(ws + WS_CTL) + CW_BAR); bar_.x = xb_xcc_id(); bar_.st = (volatile LAS unsigned*)((LAS unsigned char*)lds_raw + MISC_OFF) + 8; xcd_barrier(bar_); } while (0)
    if (IN(0)) { PH_IDS convert_weights(p, lds, 0, (G == 256 ? CV_FIRST : CV_ALL), blockIdx.x * NWAVES + wave, G * NWAVES, lane, wave); __syncthreads();
        norm_phase<1, false>(p, lds, tid, lane, wave, p->in[I_X], p->in[I_L0N1G], H); }
    SEAM(0);
    if (IN(1)) { if (G != 256 || blockIdx.x < CV_GEMM1) { const int Gg = G == 256 ? CV_GEMM1 : G;
        pg8::Gemm g{H, (const bf16*)(ws + WS_W0IN), MROWS, N0, 1024}; pg8::StaticOrder S; S.init(MROWS, N0, Gg, (int)blockIdx.x);
        pg8::EpiL0In E{(bf16*)(ws + WS_R), N0, attn_body::C2, (float*)(ws + WS_QKN)};
        pg8::gemm_phase<pg8::EpiL0In, pg8::StaticOrder, true, true>(lds, g, S, E); }
        if (G == 256) { PH_IDS __syncthreads(); convert_queue(p, lds, (unsigned*)(ws + WS_CTL) + CW_Q1, CV_FIRST, CV_ALL - CV_TAIL2 - CV_Q2 - CV_FIRST, tid, lane, wave); }     }
    SEAM(1);
    if (IN(2)) { const attn_body::bf16* P0 = (const attn_body::bf16*)(ws + WS_R);
        const attn_body::AttnTensors AT{P0, P0 + 512, P0 + 1024, (attn_body::bf16*)(ws + WS_CAT), (const float*)(ws + WS_FLOC0), (const float*)(ws + WS_FTOT0), (const float*)(ws + WS_QKN)};
        const attn_body::StaticOrder S(G, (int)blockIdx.x);
        attn_body::attn_phase<attn_body::StaticOrder>((char*)lds_raw, AT, S);
        __syncthreads();
        { PH_IDS conv_phase(p, lds, tid, lane, wave); if (G == 256) convert_queue(p, lds, (unsigned*)(ws + WS_CTL) + CW_Q2, CV_ALL - CV_TAIL2 - CV_Q2, CV_Q2, tid, lane, wave); } }
    SEAM(2);
    if (IN(3)) { pg8::Gemm g{(const bf16*)(ws + WS_CAT), (const bf16*)(ws + WS_W0OUT), MROWS, 1024, 1024}; pg8::StaticOrder S; S.init(MROWS, 1024, G, (int)blockIdx.x);
        pg8::EpiRes<true> E{p->in[I_X], (bf16*)(ws + WS_X), 1024, (float*)(ws + WS_ROWSS)};
        pg8::gemm_phase<pg8::EpiRes<true>, pg8::StaticOrder, true, true>(lds, g, S, E); }
    SEAM(3);
    if (IN(4)) { pg8::Gemm g{(const bf16*)(ws + WS_X), (const bf16*)(ws + WS_W0GU), MROWS, 2 * DFF, 1024};     pg8::StaticOrder S; S.init(MROWS, 2 * DFF, G, (int)blockIdx.x);
        pg8::EpiSwiGLU E{(bf16*)(ws + WS_R), DFF, (const float*)(ws + WS_ROWSS)};
        pg8::gemm_phase<pg8::EpiSwiGLU, pg8::StaticOrder, true, true>(lds, g, S, E);
        if (G == 256 && blockIdx.x >= 128) { PH_IDS __syncthreads(); convert_weights(p, lds, CV_ALL - CV_TAIL2, CV_ALL, (blockIdx.x - 128) * NWAVES + wave, 128 * NWAVES, lane, wave); } }
    SEAM(4);
    if (IN(5)) { pg8::Gemm g{(const bf16*)(ws + WS_R), (const bf16*)(ws + WS_W0D), MROWS, 1024, DFF}; pg8::StaticOrder S; S.init(MROWS, 1024, G, (int)blockIdx.x);
        pg8::EpiRes<false> E{ws + WS_X, (bf16*)(ws + WS_X), 1024, nullptr};
        pg8::gemm_phase<pg8::EpiRes<false>, pg8::StaticOrder, true, true>(lds, g, S, E); }
    SEAM(5);
    if (IN(6)) { PH_IDS norm_phase<2, true>(p, lds, tid, lane, wave, ws + WS_X, p->in[I_L1N1G], H); }
    SEAM(6);
    if (IN(7)) { pg8::Gemm g{H, (const bf16*)(ws + WS_W1IN), MROWS, N1, 1024}; pg8::StaticOrder S; S.init(MROWS, N1, G, (int)blockIdx.x);
        pg8::EpiBf16<0> E{(bf16*)(ws + WS_R), N1, nullptr, 0, 0, 1.f};
        pg8::gemm_phase<pg8::EpiBf16<0>, pg8::StaticOrder, true, true>(lds, g, S, E); }
    SEAM(7);
    if (IN(8)) { PH_IDS ml::pass_a(p, lds, tid, lane, wave); }
    SEAM(8);
    if (IN(9)) { PH_IDS ml::pass_b(p, lds, tid, lane, wave); }
    SEAM(9);
    if (IN(10)) { pg8::Gemm g{(const bf16*)(ws + WS_CAT), (const bf16*)(ws + WS_W1OUT), MROWS, 1024, 1024}; pg8::StaticOrder S; S.init(MROWS, 1024, G, (int)blockIdx.x);
        pg8::EpiRes<false> E{ws + WS_X, (bf16*)(ws + WS_X), 1024, nullptr};
        pg8::gemm_phase<pg8::EpiRes<false>, pg8::StaticOrder, true, true>(lds, g, S, E); }
    SEAM(10);
    if (IN(11)) { PH_IDS norm_phase<3, true>(p, lds, tid, lane, wave, ws + WS_X, p->in[I_L1N2G], H); }
    SEAM(11);
    if (IN(12)) { pg8::Gemm8 g{ws + WS_AG8, ws + WS_EGU8, MOE_ROWS, 2 * DFFE, 1024}; pg8::MoeOrder S; S.init((const unsigned*)(ws + WS_CTL) + CW_CNT, 2 * DFFE / 256, G, (int)blockIdx.x, true, (unsigned*)(ws + WS_CTL) + CW_RDY);
        pg8::EpiSwiGLU8 E{ws + WS_ACTM8, DFFE, 0.0078125f, 4.f};
        pg8::gemm_phase_f8<pg8::EpiSwiGLU8, pg8::MoeOrder, true, true>(lds, g, S, E); }
    if (IN(13)) { pg8::Gemm8 g{ws + WS_ACTM8, ws + WS_ED8, MOE_ROWS, 1024, DFFE}; pg8::MoeDownOrder S; S.init((const unsigned*)(ws + WS_CTL) + CW_CNT, G, (int)blockIdx.x, (const unsigned*)(ws + WS_CTL) + CW_RDY);
        pg8::EpiRowScale E{(bf16*)(ws + WS_Y), 1024, (const float*)(ws + WS_SGATE2), 0.00390625f, (bf16*)(ws + WS_YS)};
        pg8::gemm_phase_f8<pg8::EpiRowScale, pg8::MoeDownOrder, true, true>(lds, g, S, E); }
    SEAM(13);
    if (IN(14)) { PH_IDS final_phase(p, lane, wave); }
#undef IN
#undef SEAM
#undef SEAMX
#undef H
#undef PH_IDS
}

extern "C" void kernel_launch(void* const* d_in, const int* in_sizes, int n_in, void* d_out, int out_size, void* d_ws, size_t ws_size, hipStream_t stream) {
    static int grid = 0;
    if (grid == 0) {
        if (n_in != 29 || in_sizes[0] != MROWS * DMODEL || out_size != MROWS * DMODEL || ws_size < WS_END) { fprintf(stderr, "kernel_launch: unexpected problem (n_in %d, ws %zu < %zu?)\n", n_in, ws_size, (size_t)WS_END); grid = -1; return; }
        int dev = 0, cus = 0, per_cu = 0;
        if (hipGetDevice(&dev) != hipSuccess || hipDeviceGetAttribute(&cus, hipDeviceAttributeMultiprocessorCount, dev) != hipSuccess) { grid = -1; return; }
        if (hipFuncSetAttribute((const void*)fwd_kernel, hipFuncAttributeMaxDynamicSharedMemorySize, LDS_BYTES) != hipSuccess) { fprintf(stderr, "kernel_launch: hipFuncSetAttribute failed\n"); grid = -1; return; }
        if (hipOccupancyMaxActiveBlocksPerMultiprocessor(&per_cu, (const void*)fwd_kernel, NTHR, LDS_BYTES) != hipSuccess || per_cu < 1) { fprintf(stderr, "kernel_launch: occupancy query says %d\n", per_cu); }
        (void)hipGetLastError();
        grid = cus > 256 ? 256 : cus;
    }
    if (grid < 0) return;
    (void)hipMemsetAsync((char*)d_ws + WS_CTL, 0, CTL_ZERO_BYTES, stream);
    KP a{};
    for (int i = 0; i < 29; ++i) a.in[i] = (const float*)d_in[i];
    a.out = (float*)d_out; a.ws = (unsigned char*)d_ws;
#if MK_ONE_LAUNCH
    a.ph_lo = 0; a.ph_hi = NPHASE;
    hipLaunchKernelGGL(fwd_kernel, dim3(grid), dim3(NTHR), LDS_BYTES, stream, a);
#else
    for (int ph = 0; ph < NPHASE; ++ph) { a.ph_lo = ph; a.ph_hi = ph + 1; hipLaunchKernelGGL(fwd_kernel, dim3(grid), dim3(NTHR), LDS_BYTES, stream, a); }
#endif
}
```

```cpp
#include <hip/hip_runtime.h>
#include <cstdio>
#include <cstdint>
#include <cmath>
#ifndef WGM_D
#define WGM_D 2
#endif
#ifndef WGM_M
#define WGM_M 2
#endif
#ifndef MK_ONE_LAUNCH
#define MK_ONE_LAUNCH 1
#endif
namespace pg8 {
#define PG8_LAS __attribute__((address_space(3)))
typedef unsigned short bf16_t;
typedef short bf16x8 __attribute__((ext_vector_type(8)));
typedef float f32x4 __attribute__((ext_vector_type(4)));
typedef unsigned u32x4 __attribute__((ext_vector_type(4)));
constexpr int BM = 256, BK = 64, HALF = 128, HTB = HALF * BK * 2  , STAGE_BYTES = 8 * HTB, NXCD = 8, WGM = 8, WGM_DENSE = WGM_D, WGM_MOE = WGM_M;

__host__ __device__ __forceinline__ int lds_byte(int r, int c) { const int st = (r >> 4) * 2 + (c >> 5), rr = r & 15, cc = c & 31, ob = rr * 64 + cc * 2; return st * 1024 + (ob ^ (((ob >> 9) & 1) << 5)); }
__host__ __device__ __forceinline__ void stage_rc(int b, int& R, int& C) { const int st = b / 1024, sb = b % 1024, swz = sb ^ (((sb >> 9) & 1) << 5); R = (st >> 1) * 16 + swz / 64; C = (st & 1) * 32 + (swz % 64) / 2; }
__host__ __device__ __forceinline__ int perm32(int rho) { const int n = rho >> 4, i = rho & 15; return 8 * (i >> 2) + 4 * n + (i & 3); }

struct Unit { int pm, pn, pb, pa, ps, kt0, nkt, ys; };
struct Gemm { const bf16_t* A; const bf16_t* Bt; int M, N, K; };

struct StaticOrder {
    int nM, nN, nwg, G, c;
    __host__ __device__ void init(int M, int N, int G_, int c_) { nM = M / BM; nN = N / BM; nwg = nM * nN; G = G_; c = c_; }
    __host__ __device__ bool next(int i, Unit& u) const {
        const long L = (long)i * G + c; if (L >= nwg) return false;
        int wgid = (int)L; { const int q = nwg / NXCD, r = nwg % NXCD, xcd = wgid % NXCD, off = wgid / NXCD; wgid = (xcd < r ? xcd * (q + 1) : r * (q + 1) + (xcd - r) * q) + off; }
        const int nig = WGM_DENSE * nN, gid = wgid / nig, fm = gid * WGM_DENSE, gsz = (nM - fm) < WGM_DENSE ? (nM - fm) : WGM_DENSE;
        u.pm = fm + ((wgid % nig) % gsz); u.pn = (wgid % nig) / gsz; u.pb = u.pn; u.pa = u.pm; u.ps = u.pm; u.kt0 = 0; u.nkt = 0; u.ys = -1; return true;
    }
    __device__ __forceinline__ void a_ready(const Unit&) const {}
    __device__ __forceinline__ void done(const Unit&) const {}
};

__device__ __forceinline__ unsigned cvt_pk_bf16(float lo, float hi) { unsigned r; asm volatile("v_cvt_pk_bf16_f32 %0, %1, %2" : "=v"(r) : "v"(lo), "v"(hi)); return r; }
typedef float f32x2 __attribute__((ext_vector_type(2)));
__device__ __forceinline__ f32x2 gelu_pk(f32x2 v) {
    const f32x2 av = __builtin_elementwise_abs(v), d = av * 0.2316418882f + 1.0f;
    f32x2 t; t.x = __builtin_amdgcn_rcpf(d.x); t.y = __builtin_amdgcn_rcpf(d.y);
    f32x2 q = t * 0.5307027145f + (-0.7265760135f); q = q * t + 0.7107068705f; q = q * t + (-0.142248368f); q = q * t + 0.127414796f; q = q * t;
    const f32x2 s = (v * v) * (-0.72134752044f);
    f32x2 e; e.x = __builtin_amdgcn_exp2f(s.x); e.y = __builtin_amdgcn_exp2f(s.y);
    const f32x2 m = v * (q * e), r = v - m;
    f32x2 o; o.x = v.x < 0.f ? m.x : r.x; o.y = v.y < 0.f ? m.y : r.y; return o;
}

template <int ACT  > struct EpiBf16 {
    static constexpr bool PERM = true, AFTER_DRAIN = false; static_assert(ACT == 0 || ACT == 1, "EpiBf16: ACT is 0 (none) or 1 (gelu_pk)");
    bf16_t* O; int ldc; const float* bias; int split_cols; size_t split_stride; float scale0;
    __device__ __forceinline__ void operator()(const f32x4 (&acc)[2][2][4][2], const Unit& u, int wr, int wc, int fr, int fq) const {
        const int row0 = u.pm * BM + wr * 64 + fr; int colt = u.pn * BM; bf16_t* base = O;
        float sc = 1.f; if (split_cols) { const int t = colt / split_cols; base += (size_t)t * split_stride; colt -= t * split_cols; if (t == 0) sc = scale0; }
        const int col0 = colt + wc * 32 + 8 * fq, bcol0 = u.pn * BM + wc * 32 + 8 * fq;
        f32x4 bv[2][2];
#pragma unroll
        for (int bj = 0; bj < 2; ++bj)
#pragma unroll
            for (int n = 0; n < 2; ++n) bv[bj][n] = bias ? *(const f32x4*)(bias + bcol0 + bj * HALF + 4 * n) : (f32x4){0.f, 0.f, 0.f, 0.f};
#pragma unroll
        for (int ai = 0; ai < 2; ++ai)
#pragma unroll
            for (int m = 0; m < 4; ++m) { bf16_t* rowp = base + (size_t)(row0 + ai * HALF + m * 16) * ldc + col0;
#pragma unroll
                for (int bj = 0; bj < 2; ++bj) { f32x4 v0 = acc[ai][bj][m][0] + bv[bj][0], v1 = acc[ai][bj][m][1] + bv[bj][1];
                    if (ACT == 1) { f32x2 a = gelu_pk((f32x2){v0[0], v0[1]}), b = gelu_pk((f32x2){v0[2], v0[3]}), c = gelu_pk((f32x2){v1[0], v1[1]}), d = gelu_pk((f32x2){v1[2], v1[3]});
                        v0 = (f32x4){a.x, a.y, b.x, b.y}; v1 = (f32x4){c.x, c.y, d.x, d.y}; }
                    v0 = v0 * sc; v1 = v1 * sc; u32x4 w; w.x = cvt_pk_bf16(v0[0], v0[1]); w.y = cvt_pk_bf16(v0[2], v0[3]); w.z = cvt_pk_bf16(v1[0], v1[1]); w.w = cvt_pk_bf16(v1[2], v1[3]);
                    *(u32x4*)(rowp + bj * HALF) = w; } }
    }
};
__device__ __forceinline__ float silu_f(float g) { return g * __builtin_amdgcn_rcpf(1.0f + __builtin_amdgcn_exp2f(-1.4426950408889634f * g)); }
struct EpiL0In {
    static constexpr bool PERM = true, AFTER_DRAIN = false;
    bf16_t* O; int ldc; float scale0; float* qkn;
    __device__ __forceinline__ void operator()(const f32x4 (&acc)[2][2][4][2], const Unit& u, int wr, int wc, int fr, int fq) const {
        const int row0 = u.pm * BM + wr * 64 + fr, col0 = u.pn * BM + wc * 32 + 8 * fq; const float sc = u.pn < 2 ? scale0 : 1.f;
        float mx[2][2] = {{0.f, 0.f}, {0.f, 0.f}};
#pragma unroll
        for (int ai = 0; ai < 2; ++ai)
#pragma unroll
            for (int m = 0; m < 4; ++m) { bf16_t* rowp = O + (size_t)(row0 + ai * HALF + m * 16) * ldc + col0;
#pragma unroll
                for (int bj = 0; bj < 2; ++bj) { const f32x4 v0 = acc[ai][bj][m][0] * sc, v1 = acc[ai][bj][m][1] * sc;
                    u32x4 w; w.x = cvt_pk_bf16(v0[0], v0[1]); w.y = cvt_pk_bf16(v0[2], v0[3]); w.z = cvt_pk_bf16(v1[0], v1[1]); w.w = cvt_pk_bf16(v1[2], v1[3]);
                    *(u32x4*)(rowp + bj * HALF) = w;
                    if (u.pn < 4) { float s = 0.f;
#pragma unroll
                        for (int e = 0; e < 4; ++e) { const float lo = __uint_as_float(w[e] << 16), hi = __uint_as_float(w[e] & 0xffff0000u); s += lo * lo + hi * hi; }
                        s += __shfl_xor(s, 16); s += __shfl_xor(s, 32); mx[ai][bj] = fmaxf(mx[ai][bj], s); } } }
        if (u.pn < 4) {
#pragma unroll
            for (int ai = 0; ai < 2; ++ai)
#pragma unroll
                for (int bj = 0; bj < 2; ++bj) { float v = mx[ai][bj]; v = fmaxf(v, __shfl_xor(v, 1)); v = fmaxf(v, __shfl_xor(v, 2)); v = fmaxf(v, __shfl_xor(v, 4)); v = fmaxf(v, __shfl_xor(v, 8));
                    if (fr == 0 && fq == 0) qkn[(((size_t)(u.pn >> 1) * 256 + 4 * u.pm + 2 * ai + wr) * 8 + 4 * (u.pn & 1) + 2 * bj + (wc >> 1)) * 2 + (wc & 1)] = v; } }
    }
};
template <bool BASEF> struct EpiRes {
    static constexpr bool PERM = true, AFTER_DRAIN = false;
    const void* base; bf16_t* out; int ldc; float* rowss;
    __device__ __forceinline__ void operator()(const f32x4 (&acc)[2][2][4][2], const Unit& u, int wr, int wc, int fr, int fq) const {
        const int row0 = u.pm * BM + wr * 64 + fr, col0 = u.pn * BM + wc * 32 + 8 * fq;
#pragma unroll
        for (int ai = 0; ai < 2; ++ai)
#pragma unroll
            for (int m = 0; m < 4; ++m) { const size_t off = (size_t)(row0 + ai * HALF + m * 16) * ldc + col0; float ssq = 0.f;
#pragma unroll
                for (int bj = 0; bj < 2; ++bj) { f32x4 b0, b1;
                    if (BASEF) { b0 = *(const f32x4*)((const float*)base + off + bj * HALF); b1 = *(const f32x4*)((const float*)base + off + bj * HALF + 4); }
                    else { const u32x4 x = *(const u32x4*)((const bf16_t*)base + off + bj * HALF);
                        b0 = (f32x4){__uint_as_float(x.x << 16), __uint_as_float(x.x & 0xffff0000u), __uint_as_float(x.y << 16), __uint_as_float(x.y & 0xffff0000u)};
                        b1 = (f32x4){__uint_as_float(x.z << 16), __uint_as_float(x.z & 0xffff0000u), __uint_as_float(x.w << 16), __uint_as_float(x.w & 0xffff0000u)}; }
                    const f32x4 v0 = b0 + acc[ai][bj][m][0], v1 = b1 + acc[ai][bj][m][1];
                    u32x4 w; w.x = cvt_pk_bf16(v0[0], v0[1]); w.y = cvt_pk_bf16(v0[2], v0[3]); w.z = cvt_pk_bf16(v1[0], v1[1]); w.w = cvt_pk_bf16(v1[2], v1[3]);
                    *(u32x4*)(out + off + bj * HALF) = w;
                    if (rowss) {
#pragma unroll
                        for (int e = 0; e < 4; ++e) { const float lo = __uint_as_float(w[e] << 16), hi = __uint_as_float(w[e] & 0xffff0000u); ssq += lo * lo + hi * hi; } } }
                if (rowss) { ssq += __shfl_xor(ssq, 16); ssq += __shfl_xor(ssq, 32); if (fq == 0) rowss[(size_t)(row0 + ai * HALF + m * 16) * 16 + 4 * u.pn + wc] = ssq; } }
    }
};
struct EpiSwiGLU {
    static constexpr bool PERM = true, AFTER_DRAIN = false;
    bf16_t* O; int ldo; const float* rowss;
    __device__ __forceinline__ void operator()(const f32x4 (&acc)[2][2][4][2], const Unit& u, int wr, int wc, int fr, int fq) const {
        const int row0 = u.pm * BM + wr * 64 + fr, col0 = u.pn * HALF + wc * 32 + 8 * fq;
#pragma unroll
        for (int ai = 0; ai < 2; ++ai)
#pragma unroll
            for (int m = 0; m < 4; ++m) { bf16_t* rowp = O + (size_t)(row0 + ai * HALF + m * 16) * ldo + col0;
                float rs = 1.f; if (rowss) { const f32x4* q = (const f32x4*)(rowss + (size_t)(row0 + ai * HALF + m * 16) * 16); const f32x4 a = q[0], b = q[1], c = q[2], d = q[3];
                    rs = rsqrtf((((a[0] + a[1]) + (a[2] + a[3])) + ((b[0] + b[1]) + (b[2] + b[3])) + ((c[0] + c[1]) + (c[2] + c[3])) + ((d[0] + d[1]) + (d[2] + d[3]))) * (1.f / 1024.f) + 1e-6f); }
                const f32x4 g0 = acc[ai][0][m][0] * rs, g1 = acc[ai][0][m][1] * rs, u0 = acc[ai][1][m][0] * rs, u1 = acc[ai][1][m][1] * rs;
                u32x4 w; w.x = cvt_pk_bf16(silu_f(g0[0]) * u0[0], silu_f(g0[1]) * u0[1]); w.y = cvt_pk_bf16(silu_f(g0[2]) * u0[2], silu_f(g0[3]) * u0[3]);
                w.z = cvt_pk_bf16(silu_f(g1[0]) * u1[0], silu_f(g1[1]) * u1[1]); w.w = cvt_pk_bf16(silu_f(g1[2]) * u1[2], silu_f(g1[3]) * u1[3]);
                *(u32x4*)rowp = w; }
    }
};
__device__ __forceinline__ unsigned pk4_fp8(float a, float b, float c, float d) {
    a = __builtin_amdgcn_fmed3f(a, -448.f, 448.f); b = __builtin_amdgcn_fmed3f(b, -448.f, 448.f); c = __builtin_amdgcn_fmed3f(c, -448.f, 448.f); d = __builtin_amdgcn_fmed3f(d, -448.f, 448.f);
    unsigned w = 0u; w = __builtin_amdgcn_cvt_pk_fp8_f32(a, b, w, false); w = __builtin_amdgcn_cvt_pk_fp8_f32(c, d, w, true); return w;
}
struct EpiSwiGLU8 {
    static constexpr bool PERM = true, AFTER_DRAIN = false;
    unsigned char* O; int ldo; float si, so;
    __device__ __forceinline__ void operator()(const f32x4 (&acc)[2][2][4][2], const Unit& u, int wr, int wc, int fr, int fq) const {
        typedef unsigned u32x2 __attribute__((ext_vector_type(2)));
        const int row0 = u.pm * BM + wr * 64 + fr, col0 = u.pn * HALF + wc * 32 + 8 * fq; const float s2 = si * so;
#pragma unroll
        for (int ai = 0; ai < 2; ++ai)
#pragma unroll
            for (int m = 0; m < 4; ++m) { const unsigned off_ = (unsigned)((row0 + ai * HALF + m * 16) * ldo + col0);
                const f32x4 g0 = acc[ai][0][m][0] * si, g1 = acc[ai][0][m][1] * si, u0 = acc[ai][1][m][0] * s2, u1 = acc[ai][1][m][1] * s2;
                u32x2 w; w.x = pk4_fp8(silu_f(g0[0]) * u0[0], silu_f(g0[1]) * u0[1], silu_f(g0[2]) * u0[2], silu_f(g0[3]) * u0[3]);
                w.y = pk4_fp8(silu_f(g1[0]) * u1[0], silu_f(g1[1]) * u1[1], silu_f(g1[2]) * u1[2], silu_f(g1[3]) * u1[3]);
                asm volatile("global_store_dwordx2 %0, %1, %2 sc1" :: "v"(off_), "v"(w), "s"(O) : "memory"); }
    }
};
struct EpiRowScale {
    static constexpr bool PERM = true, AFTER_DRAIN = false;
    bf16_t* Y; int ldc; const float* rs; float mul; bf16_t* YS;
    __device__ __forceinline__ void operator()(const f32x4 (&acc)[2][2][4][2], const Unit& u, int wr, int wc, int fr, int fq) const {
        const int row0 = u.pm * BM + wr * 64 + fr, col0 = u.pn * BM + wc * 32 + 8 * fq;
        bf16_t* const yb = u.ys < 0 ? Y : YS + ((long)u.ys * 2048 - 128 * BM) * (long)ldc;
#pragma unroll
        for (int ai = 0; ai < 2; ++ai)
#pragma unroll
            for (int m = 0; m < 4; ++m) { const int row = row0 + ai * HALF + m * 16; const float s = rs[row + (u.ps - u.pm) * BM] * mul;
                bf16_t* rowp = yb + (size_t)row * ldc + col0;
#pragma unroll
                for (int bj = 0; bj < 2; ++bj) { const f32x4 v0 = acc[ai][bj][m][0] * s, v1 = acc[ai][bj][m][1] * s;
                    u32x4 w; w.x = cvt_pk_bf16(v0[0], v0[1]); w.y = cvt_pk_bf16(v0[2], v0[3]); w.z = cvt_pk_bf16(v1[0], v1[1]); w.w = cvt_pk_bf16(v1[2], v1[3]);
                    *(u32x4*)(rowp + bj * HALF) = w; } }
    }
};
struct MoeOrder {
    int nM, nN, nwg, G, c; int ct[9]; bool sparseA; mutable int prev = -1; unsigned* ready;
    __device__ __forceinline__ void init(const unsigned* cnt, int nN_, int G_, int c_, bool sparseA_, unsigned* ready_ = nullptr) { int acc = 0; ready = ready_;
#pragma unroll
        for (int e = 0; e < 8; ++e) { ct[e] = acc; acc += (int)((__builtin_amdgcn_readfirstlane((int)cnt[32 * e]) + 255) >> 8); }
        ct[8] = acc; nM = acc; nN = nN_; nwg = nM * nN; G = G_; c = c_; sparseA = sparseA_; }
    __device__ bool next(int i, Unit& u) const {
        const long L = (long)i * G + c; if (L >= nwg) return false;
        int wgid = (int)L; { const int q = nwg / NXCD, r = nwg % NXCD, xcd = wgid % NXCD, off = wgid / NXCD; wgid = (xcd < r ? xcd * (q + 1) : r * (q + 1) + (xcd - r) * q) + off; }
        const int nig = WGM_MOE * nN, gid = wgid / nig, fm = gid * WGM_MOE, gsz = (nM - fm) < WGM_MOE ? (nM - fm) : WGM_MOE;
        int pm = fm + ((wgid % nig) % gsz), pn = (wgid % nig) / gsz;
        pm = __builtin_amdgcn_readfirstlane(pm); pn = __builtin_amdgcn_readfirstlane(pn);
        int e = 0, cte = 0;
#pragma unroll
        for (int k = 1; k < 8; ++k) if (pm >= ct[k]) { e = k; cte = ct[k]; }
        u.pm = pm; u.pn = pn; u.pb = e * nN + pn; u.ps = 64 * e + (pm - cte); u.pa = sparseA ? u.ps : pm; u.kt0 = 0; u.nkt = 0; u.ys = -1; return true;
    }
    __device__ __forceinline__ void a_ready(const Unit&, bool) const {}
    __device__ __forceinline__ void publish(int pm) const { unsigned* const a = ready + 32 * pm; unsigned long long sv; unsigned t0, t1;
        asm volatile("s_mov_b64 %0, exec\n\ts_mov_b64 exec, 1\n\tv_mov_b32 %1, 0\n\tv_mov_b32 %2, 1\n\tglobal_atomic_add %1, %2, %3 sc1\n\ts_mov_b64 exec, %0" : "=&s"(sv), "=&v"(t0), "=&v"(t1) : "s"(a) : "memory"); }
    __device__ __forceinline__ void done(const Unit& u) const { if (ready) { if (prev >= 0) publish(prev); prev = u.pm; } }
    __device__ __forceinline__ void flush() const { if (ready && prev >= 0) { publish(prev); prev = -1; } }
};
struct MoeDownOrder {
    int nM, nF, G, c, r12, E, Sl, F, myfull; int ct[9]; const unsigned* ready;
    __device__ __forceinline__ void init(const unsigned* cnt, int G_, int c_, const unsigned* ready_) { int acc = 0;
#pragma unroll
        for (int e = 0; e < 8; ++e) { ct[e] = acc; acc += (int)((__builtin_amdgcn_readfirstlane((int)cnt[32 * e]) + 255) >> 8); }
        ct[8] = acc; nM = acc; nF = nM < 128 ? nM : 128; G = G_; c = c_; ready = ready_;
        int cv = c_, Gv = G_, nv = nM * 28, Fv = nF * 4; asm volatile("" : "+v"(cv), "+v"(Gv), "+v"(nv), "+v"(Fv));
        r12 = ready_ ? __builtin_amdgcn_readfirstlane(nv % Gv) : 0; E = G - r12; Sl = (nM - nF) * 28; F = nF * 4; myfull = __builtin_amdgcn_readfirstlane(cv < Fv ? (Fv - cv + Gv - 1) / Gv : 0); }
    __device__ __forceinline__ bool next(int i, Unit& u) const {
        int pm, pn, kt0 = 0, nkt = 0, ys = -1;
        if (i < myfull) { const int L = i * G + c; const int nwg = F; int wgid = L; { const int q = nwg / NXCD, r = nwg % NXCD, xcd = wgid % NXCD, off = wgid / NXCD; wgid = (xcd < r ? xcd * (q + 1) : r * (q + 1) + (xcd - r) * q) + off; }
            const int nig = WGM_MOE * 4, gid = wgid / nig, fm = gid * WGM_MOE, gsz = (nF - fm) < WGM_MOE ? (nF - fm) : WGM_MOE;
            pm = fm + ((wgid % nig) % gsz); pn = (wgid % nig) / gsz; }
        else { const int j = i - myfull; int s;
            if (c >= r12) s = j == 0 ? c - r12 : E + (j - 1) * G + c; else s = E + j * G + c;
            if (s >= Sl) return false; const int rem = s % 28; pm = nF + s / 28; pn = rem / 7; ys = rem % 7; kt0 = 4 * ys; nkt = 4; }
        pm = __builtin_amdgcn_readfirstlane(pm); pn = __builtin_amdgcn_readfirstlane(pn);
        int e = 0, cte = 0;
#pragma unroll
        for (int k = 1; k < 8; ++k) if (pm >= ct[k]) { e = k; cte = ct[k]; }
        Unit r; r.pm = pm; r.pn = pn; r.pb = e * 4 + pn; r.ps = 64 * e + (pm - cte); r.pa = pm;
        r.kt0 = __builtin_amdgcn_readfirstlane(kt0); r.nkt = __builtin_amdgcn_readfirstlane(nkt); r.ys = __builtin_amdgcn_readfirstlane(ys); u = r; return true;
    }
    __device__ __forceinline__ void a_ready(const Unit& u, bool w0) const {
        if (ready) {
            if (w0) { unsigned sp = 0u;
                while ((unsigned)__builtin_amdgcn_readfirstlane((int)__hip_atomic_load(ready + 32 * u.pm, __ATOMIC_RELAXED, __HIP_MEMORY_SCOPE_AGENT)) < 224u) { __builtin_amdgcn_s_sleep(2); if (++sp > (1u << 21)) break; }
            }
            asm volatile("" ::: "memory"); __builtin_amdgcn_s_barrier(); asm volatile("" ::: "memory");
        }
    }
    __device__ __forceinline__ void flush() const {}
    __device__ __forceinline__ void done(const Unit&) const {}
};
template <class Epi, class Sched, bool ALIGN_EPI = false, bool SP2 = false>
__device__ __forceinline__ void gemm_phase(PG8_LAS unsigned char* lds, const Gemm g, const Sched& S, const Epi& E) {
    int tid = threadIdx.x; asm volatile("" : "+v"(tid));
    const int wid = __builtin_amdgcn_readfirstlane(tid >> 6), lane = tid & 63, wr = wid >> 2, wc = wid & 3, fr = lane & 15, fq = lane >> 4;
    const int K = g.K, nt = K / BK;
    unsigned voffA[2], voffB[2];
#pragma unroll
    for (int i = 0; i < 2; ++i) { int R, C; stage_rc(tid * 16 + i * 8192, R, C); const int Rb = Epi::PERM ? ((R & ~31) + perm32(R & 31)) : R;
        voffA[i] = (unsigned)(R * K + C) * 2u; voffB[i] = (unsigned)(Rb * K + C) * 2u; }
    const size_t kstep = (size_t)(BK * 2);
    const size_t hstep = (size_t)HALF * K * 2;
    const size_t tstep = 2 * hstep;
    const unsigned ldsw = (unsigned)wid * 1024u; const unsigned ldsbase = (unsigned)__builtin_amdgcn_readfirstlane((int)((unsigned)(uintptr_t)lds + ldsw));
    const int aoff = lds_byte(wr * 64 + fr, fq * 8), boff = lds_byte(wc * 32 + fr, fq * 8);
#define PG8_SA(b, h) (((b) * 2 + (h)) * HTB)
#define PG8_SB(b, h) ((4 + (b) * 2 + (h)) * HTB)
#define PG8_STAGE(bufoff, gbase, voff) do { _Pragma("unroll") for (int _i = 0; _i < 2; ++_i) { unsigned keep_; \
        asm volatile("s_mov_b32 %0, m0\n\ts_mov_b32 m0, %3\n\ts_nop 0\n\tglobal_load_lds_dwordx4 %1, %2\n\ts_mov_b32 m0, %0" : "=&s"(keep_) : "v"((voff)[_i]), "s"((const char*)(gbase)), "s"(ldsbase + (unsigned)((bufoff) + _i * 8192)) : "memory"); } } while (0)
#define PG8_LDA(dst, b, h) do { _Pragma("unroll") for (int m = 0; m < 4; ++m) _Pragma("unroll") for (int k = 0; k < 2; ++k) dst[m][k] = *(const PG8_LAS bf16x8*)(lds + PG8_SA(b, h) + aoff + m * 2048 + k * 1024); } while (0)
#define PG8_LDB(dst, b, h) do { _Pragma("unroll") for (int n = 0; n < 2; ++n) _Pragma("unroll") for (int k = 0; k < 2; ++k) dst[n][k] = *(const PG8_LAS bf16x8*)(lds + PG8_SB(b, h) + boff + n * 2048 + k * 1024); } while (0)
#define PG8_MMA(ai, bj, At, Bt) do { __builtin_amdgcn_s_setprio(1); _Pragma("unroll") for (int m = 0; m < 4; ++m) _Pragma("unroll") for (int n = 0; n < 2; ++n) _Pragma("unroll") for (int k = 0; k < 2; ++k) \
        acc[ai][bj][m][n] = __builtin_amdgcn_mfma_f32_16x16x32_bf16(Bt[n][k], At[m][k], acc[ai][bj][m][n], 0, 0, 0); __builtin_amdgcn_s_setprio(0); } while (0)
#define PG8_WAIT_V(n) asm volatile("s_waitcnt vmcnt(" #n ")" ::: "memory")
#define PG8_WAIT_L(n) asm volatile("s_waitcnt lgkmcnt(" #n ")" ::: "memory")
#define PG8_BAR __builtin_amdgcn_s_barrier()
#define PG8_SCHED __builtin_amdgcn_sched_barrier(0)
    Unit cur, nxt; int ui = 0;
    if (!S.next(0, cur)) return;
    f32x4 acc[2][2][4][2];
#pragma unroll
    for (int a = 0; a < 2; ++a)
#pragma unroll
        for (int b = 0; b < 2; ++b)
#pragma unroll
            for (int m = 0; m < 4; ++m)
#pragma unroll
                for (int n = 0; n < 2; ++n) acc[a][b][m][n] = (f32x4){0.f, 0.f, 0.f, 0.f};
    bf16x8 At[4][2], B0[2][2], B1[2][2];
    const char* cA = (const char*)g.A + (size_t)cur.pa * tstep; const char* cB = (const char*)g.Bt + (size_t)cur.pb * tstep;
    S.a_ready(cur);
    if constexpr (SP2) {
        PG8_STAGE(PG8_SB(0, 0), cB, voffB); PG8_STAGE(PG8_SB(0, 1), cB + hstep, voffB); PG8_STAGE(PG8_SA(0, 0), cA, voffA); PG8_STAGE(PG8_SA(0, 1), cA + hstep, voffA);
        if (wr == 1) PG8_BAR;
        PG8_WAIT_V(2); PG8_BAR;
        PG8_STAGE(PG8_SB(1, 0), cB + kstep, voffB); PG8_STAGE(PG8_SA(1, 0), cA + kstep, voffA); PG8_STAGE(PG8_SB(1, 1), cB + hstep + kstep, voffB);
        PG8_WAIT_V(6); PG8_BAR;
    } else {
        PG8_STAGE(PG8_SB(0, 0), cB, voffB); PG8_STAGE(PG8_SA(0, 0), cA, voffA); PG8_STAGE(PG8_SB(0, 1), cB + hstep, voffB); PG8_STAGE(PG8_SA(0, 1), cA + hstep, voffA);
        if (wr == 1) PG8_BAR;
        PG8_WAIT_V(4); PG8_BAR;
        PG8_STAGE(PG8_SB(1, 0), cB + kstep, voffB); PG8_STAGE(PG8_SA(1, 0), cA + kstep, voffA); PG8_STAGE(PG8_SB(1, 1), cB + hstep + kstep, voffB);
        PG8_WAIT_V(6); PG8_BAR;
    }
    for (;;) {
        const bool has_next = S.next(ui + 1, nxt);
        const char* nA = has_next ? (const char*)g.A + (size_t)nxt.pa * tstep : cA; const char* nB = has_next ? (const char*)g.Bt + (size_t)nxt.pb * tstep : cB;
        for (int t = 0; t < nt; t += 2) {
            const bool last = (t == nt - 2);
            const char* a1 = cA + (size_t)(t + 1) * kstep;
            const char* a2 = last ? nA : cA + (size_t)(t + 2) * kstep; const char* b2 = last ? nB : cB + (size_t)(t + 2) * kstep;
            const char* a3 = a2 + kstep; const char* b3 = b2 + kstep;
            if (last && has_next) S.a_ready(nxt);
            if constexpr (SP2) {
            PG8_LDB(B0, 0, 0); PG8_LDB(B1, 0, 1); PG8_SCHED; PG8_LDA(At, 0, 0); PG8_STAGE(PG8_SA(1, 1), a1 + hstep, voffA);
            PG8_WAIT_V(8); PG8_WAIT_L(0); PG8_BAR; PG8_MMA(0, 0, At, B0); PG8_MMA(0, 1, At, B1); PG8_BAR; PG8_SCHED;
            PG8_LDA(At, 0, 1); PG8_STAGE(PG8_SB(0, 0), b2, voffB); PG8_STAGE(PG8_SB(0, 1), b2 + hstep, voffB); PG8_STAGE(PG8_SA(0, 0), a2, voffA);
            PG8_WAIT_V(8); PG8_WAIT_L(0); PG8_BAR; PG8_MMA(1, 0, At, B0); PG8_MMA(1, 1, At, B1); PG8_BAR; PG8_SCHED;
            PG8_LDB(B0, 1, 0); PG8_LDB(B1, 1, 1); PG8_SCHED; PG8_LDA(At, 1, 0); PG8_STAGE(PG8_SA(0, 1), a2 + hstep, voffA);
            PG8_WAIT_V(8); PG8_WAIT_L(0); PG8_BAR; PG8_MMA(0, 0, At, B0); PG8_MMA(0, 1, At, B1); PG8_BAR; PG8_SCHED;
            PG8_LDA(At, 1, 1); PG8_STAGE(PG8_SB(1, 0), b3, voffB); PG8_STAGE(PG8_SB(1, 1), b3 + hstep, voffB); PG8_STAGE(PG8_SA(1, 0), a3, voffA);
            PG8_WAIT_V(8); PG8_WAIT_L(0); PG8_BAR; PG8_MMA(1, 0, At, B0); PG8_MMA(1, 1, At, B1); PG8_BAR; PG8_SCHED;
            } else {
            PG8_LDB(B0, 0, 0); PG8_SCHED; PG8_LDA(At, 0, 0); PG8_STAGE(PG8_SA(1, 1), a1 + hstep, voffA);
            PG8_WAIT_L(8); PG8_BAR; PG8_WAIT_L(0); PG8_MMA(0, 0, At, B0); PG8_BAR; PG8_SCHED;
            PG8_LDB(B1, 0, 1); PG8_STAGE(PG8_SB(0, 0), b2, voffB);
            PG8_BAR; PG8_WAIT_L(0); PG8_MMA(0, 1, At, B1); PG8_BAR;
            PG8_LDA(At, 0, 1); PG8_STAGE(PG8_SA(0, 0), a2, voffA);
            PG8_BAR; PG8_WAIT_L(0); PG8_MMA(1, 0, At, B0); PG8_BAR; PG8_SCHED;
            PG8_STAGE(PG8_SB(0, 1), b2 + hstep, voffB);
            PG8_WAIT_V(6); PG8_BAR; PG8_MMA(1, 1, At, B1); PG8_BAR;
            PG8_LDB(B0, 1, 0); PG8_SCHED; PG8_LDA(At, 1, 0); PG8_STAGE(PG8_SA(0, 1), a2 + hstep, voffA);
            PG8_WAIT_L(8); PG8_BAR; PG8_WAIT_L(0); PG8_MMA(0, 0, At, B0); PG8_BAR; PG8_SCHED;
            PG8_LDB(B1, 1, 1); PG8_STAGE(PG8_SB(1, 0), b3, voffB);
            PG8_BAR; PG8_WAIT_L(0); PG8_MMA(0, 1, At, B1); PG8_BAR;
            PG8_LDA(At, 1, 1); PG8_STAGE(PG8_SA(1, 0), a3, voffA);
            PG8_BAR; PG8_WAIT_L(0); PG8_MMA(1, 0, At, B0); PG8_BAR; PG8_SCHED;
            PG8_STAGE(PG8_SB(1, 1), b3 + hstep, voffB);
            PG8_WAIT_V(6); PG8_BAR; PG8_MMA(1, 1, At, B1); PG8_BAR;
            }
        }
        if constexpr (ALIGN_EPI) { if (wr == 0) PG8_BAR; }
        if constexpr (!Epi::AFTER_DRAIN) { E(acc, cur, wr, wc, fr, fq); S.done(cur); }
        if (!has_next) break;
#pragma unroll
        for (int a = 0; a < 2; ++a)
#pragma unroll
            for (int b = 0; b < 2; ++b)
#pragma unroll
                for (int m = 0; m < 4; ++m)
#pragma unroll
                    for (int n = 0; n < 2; ++n) acc[a][b][m][n] = (f32x4){0.f, 0.f, 0.f, 0.f};
        cur = nxt; cA = nA; cB = nB; ++ui;
        if constexpr (ALIGN_EPI) { if (wr == 1) PG8_BAR; }
    }
    PG8_WAIT_V(0);
    if constexpr (!ALIGN_EPI) { if (wr == 0) PG8_BAR; }
    PG8_BAR;
    if constexpr (Epi::AFTER_DRAIN) { E.fused(acc, cur, wr, wc, fr, fq, lds, wid, lane); S.done(cur); }
#undef PG8_SA
#undef PG8_SB
#undef PG8_STAGE
#undef PG8_LDA
#undef PG8_LDB
#undef PG8_MMA
#undef PG8_WAIT_V
#undef PG8_WAIT_L
#undef PG8_BAR
#undef PG8_SCHED
}
typedef int i32x4 __attribute__((ext_vector_type(4)));
typedef int i32x8 __attribute__((ext_vector_type(8)));
struct Gemm8 { const unsigned char* A; const unsigned char* Bt; int M, N, K; };
template <class Epi, class Sched, bool ALIGN_EPI = false, bool SP2 = false>
__device__ __forceinline__ void gemm_phase_f8(PG8_LAS unsigned char* lds, const Gemm8 g, const Sched& S, const Epi& E) {
    int tid = threadIdx.x; asm volatile("" : "+v"(tid));
    const int wid = __builtin_amdgcn_readfirstlane(tid >> 6), lane = tid & 63, wr = wid >> 2, wc = wid & 3, fr = lane & 15, fq = lane >> 4;
    const int K = g.K, nt = K / 128;
    unsigned voffA[2], voffB[2];
#pragma unroll
    for (int i = 0; i < 2; ++i) { int R, C; stage_rc(tid * 16 + i * 8192, R, C); const int Rb = Epi::PERM ? ((R & ~31) + perm32(R & 31)) : R;
        voffA[i] = (unsigned)(R * K + 2 * C); voffB[i] = (unsigned)(Rb * K + 2 * C); }
    const size_t kstep = (size_t)(BK * 2);
    const size_t hstep = (size_t)HALF * K;
    const size_t tstep = 2 * hstep;
    const unsigned ldsw = (unsigned)wid * 1024u; const unsigned ldsbase = (unsigned)__builtin_amdgcn_readfirstlane((int)((unsigned)(uintptr_t)lds + ldsw));
    const int aoff0 = lds_byte(wr * 64 + fr, fq * 8), boff0 = lds_byte(wc * 32 + fr, fq * 8);
#define PG8_SA(b, h) (((b) * 2 + (h)) * HTB)
#define PG8_SB(b, h) ((4 + (b) * 2 + (h)) * HTB)
#define PG8_STAGE(bufoff, gbase, voff) do { _Pragma("unroll") for (int _i = 0; _i < 2; ++_i) { unsigned keep_; \
        asm volatile("s_mov_b32 %0, m0\n\ts_mov_b32 m0, %3\n\ts_nop 0\n\tglobal_load_lds_dwordx4 %1, %2\n\ts_mov_b32 m0, %0" : "=&s"(keep_) : "v"((voff)[_i]), "s"((const char*)(gbase)), "s"(ldsbase + (unsigned)((bufoff) + _i * 8192)) : "memory"); } } while (0)
#define PG8_LD8(dst, off) do { const i32x4 lo_ = *(const PG8_LAS i32x4*)(lds + (off)), hi_ = *(const PG8_LAS i32x4*)(lds + (off) + 1024); dst = __builtin_shufflevector(lo_, hi_, 0, 1, 2, 3, 4, 5, 6, 7); } while (0)
#define PG8_LDA(dst, b, h) do { _Pragma("unroll") for (int m = 0; m < 4; ++m) PG8_LD8(dst[m], PG8_SA(b, h) + aoff + m * 2048); } while (0)
#define PG8_LDB(dst, b, h) do { _Pragma("unroll") for (int n = 0; n < 2; ++n) PG8_LD8(dst[n], PG8_SB(b, h) + boff + n * 2048); } while (0)
#define PG8_MMA(ai, bj, At, Bt) do { __builtin_amdgcn_s_setprio(1); _Pragma("unroll") for (int m = 0; m < 4; ++m) { \
        f32x4 c0_ = __builtin_shufflevector(acc8[ai][bj][m], acc8[ai][bj][m], 0, 1, 2, 3), c1_ = __builtin_shufflevector(acc8[ai][bj][m], acc8[ai][bj][m], 4, 5, 6, 7); \
        c0_ = __builtin_amdgcn_mfma_scale_f32_16x16x128_f8f6f4(Bt[0], At[m], c0_, 0, 0, 0, 0x7F7F7F7F, 0, 0x7F7F7F7F); c1_ = __builtin_amdgcn_mfma_scale_f32_16x16x128_f8f6f4(Bt[1], At[m], c1_, 0, 0, 0, 0x7F7F7F7F, 0, 0x7F7F7F7F); \
        acc8[ai][bj][m] = __builtin_shufflevector(c0_, c1_, 0, 1, 2, 3, 4, 5, 6, 7); } __builtin_amdgcn_s_setprio(0); } while (0)
#define PG8_WAIT_V(n) asm volatile("s_waitcnt vmcnt(" #n ")" ::: "memory")
#define PG8_WAIT_L(n) asm volatile("s_waitcnt lgkmcnt(" #n ")" ::: "memory")
#define PG8_BAR __builtin_amdgcn_s_barrier()
#define PG8_SCHED __builtin_amdgcn_sched_barrier(0)
    Unit cur, nxt; int ui = 0;
    if (!S.next(0, cur)) return;
    typedef float f32x8 __attribute__((ext_vector_type(8)));
    f32x8 acc8[2][2][4];
#pragma unroll
    for (int a = 0; a < 2; ++a)
#pragma unroll
        for (int b = 0; b < 2; ++b)
#pragma unroll
            for (int m = 0; m < 4; ++m) acc8[a][b][m] = (f32x8){0.f, 0.f, 0.f, 0.f, 0.f, 0.f, 0.f, 0.f};
    i32x8 At[4], B0[2], B1[2];
    const char* cA = (const char*)g.A + (size_t)cur.pa * tstep + (size_t)__builtin_amdgcn_readfirstlane(cur.kt0) * kstep; const char* cB = (const char*)g.Bt + (size_t)cur.pb * tstep + (size_t)__builtin_amdgcn_readfirstlane(cur.kt0) * kstep;
    S.a_ready(cur, wid == 0);
    if constexpr (SP2) {
        PG8_STAGE(PG8_SB(0, 0), cB, voffB); PG8_STAGE(PG8_SB(0, 1), cB + hstep, voffB); PG8_STAGE(PG8_SA(0, 0), cA, voffA); PG8_STAGE(PG8_SA(0, 1), cA + hstep, voffA);
        if (wr == 1) PG8_BAR;
        PG8_WAIT_V(2); PG8_BAR;
        PG8_STAGE(PG8_SB(1, 0), cB + kstep, voffB); PG8_STAGE(PG8_SA(1, 0), cA + kstep, voffA); PG8_STAGE(PG8_SB(1, 1), cB + hstep + kstep, voffB);
        PG8_WAIT_V(6); PG8_BAR;
    } else {
        PG8_STAGE(PG8_SB(0, 0), cB, voffB); PG8_STAGE(PG8_SA(0, 0), cA, voffA); PG8_STAGE(PG8_SB(0, 1), cB + hstep, voffB); PG8_STAGE(PG8_SA(0, 1), cA + hstep, voffA);
        if (wr == 1) PG8_BAR;
        PG8_WAIT_V(4); PG8_BAR;
        PG8_STAGE(PG8_SB(1, 0), cB + kstep, voffB); PG8_STAGE(PG8_SA(1, 0), cA + kstep, voffA); PG8_STAGE(PG8_SB(1, 1), cB + hstep + kstep, voffB);
        PG8_WAIT_V(6); PG8_BAR;
    }
    for (;;) {
        const bool has_next = S.next(ui + 1, nxt);
        const char* nA = has_next ? (const char*)g.A + (size_t)nxt.pa * tstep + (size_t)__builtin_amdgcn_readfirstlane(nxt.kt0) * kstep : cA; const char* nB = has_next ? (const char*)g.Bt + (size_t)nxt.pb * tstep + (size_t)__builtin_amdgcn_readfirstlane(nxt.kt0) * kstep : cB;
        const int ntc = __builtin_amdgcn_readfirstlane(cur.nkt ? cur.nkt : nt);
#pragma unroll 1
        for (int t = 0; t < ntc; t += 2) {
            int aoff = aoff0, boff = boff0; asm volatile("" : "+v"(aoff), "+v"(boff));
            const bool last = (t == ntc - 2);
            const char* a1 = cA + (size_t)(t + 1) * kstep;
            const char* a2 = last ? nA : cA + (size_t)(t + 2) * kstep; const char* b2 = last ? nB : cB + (size_t)(t + 2) * kstep;
            const char* a3 = a2 + kstep; const char* b3 = b2 + kstep;
            if (last && has_next) S.a_ready(nxt, wid == 0);
            if constexpr (SP2) {
            PG8_LDB(B0, 0, 0); PG8_LDB(B1, 0, 1); PG8_SCHED; PG8_LDA(At, 0, 0); PG8_STAGE(PG8_SA(1, 1), a1 + hstep, voffA);
            PG8_WAIT_V(8); PG8_WAIT_L(0); PG8_BAR; PG8_MMA(0, 0, At, B0); PG8_MMA(0, 1, At, B1); PG8_BAR; PG8_SCHED;
            PG8_LDA(At, 0, 1); PG8_STAGE(PG8_SB(0, 0), b2, voffB); PG8_STAGE(PG8_SB(0, 1), b2 + hstep, voffB); PG8_STAGE(PG8_SA(0, 0), a2, voffA);
            PG8_WAIT_V(8); PG8_WAIT_L(0); PG8_BAR; PG8_MMA(1, 0, At, B0); PG8_MMA(1, 1, At, B1); PG8_BAR; PG8_SCHED;
            PG8_LDB(B0, 1, 0); PG8_LDB(B1, 1, 1); PG8_SCHED; PG8_LDA(At, 1, 0); PG8_STAGE(PG8_SA(0, 1), a2 + hstep, voffA);
            PG8_WAIT_V(8); PG8_WAIT_L(0); PG8_BAR; PG8_MMA(0, 0, At, B0); PG8_MMA(0, 1, At, B1); PG8_BAR; PG8_SCHED;
            PG8_LDA(At, 1, 1); PG8_STAGE(PG8_SB(1, 0), b3, voffB); PG8_STAGE(PG8_SB(1, 1), b3 + hstep, voffB); PG8_STAGE(PG8_SA(1, 0), a3, voffA);
            PG8_WAIT_V(8); PG8_WAIT_L(0); PG8_BAR; PG8_MMA(1, 0, At, B0); PG8_MMA(1, 1, At, B1); PG8_BAR; PG8_SCHED;
            } else {
            PG8_LDB(B0, 0, 0); PG8_SCHED; PG8_LDA(At, 0, 0); PG8_STAGE(PG8_SA(1, 1), a1 + hstep, voffA);
            PG8_WAIT_L(8); PG8_BAR; PG8_WAIT_L(0); PG8_MMA(0, 0, At, B0); PG8_BAR; PG8_SCHED;
            PG8_LDB(B1, 0, 1); PG8_STAGE(PG8_SB(0, 0), b2, voffB);
            PG8_BAR; PG8_WAIT_L(0); PG8_MMA(0, 1, At, B1); PG8_BAR;
            PG8_LDA(At, 0, 1); PG8_STAGE(PG8_SA(0, 0), a2, voffA);
            PG8_BAR; PG8_WAIT_L(0); PG8_MMA(1, 0, At, B0); PG8_BAR; PG8_SCHED;
            PG8_STAGE(PG8_SB(0, 1), b2 + hstep, voffB);
            PG8_WAIT_V(6); PG8_BAR; PG8_MMA(1, 1, At, B1); PG8_BAR;
            PG8_LDB(B0, 1, 0); PG8_SCHED; PG8_LDA(At, 1, 0); PG8_STAGE(PG8_SA(0, 1), a2 + hstep, voffA);
            PG8_WAIT_L(8); PG8_BAR; PG8_WAIT_L(0); PG8_MMA(0, 0, At, B0); PG8_BAR; PG8_SCHED;
            PG8_LDB(B1, 1, 1); PG8_STAGE(PG8_SB(1, 0), b3, voffB);
            PG8_BAR; PG8_WAIT_L(0); PG8_MMA(0, 1, At, B1); PG8_BAR;
            PG8_LDA(At, 1, 1); PG8_STAGE(PG8_SA(1, 0), a3, voffA);
            PG8_BAR; PG8_WAIT_L(0); PG8_MMA(1, 0, At, B0); PG8_BAR; PG8_SCHED;
            PG8_STAGE(PG8_SB(1, 1), b3 + hstep, voffB);
            PG8_WAIT_V(6); PG8_BAR; PG8_MMA(1, 1, At, B1); PG8_BAR;
            }
        }
        if constexpr (ALIGN_EPI) { if (wr == 0) PG8_BAR; }
        if constexpr (!Epi::AFTER_DRAIN) { f32x4 acc[2][2][4][2];
#pragma unroll
            for (int a = 0; a < 2; ++a)
#pragma unroll
                for (int b = 0; b < 2; ++b)
#pragma unroll
                    for (int m = 0; m < 4; ++m) { acc[a][b][m][0] = __builtin_shufflevector(acc8[a][b][m], acc8[a][b][m], 0, 1, 2, 3); acc[a][b][m][1] = __builtin_shufflevector(acc8[a][b][m], acc8[a][b][m], 4, 5, 6, 7); }
            E(acc, cur, wr, wc, fr, fq); S.done(cur); }
        if (!has_next) break;
#pragma unroll
        for (int a = 0; a < 2; ++a)
#pragma unroll
            for (int b = 0; b < 2; ++b)
#pragma unroll
                for (int m = 0; m < 4; ++m) acc8[a][b][m] = (f32x8){0.f, 0.f, 0.f, 0.f, 0.f, 0.f, 0.f, 0.f};
        cur = nxt; cA = nA; cB = nB; ++ui;
        if constexpr (ALIGN_EPI) { if (wr == 1) PG8_BAR; }
    }
    PG8_WAIT_V(0); S.flush();
    if constexpr (!ALIGN_EPI) { if (wr == 0) PG8_BAR; }
    PG8_BAR;
    static_assert(!Epi::AFTER_DRAIN, "fp8 body: plain epilogues only");
#undef PG8_SA
#undef PG8_SB
#undef PG8_STAGE
#undef PG8_LDA
#undef PG8_LDB
#undef PG8_MMA
#undef PG8_LD8
#undef PG8_WAIT_V
#undef PG8_WAIT_L
#undef PG8_BAR
#undef PG8_SCHED
}
}
#include <hip/hip_bf16.h>
#include <cmath>
namespace attn_body {
using bf16=__hip_bfloat16;
using bf16x8=__attribute__((ext_vector_type(8)))short;
using s16x4=__attribute__((ext_vector_type(4)))short;
using f32x16=__attribute__((ext_vector_type(16)))float;
using u32x4=__attribute__((ext_vector_type(4)))unsigned;
constexpr int BATCH=2,NHEAD=8,SEQ=8192,D=64,DM=2560,OPITCH=1024;
constexpr int NW=8,QBLK=32,QB=QBLK*NW,KVBLK=64,NQB=SEQ/QB;
constexpr int ATTN_PITCH=DM, ATTN_UNIT_ROWS=QB;
__device__ __forceinline__ int crow(int r,int hi){return (r&3)+8*(r>>2)+4*hi;}
#define SBAR() __builtin_amdgcn_sched_barrier(0)
__device__ __forceinline__ void cmask(f32x16&p0,f32x16&p1,int jb,int qrel,int hi){
  const float NEG=-INFINITY; int kb=64*jb+4*hi;
  #pragma unroll
  for(int r=0;r<16;++r){int kv=kb+(r&3)+8*(r>>2); if(kv>qrel)p0[r]=NEG; if(kv+32>qrel)p1[r]=NEG;}
}

constexpr int NSLOT=3, SLOTB=8192;
constexpr int LDS_K=0, LDS_V=NSLOT*SLOTB, LDS_WS=2*NSLOT*SLOTB, LDS_OST=LDS_WS+NW*64*4, LDS_BIAS=LDS_OST+NW*4096, LDS_PRE=LDS_BIAS+SEQ*4, LDS_BYTES=LDS_PRE+1024;
constexpr float C2=0.125f*1.4426950408889634f;
__device__ __forceinline__ void glds16(const void*gsrc,unsigned lds_dst){unsigned keep;
  asm volatile("s_mov_b32 %0, m0\n\ts_mov_b32 m0, %2\n\ts_nop 0\n\tglobal_load_lds_dwordx4 %1, off\n\ts_mov_b32 m0, %0":"=&s"(keep):"v"(gsrc),"s"(lds_dst):"memory");}
__device__ __forceinline__ float max3f(float a,float b,float c){float r;asm("v_max3_f32 %0, %1, %2, %3":"=v"(r):"v"(a),"v"(b),"v"(c));return r;}
__device__ __forceinline__ float max2f(float a,float b){float r;asm("v_max_f32_e32 %0, %1, %2":"=v"(r):"v"(a),"v"(b));return r;}
__device__ __forceinline__ float fadd_s(float a,float b){float r;asm("v_add_f32_e32 %0, %1, %2":"=v"(r):"v"(a),"v"(b));return r;}
__device__ __forceinline__ float fsub_s(float a,float b){float r;asm("v_sub_f32_e32 %0, %1, %2":"=v"(r):"v"(a),"v"(b));return r;}
typedef float f32x2_t __attribute__((ext_vector_type(2))); typedef __bf16 bf16x2_t __attribute__((ext_vector_type(2)));
__device__ __forceinline__ unsigned cvtpk_s(float lo,float hi){f32x2_t v={lo,hi};bf16x2_t b=__builtin_convertvector(v,bf16x2_t);return __builtin_bit_cast(unsigned,b);}
#define WAIT_BAR(N) asm volatile("s_waitcnt vmcnt(" #N ") lgkmcnt(0)\n\ts_barrier":::"memory")

__device__ __forceinline__ void qkt(f32x16&p0,f32x16&p1,const char*Kslot,const bf16x8*qr,int r32,int hi){
  const char*kb=Kslot+hi*1024+r32*16;
  #pragma unroll
  for(int d0=0;d0<4;++d0){
    const bf16x8 b0=*reinterpret_cast<const bf16x8*>(kb+d0*2048);
    const bf16x8 b1=*reinterpret_cast<const bf16x8*>(kb+d0*2048+512);
    p0=__builtin_amdgcn_mfma_f32_32x32x16_bf16(b0,qr[d0],p0,0,0,0);p1=__builtin_amdgcn_mfma_f32_32x32x16_bf16(b1,qr[d0],p1,0,0,0);}
}
typedef __attribute__((address_space(3))) const char* lds_cptr;
typedef short v4i16_t __attribute__((ext_vector_type(4)));
__device__ __forceinline__ void kload8(bf16x8*kf,lds_cptr kp){
  kf[0]=*(const __attribute__((address_space(3))) bf16x8*)(kp);      kf[1]=*(const __attribute__((address_space(3))) bf16x8*)(kp+512);
  kf[2]=*(const __attribute__((address_space(3))) bf16x8*)(kp+2048); kf[3]=*(const __attribute__((address_space(3))) bf16x8*)(kp+2560);
  kf[4]=*(const __attribute__((address_space(3))) bf16x8*)(kp+4096); kf[5]=*(const __attribute__((address_space(3))) bf16x8*)(kp+4608);
  kf[6]=*(const __attribute__((address_space(3))) bf16x8*)(kp+6144); kf[7]=*(const __attribute__((address_space(3))) bf16x8*)(kp+6656);
}
__device__ __forceinline__ void kload2(bf16x8*kf,lds_cptr kp,int j){ kf[2*j]=*(const __attribute__((address_space(3))) bf16x8*)(kp+j*2048); kf[2*j+1]=*(const __attribute__((address_space(3))) bf16x8*)(kp+j*2048+512); }
__device__ __forceinline__ s16x4 vtr(lds_cptr p){ return __builtin_bit_cast(s16x4,__builtin_amdgcn_ds_read_tr16_b64_v4i16((__attribute__((address_space(3))) v4i16_t*)p)); }
__device__ __forceinline__ float rowmax(const f32x16&p0,const f32x16&p1){
  float a=max3f(p0[0],p0[1],p1[0]),b=max3f(p0[2],p0[3],p1[1]);a=max3f(a,p1[2],p1[3]);
  #pragma unroll
  for(int r=4;r<16;r+=4){a=max3f(a,p0[r],p0[r+1]);b=max3f(b,p0[r+2],p0[r+3]);a=max3f(a,p1[r],p1[r+1]);b=max3f(b,p1[r+2],p1[r+3]);}
  const float m=max2f(a,b);
  auto rr=__builtin_amdgcn_permlane32_swap(__float_as_uint(m),__float_as_uint(m),false,false);
  return max2f(__uint_as_float(rr[0]),__uint_as_float(rr[1]));
}
__device__ __forceinline__ void pv(f32x16*o,int vb,bf16x8 pa0,bf16x8 pa1,bf16x8 pa2,bf16x8 pa3){
  #pragma unroll
  for(int d0=0;d0<2;++d0){s16x4 lo[4],hi[4];
    #pragma unroll
    for(int ks=0;ks<4;++ks){
      asm volatile("ds_read_b64_tr_b16 %0,%1 offset:%c2":"=&v"(lo[ks]):"v"(vb),"i"(d0*4096+ks*1024):"memory");
      asm volatile("ds_read_b64_tr_b16 %0,%1 offset:%c2":"=&v"(hi[ks]):"v"(vb),"i"(d0*4096+ks*1024+512):"memory");}
    asm volatile("s_waitcnt lgkmcnt(0)":::"memory");SBAR();
    #define PK(k) (bf16x8){lo[k][0],lo[k][1],lo[k][2],lo[k][3],hi[k][0],hi[k][1],hi[k][2],hi[k][3]}
    o[d0]=__builtin_amdgcn_mfma_f32_32x32x16_bf16(pa0,PK(0),o[d0],0,0,0);
    o[d0]=__builtin_amdgcn_mfma_f32_32x32x16_bf16(pa1,PK(1),o[d0],0,0,0);
    o[d0]=__builtin_amdgcn_mfma_f32_32x32x16_bf16(pa2,PK(2),o[d0],0,0,0);
    o[d0]=__builtin_amdgcn_mfma_f32_32x32x16_bf16(pa3,PK(3),o[d0],0,0,0);
    #undef PK
  }
}

#ifndef ATTN_STORE16
#define ATTN_STORE16(p,v) (*(u32x4*)(p)=(v))
#endif
typedef float f32x4b __attribute__((ext_vector_type(4)));
template<int THRL> __device__ __forceinline__ void attn_unit(int b,int h,int qb,const bf16*Q,const bf16*__restrict__ K,const bf16*__restrict__ V,bf16*O,const float*__restrict__ floc,const float*__restrict__ ftot,const float*__restrict__ qkn,char*shm){
  int tid=threadIdx.x; asm volatile("":"+v"(tid)); const int lane=tid&63,r32=lane&31,hi=lane>>5; const int wid=__builtin_amdgcn_readfirstlane(tid>>6);
  const long rowbase=(long)b*SEQ; const int q0=qb*QB;
  typedef __attribute__((address_space(3))) float* lds_fptr;
  const lds_fptr prel=(lds_fptr)((lds_cptr)shm+LDS_PRE); const lds_fptr biasl=(lds_fptr)((lds_cptr)shm+LDS_BIAS);
  { const int nblk=4*(qb+1);
    if(wid==0){ int pl_=lane; asm volatile("":"+v"(pl_));
      float a0=(pl_<nblk)?ftot[(b*128+pl_)*8+h]:0.f, a1=(pl_+64<nblk)?ftot[(b*128+64+pl_)*8+h]:0.f; float s0=a0,s1=a1;
      #pragma unroll
      for(int o_=1;o_<64;o_<<=1){ const float t0_=__shfl_up(s0,o_),t1_=__shfl_up(s1,o_); if(pl_>=o_){s0+=t0_;s1+=t1_;} }
      s1+=__shfl(s0,63); const float p0_=s0-a0,p1_=s1-a1;
      prel[pl_]=p0_; prel[pl_+64]=p1_;
      const float*kn_=qkn+(size_t)(256+b*128)*16+h*2; const float*qn_=qkn+(size_t)(b*128)*16+h*2;
      float k2=(pl_<nblk)?(kn_[pl_*16]+kn_[pl_*16+1]):0.f; { const float k2b=(pl_+64<nblk)?(kn_[(pl_+64)*16]+kn_[(pl_+64)*16+1]):0.f; k2=fmaxf(k2,k2b); }
      float q2=(pl_<4)?(qn_[(4*qb+pl_)*16]+qn_[(4*qb+pl_)*16+1]):0.f;
      #pragma unroll
      for(int o_=1;o_<64;o_<<=1){ k2=fmaxf(k2,__shfl_xor(k2,o_)); q2=fmaxf(q2,__shfl_xor(q2,o_)); }
      const float need=30.f+2.04f*sqrtf(k2*q2);
      const float cu=__shfl(qb<16?p0_:p1_,(4*qb)&63);
      const bool c0_=((pl_&1)==0)&&(pl_<=4*qb)&&((p0_-cu)*1.4426950408889634f>=need);
      const bool c1_=((pl_&1)==0)&&(pl_+64<=4*qb)&&((p1_-cu)*1.4426950408889634f>=need);
      const unsigned long long m0_=__ballot(c0_),m1_=__ballot(c1_);
      const int ts_=m1_?(127-__builtin_clzll(m1_)):(m0_?(63-__builtin_clzll(m0_)):0);
      if(pl_==0)prel[128]=__int_as_float(ts_); }
    asm volatile("s_waitcnt vmcnt(0) lgkmcnt(0)\n\ts_barrier":::"memory"); }
  const int tstart=__builtin_amdgcn_readfirstlane(__float_as_int(prel[128]));
  const bf16*Qw=Q+(rowbase+q0+wid*QBLK)*DM+h*D;
  const bf16*Kh=K+(rowbase+(long)tstart*KVBLK)*DM+h*D,*Vh=V+(rowbase+(long)tstart*KVBLK)*DM+h*D;
  const lds_cptr shm3=(lds_cptr)shm;
  const unsigned lds0=(unsigned)(uintptr_t)shm;
  float*wsf=(float*)(shm+LDS_WS)+wid*64;
  const bf16*ksrc=Kh+(long)lane*DM+wid*8;
  const bf16*vsrc=Vh+(long)(16*(wid&3)+(lane>>2))*DM+(wid>>2)*32+(lane&3)*8;
  const unsigned kdst=lds0+LDS_K+wid*1024, vdst=lds0+LDS_V+wid*1024;
  #define DMA_K(t,slot) glds16(ksrc+(long)(t)*KVBLK*DM,(unsigned)__builtin_amdgcn_readfirstlane(kdst+(slot)))
  #define DMA_V(t,slot) glds16(vsrc+(long)(t)*KVBLK*DM,(unsigned)__builtin_amdgcn_readfirstlane(vdst+(slot)))
  const int vb0=(int)(lds0+LDS_V)+((lane>>4)&1)*32+(lane&3)*8+(4*hi+((lane&15)>>2))*64;
  const char*Kbase=shm+LDS_K; bf16x8 kf[8];
  const lds_cptr kp0=shm3+LDS_K+hi*1024+r32*16; const lds_cptr vp0=shm3+LDS_V+((lane>>4)&1)*32+(lane&3)*8+(4*hi+((lane&15)>>2))*64;
  const int NT=(q0+QB)/KVBLK-tstart;
  DMA_K(0,0);DMA_V(0,0);DMA_K(1,SLOTB);
  bf16x8 qr[4];
  #pragma unroll
  for(int d0=0;d0<4;++d0)qr[d0]=*reinterpret_cast<const bf16x8*>(&Qw[(long)r32*DM+d0*16+hi*8]);
  { const float cref=prel[4*qb];
    for(int s_=64*tstart+tid;s_<256*(qb+1);s_+=NW*64) biasl[s_-64*tstart]=(cref-(prel[s_>>6]+floc[(rowbase+s_)*8+h]))*1.4426950408889634f;
    asm volatile("s_waitcnt vmcnt(0) lgkmcnt(0)\n\ts_barrier":::"memory"); }
  #define BIASINIT(P0,P1,t) do{ const __attribute__((address_space(3))) f32x4b* bq_=(const __attribute__((address_space(3))) f32x4b*)(biasl+64*(t)+4*hi); \
    _Pragma("unroll") for(int g_=0;g_<4;++g_){ const f32x4b x0_=bq_[2*g_],x1_=bq_[8+2*g_]; \
      P0[4*g_]=x0_[0]-mhat;P0[4*g_+1]=x0_[1]-mhat;P0[4*g_+2]=x0_[2]-mhat;P0[4*g_+3]=x0_[3]-mhat; P1[4*g_]=x1_[0]-mhat;P1[4*g_+1]=x1_[1]-mhat;P1[4*g_+2]=x1_[2]-mhat;P1[4*g_+3]=x1_[3]-mhat; } }while(0)
  float mhat=0.f,l_reg=0.f;f32x16 o[2];o[0]=f32x16{};o[1]=f32x16{};
  const int qrel=wid*QBLK+r32;
  #define CMASK(P0,P1,t) do{int jb_=(t)-(NT-4); if(jb_>=0)cmask(P0,P1,jb_,qrel,hi);}while(0)
  bool resc=false;
  #define START(P0,P1) do{ const float rm=rowmax(P0,P1); resc=false; \
    { const float dl=rm; mhat=fadd_s(mhat,dl); \
      _Pragma("unroll") for(int r=0;r<16;++r){P0[r]=fsub_s(P0[r],dl);P1[r]=fsub_s(P1[r],dl);} } \
    _Pragma("unroll") for(int r=0;r<16;++r)P0[r]=__builtin_amdgcn_exp2f(P0[r]); }while(0)
  #define RESC() do{ if(resc){ asm volatile("s_waitcnt lgkmcnt(0)":::"memory"); \
      _Pragma("unroll") for(int d_=0;d_<2;++d_) _Pragma("unroll") for(int r=0;r<16;++r)o[d_][r]*=wsf[crow(r,hi)]; } }while(0)
  f32x16 pA0,pA1,pB0,pB1;
  int sl_prev=0,sl_cur=0,sl_next=SLOTB;
  #define ROT() do{sl_prev=sl_cur;sl_cur=sl_next;sl_next=(sl_next==(NSLOT-1)*SLOTB)?0:sl_next+SLOTB;}while(0)
  DMA_K(2,2*SLOTB);
  WAIT_BAR(3);
  BIASINIT(pA0,pA1,0);qkt(pA0,pA1,Kbase,qr,r32,hi);asm volatile("s_nop 15\n\ts_nop 7":"+v"(pA0),"+v"(pA1));CMASK(pA0,pA1,0);
  START(pA0,pA1);
  _Pragma("unroll") for(int r=0;r<16;++r)pA1[r]=__builtin_amdgcn_exp2f(pA1[r]);
  WAIT_BAR(0);
  DMA_K(3,0);DMA_V(1,SLOTB);
  ROT();
  kload8(kf,kp0+sl_cur);
  WAIT_BAR(2);
  s16x4 vlo[8],vhi[8]; u32x4 pw0,pw1,pw2,pw3;
  #define PKW(P,B) cvtpk_s(P[B],P[B+1])
  #define PAF(k) __builtin_bit_cast(bf16x8,pw##k)
  #define VFR(i) (bf16x8){vlo[i][0],vlo[i][1],vlo[i][2],vlo[i][3],vhi[i][0],vhi[i][1],vhi[i][2],vhi[i][3]}
  #define PIN(x) asm volatile("":"+v"(x))
  #define MX3(a,b,c) __builtin_fmaxf(__builtin_fmaxf((a),(b)),(c))
  #define GAPA(MF,A0,A1,A2,A3,W0,W1,PW) do{ MF; sacc+=A0; sacc+=A1; sacc+=A2; sacc+=A3; PIN(sacc); W0; W1; PIN(PW); SBAR(); }while(0)
  #define EX(v) __builtin_amdgcn_exp2f(v)
  #define GAPB(MF,X,B) do{ MF; X[B]=EX(X[B]); X[B+1]=EX(X[B+1]); X[B+2]=EX(X[B+2]); X[B+3]=EX(X[B+3]); PIN(X); SBAR(); }while(0)
  #define VRD(i) do{ vlo[i]=vtr(vp_+(((i)>>2)*4096+((i)&3)*1024)); vhi[i]=vtr(vp_+(((i)>>2)*4096+((i)&3)*1024+512)); }while(0)
  #define KRD(G,j) do{ if(G){ kload2(kf,kp0+sl_next,j); SBAR(); } }while(0)
  #define STEP(C0,C1,P0,P1,t,GK,GV,GL) do{ SBAR(); BIASINIT(C0,C1,t); SBAR(); \
    const lds_cptr vp_=vp0+sl_prev; \
    VRD(0); SBAR(); float sacc=(P0[0]+P0[1]); \
    GAPA(C0=__builtin_amdgcn_mfma_f32_32x32x16_bf16(kf[0],qr[0],C0,0,0,0), P0[2],P0[3],P0[4],P0[5],     pw0[0]=PKW(P0,0), pw0[1]=PKW(P0,2), pw0); \
    VRD(4); SBAR(); GAPA(C1=__builtin_amdgcn_mfma_f32_32x32x16_bf16(kf[1],qr[0],C1,0,0,0), P0[6],P0[7],P0[8],P0[9],     pw0[2]=PKW(P0,4), pw0[3]=PKW(P0,6), pw0); \
    VRD(1); SBAR(); GAPA(C0=__builtin_amdgcn_mfma_f32_32x32x16_bf16(kf[2],qr[1],C0,0,0,0),   P0[10],P0[11],P0[12],P0[13], pw1[0]=PKW(P0,8), pw1[1]=PKW(P0,10), pw1); \
    VRD(5); SBAR(); GAPA(C1=__builtin_amdgcn_mfma_f32_32x32x16_bf16(kf[3],qr[1],C1,0,0,0),   P0[14],P0[15],P1[0],P1[1],   pw1[2]=PKW(P0,12),pw1[3]=PKW(P0,14), pw1); \
    VRD(2); SBAR(); GAPA(C0=__builtin_amdgcn_mfma_f32_32x32x16_bf16(kf[4],qr[2],C0,0,0,0),   P1[2],P1[3],P1[4],P1[5],     pw2[0]=PKW(P1,0), pw2[1]=PKW(P1,2), pw2); \
    VRD(6); SBAR(); GAPA(C1=__builtin_amdgcn_mfma_f32_32x32x16_bf16(kf[5],qr[2],C1,0,0,0),   P1[6],P1[7],P1[8],P1[9],     pw2[2]=PKW(P1,4), pw2[3]=PKW(P1,6), pw2); \
    VRD(3); SBAR(); GAPA(C0=__builtin_amdgcn_mfma_f32_32x32x16_bf16(kf[6],qr[3],C0,0,0,0),   P1[10],P1[11],P1[12],P1[13], pw3[0]=PKW(P1,8), pw3[1]=PKW(P1,10), pw3); \
    VRD(7); SBAR(); GAPA(C1=__builtin_amdgcn_mfma_f32_32x32x16_bf16(kf[7],qr[3],C1,0,0,0),   P1[14],P1[15],0.f,0.f,       pw3[2]=PKW(P1,12),pw3[3]=PKW(P1,14), pw3); \
    l_reg+=sacc; \
    if(GK){DMA_K((t)+3,sl_cur);} if(GV){DMA_V((t)+1,sl_next);} \
    CMASK(C0,C1,t); \
    { float a=MX3(C0[0],C0[1],C1[0]),b=MX3(C0[2],C0[3],C1[1]); a=MX3(a,C1[2],C1[3]); \
      _Pragma("unroll") for(int r=4;r<16;r+=4){a=MX3(a,C0[r],C0[r+1]);b=MX3(b,C0[r+2],C0[r+3]);a=MX3(a,C1[r],C1[r+1]);b=MX3(b,C1[r+2],C1[r+3]);} \
      float rm=__builtin_fmaxf(a,b); { auto rr=__builtin_amdgcn_permlane32_swap(__float_as_uint(rm),__float_as_uint(rm),false,false); rm=__builtin_fmaxf(__uint_as_float(rr[0]),__uint_as_float(rr[1])); } \
      resc=false; \
      if(__builtin_expect(__any(rm>(float)THRL),0)){ const float dl=__builtin_fmaxf(rm,0.f); mhat+=dl; \
        _Pragma("unroll") for(int r=0;r<16;++r){C0[r]-=dl;C1[r]-=dl;} \
        const float f=__builtin_amdgcn_exp2f(-dl); l_reg*=f; if(hi==0)wsf[r32]=f; resc=true; } } \
    SBAR(); \
    GAPB(o[0]=__builtin_amdgcn_mfma_f32_32x32x16_bf16(PAF(0),VFR(0),o[0],0,0,0), C0,0); \
    GAPB(o[1]=__builtin_amdgcn_mfma_f32_32x32x16_bf16(PAF(0),VFR(4),o[1],0,0,0), C0,4); \
    KRD(GL,0); GAPB(o[0]=__builtin_amdgcn_mfma_f32_32x32x16_bf16(PAF(1),VFR(1),o[0],0,0,0), C0,8); \
    KRD(GL,1); GAPB(o[1]=__builtin_amdgcn_mfma_f32_32x32x16_bf16(PAF(1),VFR(5),o[1],0,0,0), C0,12); \
    KRD(GL,2); GAPB(o[0]=__builtin_amdgcn_mfma_f32_32x32x16_bf16(PAF(2),VFR(2),o[0],0,0,0), C1,0); \
    KRD(GL,3); GAPB(o[1]=__builtin_amdgcn_mfma_f32_32x32x16_bf16(PAF(2),VFR(6),o[1],0,0,0), C1,4); \
    GAPB(o[0]=__builtin_amdgcn_mfma_f32_32x32x16_bf16(PAF(3),VFR(3),o[0],0,0,0), C1,8); \
    GAPB(o[1]=__builtin_amdgcn_mfma_f32_32x32x16_bf16(PAF(3),VFR(7),o[1],0,0,0), C1,12); \
    }while(0)
  int t=1;
  #undef CMASK
  #define CMASK(P0,P1,t) do{}while(0)
  for(;t+5<NT;t+=2){
    STEP(pB0,pB1,pA0,pA1,t,true,true,true);     WAIT_BAR(2); RESC(); ROT();
    STEP(pA0,pA1,pB0,pB1,t+1,true,true,true);   WAIT_BAR(2); RESC(); ROT();
  }
  #undef CMASK
  #define CMASK(P0,P1,t) do{int jb_=(t)-(NT-4); if(jb_>=0)cmask(P0,P1,jb_,qrel,hi);}while(0)
  #define ENDW(tt) do{ if((tt)+3<NT){WAIT_BAR(2);} else if((tt)+2<NT){WAIT_BAR(1);} else {WAIT_BAR(0);} }while(0)
  for(;t+1<NT;t+=2){
    STEP(pB0,pB1,pA0,pA1,t,(t+3<NT),(t+1<NT),(t+1<NT));       ENDW(t);   RESC(); ROT();
    STEP(pA0,pA1,pB0,pB1,t+1,(t+4<NT),(t+2<NT),(t+2<NT));     ENDW(t+1); RESC(); ROT();
  }
  STEP(pB0,pB1,pA0,pA1,NT-1,false,false,false); RESC();
  { float sacc=pB0[0]+pB0[1]; _Pragma("unroll") for(int r=2;r<16;++r)sacc+=pB0[r]; _Pragma("unroll") for(int r=0;r<16;++r)sacc+=pB1[r]; l_reg+=sacc;
    pw0=(u32x4){PKW(pB0,0),PKW(pB0,2),PKW(pB0,4),PKW(pB0,6)};pw1=(u32x4){PKW(pB0,8),PKW(pB0,10),PKW(pB0,12),PKW(pB0,14)};pw2=(u32x4){PKW(pB1,0),PKW(pB1,2),PKW(pB1,4),PKW(pB1,6)};pw3=(u32x4){PKW(pB1,8),PKW(pB1,10),PKW(pB1,12),PKW(pB1,14)};
    SBAR(); pv(o,vb0+sl_cur,PAF(0),PAF(1),PAF(2),PAF(3)); }
  #undef PKW
  #undef PAF
  #undef VFR
  #undef PIN
  #undef MX3
  #undef GAPA
  #undef GAPB
  #undef EX
  #undef VRD
  #undef KRD
  #undef STEP
  #undef ENDW
  {auto rr=__builtin_amdgcn_permlane32_swap(__float_as_uint(l_reg),__float_as_uint(l_reg),false,false);l_reg=__uint_as_float(rr[0])+__uint_as_float(rr[1]);}
  if(hi==0)wsf[32+r32]=l_reg;asm volatile("s_waitcnt lgkmcnt(0)":::"memory");
  float rli[16];
  #pragma unroll
  for(int r=0;r<16;++r)rli[r]=__builtin_amdgcn_rcpf(wsf[32+crow(r,hi)]);
  bf16*Ow=O+(rowbase+q0+wid*QBLK)*OPITCH+h*D;
  { bf16*stg=(bf16*)(shm+LDS_OST)+wid*2048;
    #pragma unroll
    for(int r=0;r<16;++r){const int orow=crow(r,hi);
      #pragma unroll
      for(int d0=0;d0<2;++d0)stg[orow*64+d0*32+r32]=__float2bfloat16(o[d0][r]*rli[r]);}
    asm volatile("s_waitcnt lgkmcnt(0)":::"memory");
    #pragma unroll
    for(int i=0;i<4;++i){const int row=i*8+(lane>>3),ch=lane&7; const u32x4 v=*(const u32x4*)(stg+row*64+ch*8); ATTN_STORE16(Ow+(long)row*OPITCH+ch*8,v);} }
  asm volatile("s_waitcnt lgkmcnt(0)\n\ts_barrier":::"memory");
  #undef DMA_K
  #undef DMA_V
  #undef BIASINIT
  #undef CMASK
  #undef START
  #undef RESC
  #undef ROT
}
constexpr int ATTN_LDS_BYTES=LDS_BYTES;
struct AttnTensors { const bf16* Q; const bf16* K; const bf16* V; bf16* O; const float* floc; const float* ftot; const float* qkn; };
struct AttnUnit { int bh; int qb; };
struct StaticOrder {
  int vcu, G;
  __device__ __forceinline__ explicit StaticOrder(int grid,int block):vcu((grid%8==0)?(block%8)*(grid/8)+block/8:block),G(grid){}
  __device__ __forceinline__ bool next(int i,AttnUnit&u)const{ const int pair=vcu+(i>>1)*G; if(pair>=256)return false; const int s=pair&15; u.bh=pair>>4; u.qb=(i&1)?s:31-s; return true; }
  __device__ __forceinline__ void a_ready(const AttnUnit&)const{}
  __device__ __forceinline__ void done(const AttnUnit&)const{}
};
template<class Sched,int THRL=8> __device__ __forceinline__ void attn_phase(char*lds,const AttnTensors&T,const Sched&S){
  AttnUnit u;
  for(int i=0;S.next(i,u);++i){ S.a_ready(u); attn_unit<THRL>(u.bh/NHEAD,u.bh%NHEAD,u.qb,T.Q,T.K,T.V,T.O,T.floc,T.ftot,T.qkn,lds); S.done(u); }
}
#undef SBAR
#undef WAIT_BAR
}
#define GAS __attribute__((address_space(1)))
#define LAS __attribute__((address_space(3)))
typedef unsigned short bf16;
typedef unsigned v4u __attribute__((ext_vector_type(4)));
typedef float f32x4 __attribute__((ext_vector_type(4)));
typedef short bf16x8 __attribute__((ext_vector_type(8)));
typedef GAS unsigned gu32;
typedef GAS unsigned long long gu64;
#define RLX_AGENT __ATOMIC_RELAXED, __HIP_MEMORY_SCOPE_AGENT
#define LDS_WAIT() asm volatile("s_waitcnt lgkmcnt(0)" ::: "memory")
#define VM_WAIT() asm volatile("s_waitcnt vmcnt(0)" ::: "memory")
__device__ __forceinline__ unsigned long long rt() { return __builtin_amdgcn_s_memrealtime(); }
__device__ __forceinline__ unsigned f2bf(float f) { unsigned u = __builtin_bit_cast(unsigned, f); return (u + 0x7fffu + ((u >> 16) & 1u)) >> 16; }
__device__ __forceinline__ unsigned pk2(float lo, float hi) { return f2bf(lo) | (f2bf(hi) << 16); }

#define XB_TMO      128
#define XB_XCNT(j)  (256  + 64 * (j))
#define XB_XSUB(j)  (1280 + 64 * (j))
#define XB_XGEN(j)  (2304 + 64 * (j))
#define XB_TOP      3328
#define XB_TOPGEN   3392
#define XCD_BAR_WORDS 3456
#define XB_SPIN_CAP (1u << 18)

__device__ __forceinline__ unsigned xb_ld(unsigned* p)              { return __hip_atomic_load(p, __ATOMIC_RELAXED, __HIP_MEMORY_SCOPE_AGENT); }
__device__ __forceinline__ unsigned xb_add(unsigned* p, unsigned v) { return __hip_atomic_fetch_add(p, v, __ATOMIC_RELAXED, __HIP_MEMORY_SCOPE_AGENT); }
__device__ __forceinline__ unsigned xb_xcc_id() { return (unsigned)__builtin_amdgcn_s_getreg((3 << 11) | 20) & 0xFu; }
#define XB_SPIN(cond, bar) do { unsigned _sp = 0; while (cond) { __builtin_amdgcn_s_sleep(1); \
    if ((++_sp & 255u) == 0u) { if (xb_ld(&(bar)[XB_TMO])) break; if (_sp > XB_SPIN_CAP) { atomicAdd(&(bar)[XB_TMO], 1u); break; } } } } while (0)

struct XcdBarrier {
    unsigned* bar; unsigned x;
    volatile LAS unsigned* st;
};

__device__ __forceinline__ XcdBarrier xcd_barrier_post(unsigned* bar, volatile LAS unsigned* st) {
    XcdBarrier b; b.bar = bar; b.x = xb_xcc_id(); b.st = st;
    if (threadIdx.x == 0) (void)xb_add(&bar[XB_XCNT(b.x)], 1u);
    return b;
}
__device__ __forceinline__ void xcd_barrier_complete(unsigned* bar, unsigned x, unsigned& nloc, unsigned& nx) {
    const unsigned G = gridDim.x * gridDim.y * gridDim.z;
    unsigned sum, cnt, mine, sp = 0u;
    for (;;) {
        sum = 0u; cnt = 0u; mine = 0u;
#pragma unroll
        for (unsigned j = 0; j < 16; ++j) { const unsigned c = xb_ld(&bar[XB_XCNT(j)]); sum += c; cnt += (c > 0u) ? 1u : 0u; mine = (j == x) ? c : mine; }
        if (sum == G) break;
        __builtin_amdgcn_s_sleep(1);
        if ((++sp & 255u) == 0u) { if (xb_ld(&bar[XB_TMO])) break; if (sp > XB_SPIN_CAP) { atomicAdd(&bar[XB_TMO], 1u); break; } }
    }
    nloc = mine > 0u ? mine : 1u; nx = cnt > 0u ? cnt : 1u;
}

__device__ __forceinline__ void xcd_barrier(const XcdBarrier& b) {
    asm volatile("s_waitcnt vmcnt(0)" ::: "memory");
    __syncthreads();
    if (threadIdx.x == 0) {
        unsigned* bar = b.bar;
        __builtin_amdgcn_s_waitcnt(0);
        unsigned nloc = b.st[0], nx = b.st[1];
        if (nloc == 0u) { xcd_barrier_complete(bar, b.x, nloc, nx); b.st[0] = nloc; b.st[1] = nx; }
        const unsigned old = xb_add(&bar[XB_XSUB(b.x)], 1u);
        const unsigned gen = old / nloc;
        if (old + 1u == (gen + 1u) * nloc) {
            __builtin_amdgcn_fence(__ATOMIC_RELEASE, "agent");
            asm volatile("s_waitcnt vmcnt(0)" ::: "memory");
            const unsigned og = xb_add(&bar[XB_TOP], 1u);
            const unsigned tg = og / nx;
            if (og + 1u == (tg + 1u) * nx) xb_add(&bar[XB_TOPGEN], 1u);
            else XB_SPIN(xb_ld(&bar[XB_TOPGEN]) == tg, bar);
            __builtin_amdgcn_fence(__ATOMIC_ACQUIRE, "agent");
            xb_add(&bar[XB_XGEN(b.x)], 1u);
            asm volatile("s_waitcnt vmcnt(0)" ::: "memory");
        } else {
            XB_SPIN(xb_ld(&bar[XB_XGEN(b.x)]) == gen, bar);
            __builtin_amdgcn_fence(__ATOMIC_ACQUIRE, "agent");
            asm volatile("s_waitcnt vmcnt(0)" ::: "memory");
        }
    }
    __syncthreads();
}
constexpr int NWAVES = 8, NTHR = 512;
constexpr int BATCH = 2, SEQ = 8192, DMODEL = 1024, MROWS = BATCH * SEQ;
constexpr int N0 = 2560, N0SRC = 2568, DFF = 2816, N1 = 3072, N1SRC = 3088, NEXP = 8, DFFE = 3584;
constexpr int MOE_TILES = 136, MOE_ROWS = MOE_TILES * 256;
constexpr float EPS = 1e-6f, LOG2E = 1.4426950408889634f;
constexpr int NPHASE = 15;
#ifndef MK_ONE_LAUNCH
#define MK_ONE_LAUNCH 1
#endif
constexpr size_t MiB = 1u << 20;
constexpr size_t WS_CTL = 0, CTL_ZERO_BYTES = 65536;
constexpr size_t WS_FLOC0 = 1 * MiB, WS_FLOC1 = WS_FLOC0 + 512 * 1024, WS_IG1 = WS_FLOC1 + 512 * 1024;
constexpr size_t WS_TOKS = WS_IG1 + 512 * 1024;
constexpr size_t WS_SGATE2 = WS_TOKS + 128 * 1024;
constexpr size_t WS_FTOT0 = WS_SGATE2 + 512 * 1024, WS_FTOT1 = WS_FTOT0 + 8192, WS_GMAX1 = WS_FTOT1 + 8192, WS_HIST = WS_GMAX1 + 8192, WS_META = WS_HIST + 8192, WS_QKN = WS_META + 4096;
static_assert(WS_QKN + 32768 <= 4 * MiB, "small arrays");
constexpr size_t WS_EGU8 = 4 * MiB;
constexpr size_t WS_ED8 = 60 * MiB;
constexpr size_t WS_H = 116 * MiB;
constexpr size_t WS_W0IN = 148 * MiB, WS_W0OUT = WS_W0IN + 5 * MiB, WS_W0GU = WS_W0OUT + 2 * MiB, WS_W0D = WS_W0GU + 11 * MiB, WS_W1IN = WS_W0D + 5632 * 1024,
                 WS_WQ = WS_W1IN + 6 * MiB, WS_WK = WS_WQ + 256 * 1024, WS_W1OUT = WS_WK + 256 * 1024;
static_assert(WS_W1OUT + 2 * MiB == 180 * MiB, "dense weights");
constexpr size_t WS_R = 180 * MiB;
constexpr size_t WS_CAT = 276 * MiB, WS_Q1 = 308 * MiB, WS_K1 = 340 * MiB, WS_TST = 372 * MiB;
constexpr size_t WS_X = 392 * MiB;
constexpr size_t WS_ROWSS = 424 * MiB;
constexpr size_t WS_AG8 = 88 * MiB;
constexpr size_t WS_YS = 160 * MiB;
constexpr size_t WS_ACTM8 = 232 * MiB;
constexpr size_t WS_Y = 88 * MiB;
constexpr size_t WS_END = WS_ROWSS + (size_t)MROWS * 64;
static_assert(WS_AG8 + (size_t)8 * 16384 * 1024 <= WS_ACTM8 && WS_Y + (size_t)MOE_ROWS * 1024 * 4 <= WS_ACTM8 && WS_ED8 + (size_t)8 * 1024 * DFFE <= WS_Y && WS_EGU8 + (size_t)8 * 7168 * 1024 <= WS_ED8 && WS_ACTM8 + (size_t)MOE_ROWS * DFFE <= WS_X && WS_TST + (size_t)256 * 160 * 128 * 4 <= WS_X && WS_END <= 455 * MiB, "moe map");
constexpr int CW_TMO = 0, CW_BAR = 4096, CW_CNT = 13056, CW_Q2 = 8256, CW_Q1 = 8320, CW_RDY = 8448;
constexpr int SCR_BYTES = 155648, MISC_OFF = SCR_BYTES, LDS_BYTES = 159744;
__device__ __forceinline__ float bf2f(unsigned short b) { return __uint_as_float((unsigned)b << 16); }
__device__ __forceinline__ float bflo(unsigned w) { return __uint_as_float(w << 16); }
__device__ __forceinline__ float bfhi(unsigned w) { return __uint_as_float(w & 0xffff0000u); }
__device__ __forceinline__ float wave_sum(float v) {
#pragma unroll
    for (int o = 1; o < 64; o <<= 1) v += __shfl_xor(v, o);
    return v;
}
__device__ __forceinline__ float wave_max(float v) {
#pragma unroll
    for (int o = 1; o < 64; o <<= 1) v = fmaxf(v, __shfl_xor(v, o));
    return v;
}
__device__ __forceinline__ float scan_add(float v, int lane) {
#pragma unroll
    for (int o = 1; o < 64; o <<= 1) { const float t = __shfl_up(v, o); if (lane >= o) v += t; }
    return v;
}
__device__ __forceinline__ float scan_max(float v, int lane) {
#pragma unroll
    for (int o = 1; o < 64; o <<= 1) { const float t = __shfl_up(v, o); if (lane >= o) v = fmaxf(v, t); }
    return v;
}
__device__ __forceinline__ float log_sigmoid(float z) { return fminf(z, 0.f) - log1pf(expf(-fabsf(z))); }
__device__ __forceinline__ float sigmoid_f(float z) { return 1.0f / (1.0f + expf(-z)); }

struct KP {
    const float* in[29]; float* out; unsigned char* ws; int ph_lo, ph_hi;
};
typedef const __attribute__((address_space(4))) KP* KPp;
__device__ __forceinline__ KPp kp_get() { KPp q = (KPp)__builtin_amdgcn_kernarg_segment_ptr(); asm volatile("" : "+s"(q)); return q; }
enum { I_X = 0, I_L0N1G, I_L0WIN, I_L0BF, I_L0DWW, I_L0DWB, I_L0CLNG, I_L0CLNB, I_L0WOUT, I_L0N2G, I_L0WG, I_L0WU, I_L0WD,
       I_L1N1G, I_L1WIN, I_L1BI, I_L1BF, I_L1CW, I_L1CB, I_L1WQ, I_L1WK, I_L1HG, I_L1WOUT, I_L1N2G, I_L1RT, I_L1EG, I_L1EU, I_L1ED, I_FNG };

__device__ __forceinline__ void cvt_item(const float* src, int ld, int c0, int k0, bf16* dst, int K, int r0, float scale, LAS float* scr, int lane, const float* ksc = nullptr) {
    const GAS float* s = (const GAS float*)src + (size_t)k0 * ld + c0;
    f32x4 v[16];
#pragma unroll
    for (int i = 0; i < 16; ++i) v[i] = __builtin_nontemporal_load((const GAS f32x4*)(s + (size_t)(4 * i + (lane >> 4)) * ld + 4 * (lane & 15)));
#pragma unroll
    for (int i = 0; i < 16; ++i) { LAS float* p = scr + (4 * i + (lane >> 4)) * 65 + 4 * (lane & 15); p[0] = v[i][0]; p[1] = v[i][1]; p[2] = v[i][2]; p[3] = v[i][3]; }
    LDS_WAIT(); asm volatile("" ::: "memory");
    const int c = lane & 7;
    float ks[8];
#pragma unroll
    for (int i = 0; i < 8; ++i) ks[i] = ksc ? scale * ksc[k0 + 8 * c + i] : scale;
#pragma unroll
    for (int j = 0; j < 8; ++j) { const int n = (lane >> 3) + 8 * j; const LAS float* q = scr + (8 * c) * 65 + n;
        v4u o; o.x = pk2(q[0] * ks[0], q[65] * ks[1]); o.y = pk2(q[130] * ks[2], q[195] * ks[3]); o.z = pk2(q[260] * ks[4], q[325] * ks[5]); o.w = pk2(q[390] * ks[6], q[455] * ks[7]);
        __builtin_nontemporal_store(o, (GAS v4u*)(dst + (size_t)(r0 + n) * K + k0 + 8 * c)); }
    LDS_WAIT(); asm volatile("" ::: "memory");
}
__device__ __forceinline__ void cvt_item8(const float* src, int ld, int c0, int k0, unsigned char* dst, int K, int r0, float scale, LAS float* scr, int lane) {
    const GAS float* s = (const GAS float*)src + (size_t)k0 * ld + c0;
    f32x4 v[16];
#pragma unroll
    for (int i = 0; i < 16; ++i) v[i] = __builtin_nontemporal_load((const GAS f32x4*)(s + (size_t)(4 * i + (lane >> 4)) * ld + 4 * (lane & 15)));
#pragma unroll
    for (int i = 0; i < 16; ++i) { LAS float* p = scr + (4 * i + (lane >> 4)) * 65 + 4 * (lane & 15); p[0] = v[i][0]; p[1] = v[i][1]; p[2] = v[i][2]; p[3] = v[i][3]; }
    LDS_WAIT(); asm volatile("" ::: "memory");
    const int c = lane & 3;
#pragma unroll
    for (int j = 0; j < 4; ++j) { const int n = (lane >> 2) + 16 * j; const LAS float* q = scr + (16 * c) * 65 + n;
        v4u o; o.x = pg8::pk4_fp8(q[0] * scale, q[65] * scale, q[130] * scale, q[195] * scale); o.y = pg8::pk4_fp8(q[260] * scale, q[325] * scale, q[390] * scale, q[455] * scale);
        o.z = pg8::pk4_fp8(q[520] * scale, q[585] * scale, q[650] * scale, q[715] * scale); o.w = pg8::pk4_fp8(q[780] * scale, q[845] * scale, q[910] * scale, q[975] * scale);
        __builtin_nontemporal_store(o, (GAS v4u*)(dst + (size_t)(r0 + n) * K + k0 + 16 * c)); }
    LDS_WAIT(); asm volatile("" ::: "memory");
}
constexpr int CV_DENSE = 16 * 40 + 256 + 16 * 88 + 44 * 16 + 16 * 48 + 32 + 32 + 256, CV_EXP = 8 * 16 * 112 + 8 * 56 * 16, CV_ALL = CV_DENSE + CV_EXP;
constexpr int CV_FIRST = 16 * 40;
constexpr int CV_GEMM1 = 160;
constexpr int CV_TAIL2 = 3072, CV_Q2 = 3072;
__device__ __forceinline__ void convert_weights(KPp p, LAS unsigned char* lds, int it_lo, int it_hi, int gw, int ngw, int lane, int wave) {
    LAS float* scr = (LAS float*)(lds + wave * 16640);
    unsigned char* ws = p->ws;
    constexpr int J0 = 16 * 40, J1 = 256, J2 = 16 * 88, J3 = 44 * 16, J4 = 16 * 48, J5 = 32, J6 = 32, J7 = 256, J8 = 8 * 16 * 112;
    for (int it = it_lo + gw; it < it_hi; it += ngw) {
        const float* src; int ld, c0, k0, K, r0; size_t dsto; float scale = 1.f; bool f8 = false; const float* ksc = nullptr;
        int r = it;
        if (r < J0) { const int kb = r / 40, nb = r % 40, n0 = nb * 64; src = p->in[I_L0WIN]; ld = N0SRC; c0 = n0 < 1536 ? n0 : n0 + 8; k0 = kb * 64; dsto = WS_W0IN; K = 1024; r0 = n0; }
        else if ((r -= J0) < J1) { const int kb = r / 16, nb = r % 16; src = p->in[I_L0WOUT]; ld = 1024; c0 = nb * 64; k0 = kb * 64; dsto = WS_W0OUT; K = 1024; r0 = nb * 64; }
        else if ((r -= J1) < J2) { const int kb = r / 88, nb = r % 88, n0 = nb * 64, pn = n0 >> 8, j = n0 & 255; src = j < 128 ? p->in[I_L0WG] : p->in[I_L0WU]; ld = DFF; c0 = 128 * pn + (j & 127); k0 = kb * 64; dsto = WS_W0GU; K = 1024; r0 = n0; ksc = p->in[I_L0N2G]; }
        else if ((r -= J2) < J3) { const int kb = r / 16, nb = r % 16; src = p->in[I_L0WD]; ld = 1024; c0 = nb * 64; k0 = kb * 64; dsto = WS_W0D; K = DFF; r0 = nb * 64; }
        else if ((r -= J3) < J4) { const int kb = r / 48, nb = r % 48; src = p->in[I_L1WIN]; ld = N1SRC; c0 = nb * 64; k0 = kb * 64; dsto = WS_W1IN; K = 1024; r0 = nb * 64; }
        else if ((r -= J4) < J5) { const int h = r >> 2, kb = (r >> 1) & 1, nb = r & 1; src = p->in[I_L1WQ] + (size_t)h * 16384; ld = 128; c0 = nb * 64; k0 = kb * 64; dsto = WS_WQ + (size_t)h * 32768; K = 128; r0 = nb * 64; }
        else if ((r -= J5) < J6) { const int h = r >> 2, kb = (r >> 1) & 1, nb = r & 1; src = p->in[I_L1WK] + (size_t)h * 16384; ld = 128; c0 = nb * 64; k0 = kb * 64; dsto = WS_WK + (size_t)h * 32768; K = 128; r0 = nb * 64; scale = 0.08838834764831845f; }
        else if ((r -= J6) < J7) { const int kb = r / 16, nb = r % 16; src = p->in[I_L1WOUT]; ld = 1024; c0 = nb * 64; k0 = kb * 64; dsto = WS_W1OUT; K = 1024; r0 = nb * 64; }
        else if ((r -= J7) < J8) { const int e = r / (16 * 112), q = r % (16 * 112), kb = q / 112, nb = q % 112, n0 = nb * 64, pn = n0 >> 8, j = n0 & 255;
            src = (j < 128 ? p->in[I_L1EG] : p->in[I_L1EU]) + (size_t)e * 1024 * DFFE; ld = DFFE; c0 = 128 * pn + (j & 127); k0 = kb * 64; dsto = WS_EGU8 + (size_t)e * 7168 * 1024; K = 1024; r0 = n0; f8 = true; scale = 32.f; }
        else { r -= J8; const int e = r / (56 * 16), q = r % (56 * 16), kb = q / 16, nb = q % 16;
            src = p->in[I_L1ED] + (size_t)e * DFFE * 1024; ld = 1024; c0 = nb * 64; k0 = kb * 64; dsto = WS_ED8 + (size_t)e * 1024 * DFFE; K = DFFE; r0 = nb * 64; f8 = true; scale = 64.f; }
        if (f8) cvt_item8(src, ld, c0, k0, ws + dsto, K, r0, scale, scr, lane);
        else cvt_item(src, ld, c0, k0, (bf16*)(ws + dsto), K, r0, scale, scr, lane, ksc);
    }
}

__device__ __forceinline__ void convert_queue(KPp p, LAS unsigned char* lds, unsigned* ctr, int it_lo, int n, int tid, int lane, int wave) {
    LAS int* slot = (LAS int*)(lds + 135168);
    int nxt = 0; if (tid == 0) nxt = (int)atomicAdd(ctr, 8u);
    for (;;) {
        if (tid == 0) slot[0] = nxt;
        __syncthreads();
        const int base = slot[0];
        __syncthreads();
        if (base >= n) break;
        if (tid == 0) nxt = (int)atomicAdd(ctr, 8u);
        if (base + wave < n) convert_weights(p, lds, it_lo + base + wave, it_lo + base + wave + 1, 0, 1, lane, wave);
    }
}

template <int MODE, bool SRCB> __device__ __forceinline__ void norm_phase(KPp p, LAS unsigned char* lds, int tid, int lane, int wave, const void* src, const float* gain, bf16* dst) {
    constexpr int NC = MODE == 0 ? 0 : (MODE == 2 ? 16 : 8);
    unsigned char* ws = p->ws;
    LAS float* wt = (LAS float*)lds;
    LAS float* gt = (LAS float*)(lds + 65536);
    LAS int* et = (LAS int*)(lds + 65536 + 4096);
    LAS int* lr = et + 128; LAS float* gl = (LAS float*)(et + 256); LAS int* eb = et + 384;
    LAS unsigned char* rc = lds + 73728;
    v4u cb[4][2], nb[4][2]; f32x4 cf[4][2][2], nf[4][2][2];
#define NP_LOAD(RB, RF, BLK, BT) do { const int row0_ = (BLK) * 64 + wave * 8 + (BT) * 4; \
        _Pragma("unroll") for (int r_ = 0; r_ < 4; ++r_) _Pragma("unroll") for (int j_ = 0; j_ < 2; ++j_) { \
            if (SRCB) RB[r_][j_] = *(const GAS v4u*)((const bf16*)src + (size_t)(row0_ + r_) * DMODEL + 8 * lane + 512 * j_); \
            else { const GAS f32x4* xr_ = (const GAS f32x4*)((const float*)src + (size_t)(row0_ + r_) * DMODEL + 8 * lane + 512 * j_); RF[r_][j_][0] = xr_[0]; RF[r_][j_][1] = xr_[1]; } } } while (0)
    if ((int)blockIdx.x < MROWS / 64) NP_LOAD(cb, cf, (int)blockIdx.x, 0);
    if (NC) {
        const float* wsrc = MODE == 1 ? p->in[I_L0WIN] + 1536 : MODE == 2 ? p->in[I_L1WIN] + 3072 : p->in[I_L1RT];
        const int wld = MODE == 1 ? N0SRC : MODE == 2 ? N1SRC : 8;
        for (int k = tid; k < 1024; k += NTHR) {
#pragma unroll
            for (int c4 = 0; c4 < NC / 4; ++c4) { const f32x4 w = *(const GAS f32x4*)(wsrc + (size_t)k * wld + 4 * c4);
                wt[(4 * c4 + 0) * 1024 + k] = w[0]; wt[(4 * c4 + 1) * 1024 + k] = w[1]; wt[(4 * c4 + 2) * 1024 + k] = w[2]; wt[(4 * c4 + 3) * 1024 + k] = w[3]; }
        }
        __syncthreads();
    }
    float g[2][8];
#pragma unroll
    for (int j = 0; j < 2; ++j) { const f32x4 a = *(const GAS f32x4*)(gain + 8 * lane + 512 * j), c = *(const GAS f32x4*)(gain + 8 * lane + 512 * j + 4);
        g[j][0] = a[0]; g[j][1] = a[1]; g[j][2] = a[2]; g[j][3] = a[3]; g[j][4] = c[0]; g[j][5] = c[1]; g[j][6] = c[2]; g[j][7] = c[3]; }
    for (int blk = blockIdx.x; blk < MROWS / 64; blk += gridDim.x) {
#pragma unroll 1
        for (int bt = 0; bt < 2; ++bt) {
            const int rl0 = wave * 8 + bt * 4;
            { const int nblk = bt ? blk + (int)gridDim.x : blk; if (nblk < MROWS / 64) NP_LOAD(nb, nf, nblk, bt ^ 1); }
            float v[4][2][8];
#pragma unroll
            for (int r = 0; r < 4; ++r) { const int row = blk * 64 + rl0 + r; float ss = 0.f;
#pragma unroll
                for (int j = 0; j < 2; ++j) {
                    if (SRCB) { const v4u x = cb[r][j];
                        v[r][j][0] = bflo(x.x); v[r][j][1] = bfhi(x.x); v[r][j][2] = bflo(x.y); v[r][j][3] = bfhi(x.y); v[r][j][4] = bflo(x.z); v[r][j][5] = bfhi(x.z); v[r][j][6] = bflo(x.w); v[r][j][7] = bfhi(x.w); }
                    else { const f32x4 a = cf[r][j][0], c = cf[r][j][1];
                        v[r][j][0] = a[0]; v[r][j][1] = a[1]; v[r][j][2] = a[2]; v[r][j][3] = a[3]; v[r][j][4] = c[0]; v[r][j][5] = c[1]; v[r][j][6] = c[2]; v[r][j][7] = c[3]; }
#pragma unroll
                    for (int e = 0; e < 8; ++e) ss += v[r][j][e] * v[r][j][e]; }
                const float rstd = rsqrtf(wave_sum(ss) * (1.f / DMODEL) + EPS);
#pragma unroll
                for (int j = 0; j < 2; ++j) {
#pragma unroll
                    for (int e = 0; e < 8; ++e) v[r][j][e] = v[r][j][e] * rstd * g[j][e];
                    v4u o; o.x = pk2(v[r][j][0], v[r][j][1]); o.y = pk2(v[r][j][2], v[r][j][3]); o.z = pk2(v[r][j][4], v[r][j][5]); o.w = pk2(v[r][j][6], v[r][j][7]);
                    if (MODE != 3) *(GAS v4u*)(dst + (size_t)row * DMODEL + 8 * lane + 512 * j) = o;
                    else { typedef unsigned u32x2 __attribute__((ext_vector_type(2))); *(LAS u32x2*)(rc + (rl0 + r) * 1024 + 8 * lane + 512 * j) = (u32x2){pg8::pk4_fp8(4.f * v[r][j][0], 4.f * v[r][j][1], 4.f * v[r][j][2], 4.f * v[r][j][3]), pg8::pk4_fp8(4.f * v[r][j][4], 4.f * v[r][j][5], 4.f * v[r][j][6], 4.f * v[r][j][7])}; } } }
            if (NC) {
                constexpr int NP = 4 * (NC ? NC : 1);
                float pt[NP];
#pragma unroll
                for (int c = 0; c < NC; ++c) {
                    f32x4 w[2][2];
#pragma unroll
                    for (int j = 0; j < 2; ++j) { w[j][0] = *(const LAS f32x4*)(wt + c * 1024 + 8 * lane + 512 * j); w[j][1] = *(const LAS f32x4*)(wt + c * 1024 + 8 * lane + 512 * j + 4); }
#pragma unroll
                    for (int r = 0; r < 4; ++r) { float s = 0.f;
#pragma unroll
                        for (int j = 0; j < 2; ++j) s += (v[r][j][0] * w[j][0][0] + v[r][j][1] * w[j][0][1]) + (v[r][j][2] * w[j][0][2] + v[r][j][3] * w[j][0][3]) + (v[r][j][4] * w[j][1][0] + v[r][j][5] * w[j][1][1]) + (v[r][j][6] * w[j][1][2] + v[r][j][7] * w[j][1][3]);
                        pt[r * NC + c] = s; } }
                if (NP == 32) {
#pragma unroll
                    for (int i = 0; i < NP; ++i) pt[i] += __shfl_xor(pt[i], 32); }
#pragma unroll
                for (int hh = NP / 2, mask = (NP == 64 ? 32 : 16); hh >= 1; hh >>= 1, mask >>= 1) { const bool up = (lane & mask) != 0;
#pragma unroll
                    for (int i = 0; i < hh; ++i) { const float keep = up ? pt[i + hh] : pt[i], send = up ? pt[i] : pt[i + hh]; pt[i] = keep + __shfl_xor(send, mask); } }
                const int pi = lane & (NP - 1);
                if (lane < NP) gt[(rl0 + pi / NC) * 16 + (pi % NC)] = pt[0];
            }
#pragma unroll
            for (int r = 0; r < 4; ++r)
#pragma unroll
                for (int j = 0; j < 2; ++j) { if (SRCB) cb[r][j] = nb[r][j]; else { cf[r][j][0] = nf[r][j][0]; cf[r][j][1] = nf[r][j][1]; } }
        }
        if (MODE == 3) {
            __syncthreads();
            if (wave == 0) { float a[8];
#pragma unroll
                for (int c = 0; c < 8; ++c) a[c] = gt[lane * 16 + c];
                int e1 = 0; float l1 = a[0];
#pragma unroll
                for (int c = 1; c < 8; ++c) if (a[c] > l1) { l1 = a[c]; e1 = c; }
                int e2 = -1; float l2 = -INFINITY;
#pragma unroll
                for (int c = 0; c < 8; ++c) if (c != e1 && a[c] > l2) { l2 = a[c]; e2 = c; }
                const float g1 = 1.f / (1.f + expf(l2 - l1)), g2 = 1.f - g1;
                int r1 = 0, r2 = 0, mycnt = 0;
#pragma unroll
                for (int e = 0; e < 8; ++e) { const unsigned long long m = __ballot(e1 == e || e2 == e);
                    const int before = (int)__builtin_amdgcn_mbcnt_hi((unsigned)(m >> 32), __builtin_amdgcn_mbcnt_lo((unsigned)m, 0u));
                    if (e1 == e) r1 = before; if (e2 == e) r2 = before; if (lane == e) mycnt = __popcll(m); }
                et[lane * 2] = e1; et[lane * 2 + 1] = e2; gl[lane * 2] = g1; gl[lane * 2 + 1] = g2; lr[lane * 2] = r1; lr[lane * 2 + 1] = r2;
                if (lane < 8) eb[lane] = (int)atomicAdd((unsigned*)(ws + WS_CTL) + CW_CNT + 32 * lane, (unsigned)mycnt); }
        }
        if (NC) {
            __syncthreads();
            const int row = blk * 64 + lane, h = wave;
            if (MODE == 1) {
                const float lf = log_sigmoid(gt[lane * 16 + h] + p->in[I_L0BF][h]); const float cs = scan_add(lf, lane);
                ((float*)(ws + WS_FLOC0))[row * 8 + h] = cs; if (lane == 63) ((float*)(ws + WS_FTOT0))[blk * 8 + h] = cs;
            } else if (MODE == 2) {
                const float li = gt[lane * 16 + h] + p->in[I_L1BI][h]; const float lf = log_sigmoid(gt[lane * 16 + 8 + h] + p->in[I_L1BF][h]); const float cs = scan_add(lf, lane);
                ((float*)(ws + WS_FLOC1))[row * 8 + h] = cs; ((float*)(ws + WS_IG1))[row * 8 + h] = li;
                const float gm = wave_max(li - cs);
                if (lane == 63) { ((float*)(ws + WS_FTOT1))[blk * 8 + h] = cs; ((float*)(ws + WS_GMAX1))[blk * 8 + h] = gm; }
            } else if (MODE == 3) {
                for (int rr = 0; rr < 8; ++rr) { const int rl = wave * 8 + rr; const v4u rowv = *(const LAS v4u*)(rc + rl * 1024 + lane * 16);
#pragma unroll
                    for (int k = 0; k < 2; ++k) { const int e = et[rl * 2 + k]; const int sr = e * 16384 + eb[e] + lr[rl * 2 + k];
                        if (lane == 0) { ((int*)(ws + WS_TOKS))[(blk * 64 + rl) * 2 + k] = sr; ((float*)(ws + WS_SGATE2))[sr] = gl[rl * 2 + k]; }
                        *(GAS v4u*)(ws + WS_AG8 + (size_t)sr * 1024 + lane * 16) = rowv; } }
            }
            __syncthreads();
        }
    }
}

__device__ __forceinline__ void final_phase(KPp p, int lane, int wave) {
    unsigned char* ws = p->ws; const bf16* Y = (const bf16*)(ws + WS_Y); const bf16* X = (const bf16*)(ws + WS_X);
    float g[2][8];
#pragma unroll
    for (int j = 0; j < 2; ++j) { const f32x4 a = *(const GAS f32x4*)(p->in[I_FNG] + 8 * lane + 512 * j), c = *(const GAS f32x4*)(p->in[I_FNG] + 8 * lane + 512 * j + 4);
        g[j][0] = a[0]; g[j][1] = a[1]; g[j][2] = a[2]; g[j][3] = a[3]; g[j][4] = c[0]; g[j][5] = c[1]; g[j][6] = c[2]; g[j][7] = c[3]; }
    int ct[8]; { int acc = 0;
#pragma unroll
        for (int e = 0; e < 8; ++e) { ct[e] = acc; acc += (int)((((const unsigned*)(ws + WS_CTL))[CW_CNT + 32 * e] + 255) >> 8); } }
    for (int row = blockIdx.x * NWAVES + wave; row < MROWS; row += gridDim.x * NWAVES) {
        const int r1 = ((const int*)(ws + WS_TOKS))[row * 2], r2 = ((const int*)(ws + WS_TOKS))[row * 2 + 1];
        int c1 = 0, c2 = 0;
#pragma unroll
        for (int k = 1; k < 8; ++k) { if ((r1 >> 14) >= k) c1 = ct[k]; if ((r2 >> 14) >= k) c2 = ct[k]; }
        const int s1 = c1 * 256 + (r1 & 16383), s2 = c2 * 256 + (r2 & 16383);
        float v[2][8]; float ss = 0.f; const bf16* YS = (const bf16*)(ws + WS_YS);
#pragma unroll
        for (int j = 0; j < 2; ++j) { const int c0 = 8 * lane + 512 * j; const v4u zz = {0u, 0u, 0u, 0u}; const v4u x = *(const GAS v4u*)(X + (size_t)row * DMODEL + c0), y1 = s1 < 32768 ? *(const GAS v4u*)(Y + (size_t)s1 * DMODEL + c0) : zz, y2 = s2 < 32768 ? *(const GAS v4u*)(Y + (size_t)s2 * DMODEL + c0) : zz;
            v[j][0] = bflo(x.x) + bflo(y1.x) + bflo(y2.x); v[j][1] = bfhi(x.x) + bfhi(y1.x) + bfhi(y2.x); v[j][2] = bflo(x.y) + bflo(y1.y) + bflo(y2.y); v[j][3] = bfhi(x.y) + bfhi(y1.y) + bfhi(y2.y);
            v[j][4] = bflo(x.z) + bflo(y1.z) + bflo(y2.z); v[j][5] = bfhi(x.z) + bfhi(y1.z) + bfhi(y2.z); v[j][6] = bflo(x.w) + bflo(y1.w) + bflo(y2.w); v[j][7] = bfhi(x.w) + bfhi(y1.w) + bfhi(y2.w);
#pragma unroll
            for (int q = 0; q < 2; ++q) { const int sq = q ? s2 : s1; if (sq >= 32768) {
                for (int ks = 0; ks < 7; ++ks) { const v4u y = *(const GAS v4u*)(YS + ((size_t)ks * 2048 + (sq - 32768)) * DMODEL + c0);
                    v[j][0] += bflo(y.x); v[j][1] += bfhi(y.x); v[j][2] += bflo(y.y); v[j][3] += bfhi(y.y); v[j][4] += bflo(y.z); v[j][5] += bfhi(y.z); v[j][6] += bflo(y.w); v[j][7] += bfhi(y.w); } } }
#pragma unroll
            for (int e = 0; e < 8; ++e) ss += v[j][e] * v[j][e]; }
        const float rstd = rsqrtf(wave_sum(ss) * (1.f / DMODEL) + EPS);
#pragma unroll
        for (int j = 0; j < 2; ++j) { GAS f32x4* o = (GAS f32x4*)(p->out + (size_t)row * DMODEL + 8 * lane + 512 * j);
            o[0] = (f32x4){v[j][0] * rstd * g[j][0], v[j][1] * rstd * g[j][1], v[j][2] * rstd * g[j][2], v[j][3] * rstd * g[j][3]};
            o[1] = (f32x4){v[j][4] * rstd * g[j][4], v[j][5] * rstd * g[j][5], v[j][6] * rstd * g[j][6], v[j][7] * rstd * g[j][7]}; }
    }
}

__device__ __forceinline__ float fast_sigmoid(float z) { return __builtin_amdgcn_rcpf(1.0f + __builtin_amdgcn_exp2f(-1.4426950408889634f * z)); }
__device__ __forceinline__ void conv_phase(KPp p, LAS unsigned char* lds, int tid, int lane, int wave) {
    unsigned char* ws = p->ws; const bf16* P0 = (const bf16*)(ws + WS_R); bf16* CAT = (bf16*)(ws + WS_CAT);
    LAS bf16* ub = (LAS bf16*)lds;
    LAS float* yt = (LAS float*)(lds + 96256);
    const int c = tid;
    float w[31];
#pragma unroll
    for (int j = 0; j < 31; ++j) w[j] = p->in[I_L0DWW][j * 512 + c];
    const float bias = p->in[I_L0DWB][c];
    const f32x4 ga = *(const GAS f32x4*)(p->in[I_L0CLNG] + lane * 8), gb = *(const GAS f32x4*)(p->in[I_L0CLNG] + lane * 8 + 4), ba = *(const GAS f32x4*)(p->in[I_L0CLNB] + lane * 8), bb = *(const GAS f32x4*)(p->in[I_L0CLNB] + lane * 8 + 4);
    for (int u = blockIdx.x; u < MROWS / 64; u += gridDim.x) {
        const int row0 = u * 64, b = row0 / SEQ, t0 = row0 % SEQ;
        {
            v4u av[12], gv[12];
#pragma unroll
            for (int i = 0; i < 12; ++i) { const int q = tid + NTHR * i, r = q >> 6, ch = q & 63, t = t0 - 30 + r; av[i] = (v4u){0u, 0u, 0u, 0u}; gv[i] = av[i];
                if (r < 94 && t >= 0) { const bf16* s = P0 + (size_t)(b * SEQ + t) * N0 + 1536 + 8 * ch; av[i] = *(const GAS v4u*)s; gv[i] = *(const GAS v4u*)(s + 512); } }
#pragma unroll
            for (int i = 0; i < 12; ++i) { const int q = tid + NTHR * i, r = q >> 6, ch = q & 63;
                if (r < 94) { v4u o;
                    o.x = pk2(bflo(av[i].x) * fast_sigmoid(bflo(gv[i].x)), bfhi(av[i].x) * fast_sigmoid(bfhi(gv[i].x))); o.y = pk2(bflo(av[i].y) * fast_sigmoid(bflo(gv[i].y)), bfhi(av[i].y) * fast_sigmoid(bfhi(gv[i].y)));
                    o.z = pk2(bflo(av[i].z) * fast_sigmoid(bflo(gv[i].z)), bfhi(av[i].z) * fast_sigmoid(bfhi(gv[i].z))); o.w = pk2(bflo(av[i].w) * fast_sigmoid(bflo(gv[i].w)), bfhi(av[i].w) * fast_sigmoid(bfhi(gv[i].w)));
                    *(LAS v4u*)(ub + r * 512 + 8 * ch) = o; } }
        }
        __syncthreads();
        for (int sub = 0; sub < 4; ++sub) {
            float y[16];
#pragma unroll
            for (int i = 0; i < 16; ++i) y[i] = bias;
            const LAS bf16* ucol = ub + (sub * 16) * 512 + c;
#pragma unroll
            for (int r = 0; r < 46; ++r) { const float uv = bf2f(ucol[r * 512]);
#pragma unroll
                for (int i = 0; i < 16; ++i) { const int j = r - i; if (j >= 0 && j <= 30) y[i] += w[j] * uv; } }
#pragma unroll
            for (int i = 0; i < 16; ++i) yt[i * 512 + c] = y[i];
            __syncthreads();
#pragma unroll
            for (int k = 0; k < 2; ++k) { const int i = wave * 2 + k;
                const f32x4 v0 = *(const LAS f32x4*)(yt + i * 512 + lane * 8), v1 = *(const LAS f32x4*)(yt + i * 512 + lane * 8 + 4);
                const float mu = wave_sum((v0[0] + v0[1]) + (v0[2] + v0[3]) + (v1[0] + v1[1]) + (v1[2] + v1[3])) * (1.f / 512.f);
                const f32x4 d0 = v0 - mu, d1 = v1 - mu;
                const float var = wave_sum((d0[0] * d0[0] + d0[1] * d0[1]) + (d0[2] * d0[2] + d0[3] * d0[3]) + (d1[0] * d1[0] + d1[1] * d1[1]) + (d1[2] * d1[2] + d1[3] * d1[3])) * (1.f / 512.f);
                const float rstd = rsqrtf(var + EPS);
                f32x4 o0 = d0 * rstd * ga + ba, o1 = d1 * rstd * gb + bb;
#pragma unroll
                for (int e = 0; e < 4; ++e) { o0[e] = o0[e] * fast_sigmoid(o0[e]); o1[e] = o1[e] * fast_sigmoid(o1[e]); }
                v4u o; o.x = pk2(o0[0], o0[1]); o.y = pk2(o0[2], o0[3]); o.z = pk2(o1[0], o1[1]); o.w = pk2(o1[2], o1[3]);
                *(GAS v4u*)(CAT + (size_t)(row0 + sub * 16 + i) * 1024 + 512 + lane * 8) = o; }
            __syncthreads();
        }
    }
}
namespace ml {
typedef float f32x16 __attribute__((ext_vector_type(16)));
typedef short s16x4 __attribute__((ext_vector_type(4)));
typedef unsigned u32x2 __attribute__((ext_vector_type(2)));
constexpr int LD = 136, LDV = 160, LDK = 160, LDP = 72, LDH = 132;
constexpr int O_QL = 0, O_KL = 17408, O_KP = 34816, O_VL = 55296, O_PL = 75776, O_SL = 93184, O_TB = 136704;
constexpr int O_PLB = 75776, O_HSB = 84992, O_SLB = 102400, O_TBB = 145920;
constexpr int T_FPRE = 0, T_MST = 128, T_G2 = 272, T_M2 = 336, T_WI = 400, T_EDM = 464, T_NQ = 528, T_WS = 592, T_CW = 656, T_HG = 1296, T_END = 1296 + 128, T_DB2 = T_END;
static_assert(O_TB + T_END * 4 <= SCR_BYTES && O_TBB + (T_DB2 + 320) * 4 <= SCR_BYTES, "mlstm lds");
__device__ __forceinline__ f32x16 mfma32(bf16x8 a, bf16x8 b, f32x16 c) { return __builtin_amdgcn_mfma_f32_32x32x16_bf16(a, b, c, 0, 0, 0); }
__device__ __forceinline__ const LAS bf16* tr_lane(const LAS bf16* X, int ldx, int lane) { const int g4 = lane >> 4, hh = g4 >> 1, cg = g4 & 1, i = lane & 15, q = i >> 2, pp = i & 3; return X + (8 * hh + q) * ldx + 16 * cg + 4 * pp; }
__device__ __forceinline__ bf16x8 tr_frag(const LAS bf16* a, int ldx, int off) {
    const s16x4 lo = __builtin_bit_cast(s16x4, __builtin_amdgcn_ds_read_tr16_b64_v4i16((LAS s16x4*)(a + off)));
    const s16x4 hi = __builtin_bit_cast(s16x4, __builtin_amdgcn_ds_read_tr16_b64_v4i16((LAS s16x4*)(a + off + 4 * ldx)));
    return (bf16x8){lo[0], lo[1], lo[2], lo[3], hi[0], hi[1], hi[2], hi[3]};
}
#define ML_BAR() asm volatile("s_waitcnt lgkmcnt(0)\n\ts_barrier" ::: "memory")
#define ML_LAUNDER(ptr) asm volatile("" : "+v"(ptr))
__device__ __forceinline__ f32x16 mma_nt8(f32x16 acc, const LAS bf16* a, const LAS bf16* b) {
#pragma unroll
    for (int ks = 0; ks < 8; ++ks) acc = mfma32(*(const LAS bf16x8*)(a + 16 * ks), *(const LAS bf16x8*)(b + 16 * ks), acc);
    return acc;
}
__device__ __forceinline__ void st4(LAS bf16* d, float a, float b, float c, float e) { *(LAS u32x2*)d = (u32x2){pk2(a, b), pk2(c, e)}; }
__device__ __forceinline__ void gate_setup(const unsigned char* ws, LAS float* tb, int b, int h, int lane, int wave) {
    if (wave == 0) {
        const float* ft = (const float*)(ws + WS_FTOT1); const float* gm = (const float*)(ws + WS_GMAX1);
        const float a0 = ft[(b * 128 + lane) * 8 + h], a1 = ft[(b * 128 + 64 + lane) * 8 + h];
        const float s0 = scan_add(a0, lane), s1 = scan_add(a1, lane) + __shfl(s0, 63);
        const float f0 = s0 - a0, f1 = s1 - a1;
        tb[T_FPRE + lane] = f0; tb[T_FPRE + 64 + lane] = f1;
        const float m0 = scan_max(gm[(b * 128 + lane) * 8 + h] - f0, lane); const float m1 = fmaxf(scan_max(gm[(b * 128 + 64 + lane) * 8 + h] - f1, lane), __shfl(m0, 63));
        tb[T_MST + 1 + lane] = fmaxf(m0, 0.f); tb[T_MST + 65 + lane] = fmaxf(m1, 0.f); if (lane == 0) tb[T_MST] = 0.f;
    }
}
__device__ __forceinline__ void unpack16(const v4u x0, const v4u x1, float (&f)[16]) {
    f[0] = bflo(x0.x); f[1] = bfhi(x0.x); f[2] = bflo(x0.y); f[3] = bfhi(x0.y); f[4] = bflo(x0.z); f[5] = bfhi(x0.z); f[6] = bflo(x0.w); f[7] = bfhi(x0.w);
    f[8] = bflo(x1.x); f[9] = bfhi(x1.x); f[10] = bflo(x1.y); f[11] = bfhi(x1.y); f[12] = bflo(x1.z); f[13] = bfhi(x1.z); f[14] = bflo(x1.w); f[15] = bfhi(x1.w);
}
__device__ __forceinline__ void pack16(const float (&f)[16], v4u& x0, v4u& x1) {
    x0.x = pk2(f[0], f[1]); x0.y = pk2(f[2], f[3]); x0.z = pk2(f[4], f[5]); x0.w = pk2(f[6], f[7]); x1.x = pk2(f[8], f[9]); x1.y = pk2(f[10], f[11]); x1.z = pk2(f[12], f[13]); x1.w = pk2(f[14], f[15]);
}

__device__ __forceinline__ void pass_a(KPp p, LAS unsigned char* lds, int tid, int lane, int wave) {
    unsigned char* ws = p->ws;
    const bf16* P1 = (const bf16*)(ws + WS_R); bf16* Q1 = (bf16*)(ws + WS_Q1); bf16* K1 = (bf16*)(ws + WS_K1); float* TST = (float*)(ws + WS_TST);
    const float* FLOC1 = (const float*)(ws + WS_FLOC1); const float* IG1 = (const float*)(ws + WS_IG1);
    LAS bf16* Ql = (LAS bf16*)(lds + O_QL); LAS bf16* Kl = (LAS bf16*)(lds + O_KL); LAS bf16* Kp = (LAS bf16*)(lds + O_KP); LAS bf16* Vl = (LAS bf16*)(lds + O_VL); LAS bf16* Ul = (LAS bf16*)(lds + O_PL);
    LAS bf16* Xl0 = (LAS bf16*)(lds + O_SL);
    LAS float* tb = (LAS float*)(lds + O_TB);
    const int r = lane & 31, hh = lane >> 5, vtile = wave & 3, kt0 = 2 * (wave >> 2), t = tid >> 3, dg = tid & 7;
    const unsigned voffX = (unsigned)(t * N1 + 16 * dg), voffQ = (unsigned)(t * 1024 + 16 * dg), voffG = (unsigned)(t * 8);
    const LAS bf16* const trV = tr_lane(Vl, LDV, lane); const LAS bf16* const trK = tr_lane(Kp, LDK, lane);
#define ML_XLOAD(cidx, x0_, x1_, h0_, h1_) do { const bf16* xs_ = P1 + ((size_t)b * SEQ + (size_t)(cidx) * 64) * N1 + h * 128; x0_ = *(const GAS v4u*)(xs_ + voffX); x1_ = *(const GAS v4u*)(xs_ + voffX + 8); \
        h0_ = (v4u){0u, 0u, 0u, 0u}; h1_ = h0_; if (t < 3 && (cidx) > 0) { const bf16* hs_ = xs_ - (size_t)3 * N1; h0_ = *(const GAS v4u*)(hs_ + voffX); h1_ = *(const GAS v4u*)(hs_ + voffX + 8); } } while (0)
#define ML_XSTORE(xb, x0_, x1_, h0_, h1_) do { *(LAS v4u*)((xb) + (t + 3) * LD + 16 * dg) = x0_; *(LAS v4u*)((xb) + (t + 3) * LD + 16 * dg + 8) = x1_; \
        if (t < 3) { *(LAS v4u*)((xb) + t * LD + 16 * dg) = h0_; *(LAS v4u*)((xb) + t * LD + 16 * dg + 8) = h1_; } } while (0)
    for (int unit = blockIdx.x; unit < 256; unit += gridDim.x) {
        const int b = unit >> 7, h = (unit >> 4) & 7, j = unit & 15;
        { v4u x0, x1, h0, h1; ML_XLOAD(8 * j, x0, x1, h0, h1); ML_XSTORE(Xl0, x0, x1, h0, h1); }
        gate_setup(ws, tb, b, h, lane, wave);
        for (int idx = tid; idx < 640; idx += NTHR) { const int jj = idx >> 7, d = idx & 127; tb[T_CW + idx] = jj < 4 ? p->in[I_L1CW][jj * 1024 + h * 128 + d] : p->in[I_L1CB][h * 128 + d]; }
        *(LAS u32x2*)(Vl + t * LDV + 128 + 4 * dg) = (u32x2){dg == 0 ? 0x3F80u : 0u, 0u};
        bf16x8 wf[8];
        { const bf16* wsrc = (const bf16*)(ws + (wave < 4 ? WS_WQ : WS_WK)) + (size_t)(h * 128 + (wave & 3) * 32 + r) * 128 + 8 * hh;
#pragma unroll
          for (int ks = 0; ks < 8; ++ks) wf[ks] = *(const GAS bf16x8*)(wsrc + 16 * ks); }
        f32x16 aT0 = {}, aT1 = {}, aN = {};
        ML_BAR();
        const float Mend = tb[T_MST + 8 * j + 8];
#pragma unroll 1
        for (int cc = 0; cc < 8; ++cc) {
            const int c = 8 * j + cc; const size_t row0 = (size_t)b * SEQ + c * 64;
            const LAS bf16* Xl = Xl0 + (cc & 1) * (67 * LD); LAS bf16* Xn = Xl0 + ((cc & 1) ^ 1) * (67 * LD);
            const LAS bf16* tV = trV; const LAS bf16* tK = trK; ML_LAUNDER(tV); ML_LAUNDER(tK);
            const LAS bf16* tVv = tV + vtile * 32; const LAS bf16* tKk = tK + kt0 * 32; const LAS bf16* tKw = tK + wave * 32;
            {
                const bf16* vs = P1 + row0 * N1 + 1024 + h * 128; const v4u v0 = *(const GAS v4u*)(vs + voffX), v1 = *(const GAS v4u*)(vs + voffX + 8);
                const float gi = (IG1 + row0 * 8 + h)[voffG], fl = (FLOC1 + row0 * 8 + h)[voffG];
                float yv[16];
#pragma unroll
                for (int i = 0; i < 16; ++i) yv[i] = tb[T_CW + 512 + 16 * dg + i];
#pragma unroll
                for (int jj = 0; jj < 4; ++jj) { float xf[16]; unpack16(*(const LAS v4u*)(Xl + (t + jj) * LD + 16 * dg), *(const LAS v4u*)(Xl + (t + jj) * LD + 16 * dg + 8), xf);
#pragma unroll
                    for (int i = 0; i < 16; ++i) yv[i] += tb[T_CW + jj * 128 + 16 * dg + i] * xf[i]; }
#pragma unroll
                for (int i = 0; i < 16; ++i) yv[i] = yv[i] * fast_sigmoid(yv[i]);
                v4u u0, u1; pack16(yv, u0, u1); *(LAS v4u*)(Ul + t * LD + 16 * dg) = u0; *(LAS v4u*)(Ul + t * LD + 16 * dg + 8) = u1;
                *(LAS v4u*)(Vl + t * LDV + 16 * dg) = v0; *(LAS v4u*)(Vl + t * LDV + 16 * dg + 8) = v1;
                if (dg == 0) tb[T_WS + t] = expf(gi - (tb[T_FPRE + c] + fl) - Mend);
            }
            ML_BAR();
            {
                f32x16 a0 = {}, a1 = {}; const LAS bf16* ub = Ul + r * LD + 8 * hh; const int et = wave & 3;
#pragma unroll
                for (int ks = 0; ks < 8; ++ks) { a0 = mfma32(wf[ks], *(const LAS bf16x8*)(ub + 16 * ks), a0); a1 = mfma32(wf[ks], *(const LAS bf16x8*)(ub + 32 * LD + 16 * ks), a1); }
                if (wave < 4) {
#pragma unroll
                    for (int g = 0; g < 4; ++g) { const int e0 = et * 32 + 8 * g + 4 * hh;
                        st4(Ql + r * LD + e0, a0[4 * g], a0[4 * g + 1], a0[4 * g + 2], a0[4 * g + 3]); st4(Ql + (32 + r) * LD + e0, a1[4 * g], a1[4 * g + 1], a1[4 * g + 2], a1[4 * g + 3]); }
                } else { const float w0 = tb[T_WS + r], w1 = tb[T_WS + 32 + r];
#pragma unroll
                    for (int g = 0; g < 4; ++g) { const int e0 = et * 32 + 8 * g + 4 * hh;
                        st4(Kl + r * LD + e0, a0[4 * g], a0[4 * g + 1], a0[4 * g + 2], a0[4 * g + 3]); st4(Kl + (32 + r) * LD + e0, a1[4 * g], a1[4 * g + 1], a1[4 * g + 2], a1[4 * g + 3]);
                        st4(Kp + r * LDK + e0, a0[4 * g] * w0, a0[4 * g + 1] * w0, a0[4 * g + 2] * w0, a0[4 * g + 3] * w0); st4(Kp + (32 + r) * LDK + e0, a1[4 * g] * w1, a1[4 * g + 1] * w1, a1[4 * g + 2] * w1, a1[4 * g + 3] * w1); } }
            }
            ML_BAR();
            {
                v4u x0 = {}, x1 = {}, h0 = {}, h1 = {};
                if (cc < 7) ML_XLOAD(c + 1, x0, x1, h0, h1);
                bf16* qd = Q1 + row0 * 1024 + h * 128; bf16* kd = K1 + row0 * 1024 + h * 128;
                *(GAS v4u*)(qd + voffQ) = *(const LAS v4u*)(Ql + t * LD + 16 * dg); *(GAS v4u*)(qd + voffQ + 8) = *(const LAS v4u*)(Ql + t * LD + 16 * dg + 8);
                *(GAS v4u*)(kd + voffQ) = *(const LAS v4u*)(Kl + t * LD + 16 * dg); *(GAS v4u*)(kd + voffQ + 8) = *(const LAS v4u*)(Kl + t * LD + 16 * dg + 8);
#pragma unroll
                for (int ks = 0; ks < 4; ++ks) { const bf16x8 bv = tr_frag(tVv, LDV, 16 * ks * LDV), a0 = tr_frag(tKk, LDK, 16 * ks * LDK), a1 = tr_frag(tKk, LDK, 16 * ks * LDK + 32);
                    aT0 = mfma32(a0, bv, aT0); aT1 = mfma32(a1, bv, aT1); }
                if (wave < 4) {
#pragma unroll
                    for (int ks = 0; ks < 4; ++ks) { const bf16x8 bn = tr_frag(tV, LDV, 16 * ks * LDV + 128), a = tr_frag(tKw, LDK, 16 * ks * LDK); aN = mfma32(a, bn, aN); } }
                if (cc < 7) ML_XSTORE(Xn, x0, x1, h0, h1);
            }
            ML_BAR();
        }
        {
            bf16* T = (bf16*)TST + ((size_t)unit * 8 + wave) * (12 * 64 * 4) + lane * 4;
#pragma unroll
            for (int g = 0; g < 4; ++g) { *(GAS u32x2*)(T + g * 256) = (u32x2){pk2(aT0[4 * g], aT0[4 * g + 1]), pk2(aT0[4 * g + 2], aT0[4 * g + 3])};
                *(GAS u32x2*)(T + (4 + g) * 256) = (u32x2){pk2(aT1[4 * g], aT1[4 * g + 1]), pk2(aT1[4 * g + 2], aT1[4 * g + 3])};
                if (wave < 4) *(GAS u32x2*)(T + (8 + g) * 256) = (u32x2){pk2(aN[4 * g], aN[4 * g + 1]), pk2(aN[4 * g + 2], aN[4 * g + 3])}; }
        }
    }
#undef ML_XLOAD
#undef ML_XSTORE
}

__device__ __forceinline__ void pass_b(KPp p, LAS unsigned char* lds, int tid, int lane, int wave) {
    unsigned char* ws = p->ws;
    const bf16* P1 = (const bf16*)(ws + WS_R); const bf16* Q1 = (const bf16*)(ws + WS_Q1); const bf16* K1 = (const bf16*)(ws + WS_K1); const float* TST = (const float*)(ws + WS_TST); bf16* CAT = (bf16*)(ws + WS_CAT);
    const float* FLOC1 = (const float*)(ws + WS_FLOC1); const float* IG1 = (const float*)(ws + WS_IG1);
    LAS bf16* Ql = (LAS bf16*)(lds + O_QL); LAS bf16* Kl = (LAS bf16*)(lds + O_KL); LAS bf16* Kp = (LAS bf16*)(lds + O_KP); LAS bf16* Vl = (LAS bf16*)(lds + O_VL); LAS bf16* Pl = (LAS bf16*)(lds + O_PLB);
    LAS bf16* Sl = (LAS bf16*)(lds + O_SLB); LAS bf16* Hst = (LAS bf16*)(lds + O_HSB); LAS float* tb = (LAS float*)(lds + O_TBB);
    const int r = lane & 31, hh = lane >> 5, vth = wave >> 1, ttile = wave & 1, vtile = wave & 3, kt0 = 2 * (wave >> 2), t = tid >> 3, dg = tid & 7;
    const unsigned voffX = (unsigned)(t * N1 + 16 * dg), voffQ = (unsigned)(t * 1024 + 16 * dg), voffG = (unsigned)(t * 8);
    const LAS bf16* const trV = tr_lane(Vl, LDV, lane); const LAS bf16* const trK = tr_lane(Kp, LDK, lane);
    for (int unit = blockIdx.x; unit < 256; unit += gridDim.x) {
        const int b = unit >> 7, h = (unit >> 4) & 7, j = unit & 15;
        v4u nq0, nq1, nk0, nk1, nv0, nv1; float ngi, nfl, ngil = 0.f, nfll = 0.f;
#define ML_LOAD_B(cidx) do { const size_t rw_ = (size_t)b * SEQ + (size_t)(cidx) * 64; const bf16* qs_ = Q1 + rw_ * 1024 + h * 128; const bf16* ks2_ = K1 + rw_ * 1024 + h * 128; const bf16* vs_ = P1 + rw_ * N1 + 1024 + h * 128; \
            nq0 = *(const GAS v4u*)(qs_ + voffQ); nq1 = *(const GAS v4u*)(qs_ + voffQ + 8); nk0 = *(const GAS v4u*)(ks2_ + voffQ); nk1 = *(const GAS v4u*)(ks2_ + voffQ + 8); nv0 = *(const GAS v4u*)(vs_ + voffX); nv1 = *(const GAS v4u*)(vs_ + voffX + 8); \
            ngi = (IG1 + rw_ * 8 + h)[voffG]; nfl = (FLOC1 + rw_ * 8 + h)[voffG]; if (wave == 0) { ngil = (IG1 + rw_ * 8 + h)[lane * 8]; nfll = (FLOC1 + rw_ * 8 + h)[lane * 8]; } } while (0)
        ML_LOAD_B(8 * j);
        gate_setup(ws, tb, b, h, lane, wave);
        if (tid < 128) tb[T_HG + tid] = p->in[I_L1HG][h * 128 + tid];
        *(LAS u32x2*)(Vl + t * LDV + 128 + 4 * dg) = (u32x2){dg == 0 ? 0x3F80u : 0u, 0u};
        ML_BAR();
        f32x16 S0 = {}, S1 = {}, SN = {};
        { const float Mstart = tb[T_MST + 8 * j];
#pragma unroll 4
          for (int jp = 0; jp < j; ++jp) { const float wgt = expf(tb[T_MST + 8 * jp + 8] - Mstart); const bf16* T = (const bf16*)TST + ((size_t)(unit - j + jp) * 8 + wave) * (12 * 64 * 4) + lane * 4;
#pragma unroll
              for (int g = 0; g < 4; ++g) { const u32x2 x0 = *(const GAS u32x2*)(T + g * 256), x1 = *(const GAS u32x2*)(T + (4 + g) * 256);
                  S0[4 * g] += wgt * bflo(x0.x); S0[4 * g + 1] += wgt * bfhi(x0.x); S0[4 * g + 2] += wgt * bflo(x0.y); S0[4 * g + 3] += wgt * bfhi(x0.y);
                  S1[4 * g] += wgt * bflo(x1.x); S1[4 * g + 1] += wgt * bfhi(x1.x); S1[4 * g + 2] += wgt * bflo(x1.y); S1[4 * g + 3] += wgt * bfhi(x1.y);
                  if (wave < 4) { const u32x2 xn = *(const GAS u32x2*)(T + (8 + g) * 256);
                      SN[4 * g] += wgt * bflo(xn.x); SN[4 * g + 1] += wgt * bfhi(xn.x); SN[4 * g + 2] += wgt * bflo(xn.y); SN[4 * g + 3] += wgt * bfhi(xn.y); } } } }
#define ML_WRITE_SL() do { _Pragma("unroll") for (int g = 0; g < 4; ++g) { const int k0 = kt0 * 32 + 8 * g + 4 * hh; \
            st4(Sl + (vtile * 32 + r) * LD + k0, S0[4 * g], S0[4 * g + 1], S0[4 * g + 2], S0[4 * g + 3]); st4(Sl + (vtile * 32 + r) * LD + k0 + 32, S1[4 * g], S1[4 * g + 1], S1[4 * g + 2], S1[4 * g + 3]); \
            if (wave < 4) st4(Sl + (128 + r) * LD + wave * 32 + 8 * g + 4 * hh, SN[4 * g], SN[4 * g + 1], SN[4 * g + 2], SN[4 * g + 3]); } } while (0)
        ML_WRITE_SL();
        v4u oc0, oc1;
#define ML_STEP1(cidx, par_, more_) do { const int c_ = (cidx); const float Mc_ = tb[T_MST + c_], Mc1_ = tb[T_MST + c_ + 1], Fp_ = tb[T_FPRE + c_]; const int to_ = (par_) ? (T_DB2 - T_G2) : 0; \
            const bf16* os_ = P1 + ((size_t)b * SEQ + (size_t)c_ * 64) * N1 + 2048 + h * 128; oc0 = *(const GAS v4u*)(os_ + voffX); oc1 = *(const GAS v4u*)(os_ + voffX + 8); \
            const float w_ = expf(ngi - (Fp_ + nfl) - Mc1_); \
            *(LAS v4u*)(Ql + t * LD + 16 * dg) = nq0; *(LAS v4u*)(Ql + t * LD + 16 * dg + 8) = nq1; *(LAS v4u*)(Kl + t * LD + 16 * dg) = nk0; *(LAS v4u*)(Kl + t * LD + 16 * dg + 8) = nk1; \
            *(LAS v4u*)(Vl + t * LDV + 16 * dg) = nv0; *(LAS v4u*)(Vl + t * LDV + 16 * dg + 8) = nv1; \
            float kf_[16]; unpack16(nk0, nk1, kf_); _Pragma("unroll") for (int i = 0; i < 16; ++i) kf_[i] *= w_; \
            v4u p0_, p1_; pack16(kf_, p0_, p1_); *(LAS v4u*)(Kp + t * LDK + 16 * dg) = p0_; *(LAS v4u*)(Kp + t * LDK + 16 * dg + 8) = p1_; \
            if (wave == 0) { const float F_ = Fp_ + nfll; const float Gl_ = ngil - F_; const float M_ = fmaxf(Mc_, scan_max(Gl_, lane)); \
                tb[T_G2 + to_ + lane] = Gl_ * LOG2E; tb[T_M2 + to_ + lane] = M_ * LOG2E; tb[T_WI + to_ + lane] = expf(Mc_ - M_); tb[T_EDM + to_ + lane] = expf(-(F_ + M_)); } \
            if (more_) ML_LOAD_B(c_ + 1); } while (0)
        ML_STEP1(8 * j, 0, true);
        ML_BAR();
#pragma unroll 1
        for (int cc = 0; cc < 8; ++cc) {
            const int c = 8 * j + cc; const size_t row0 = (size_t)b * SEQ + c * 64; const int to = (cc & 1) ? (T_DB2 - T_G2) : 0;
            const float Mc = tb[T_MST + c], Mc1 = tb[T_MST + c + 1];
            const LAS bf16* tV = trV; const LAS bf16* tK = trK; ML_LAUNDER(tV); ML_LAUNDER(tK);
            const LAS bf16* tVv = tV + vtile * 32; const LAS bf16* tVh = tV + vth * 32; const LAS bf16* tKk = tK + kt0 * 32; const LAS bf16* tKw = tK + wave * 32;
            f32x16 aH = {}, aNq = {};
            {
                const LAS bf16* qb = Ql + (ttile * 32 + r) * LD + 8 * hh;
                aH = mma_nt8(aH, Sl + (vth * 32 + r) * LD + 8 * hh, qb);
                if (wave < 4) { const int stile = wave >> 1; f32x16 aP = {}; aP = mma_nt8(aP, Kl + (stile * 32 + r) * LD + 8 * hh, qb);
                    const int tq = ttile * 32 + r; const float m2 = tb[T_M2 + to + tq];
#pragma unroll
                    for (int g = 0; g < 4; ++g) { const int s0 = stile * 32 + 8 * g + 4 * hh; const f32x4 gg = *(const LAS f32x4*)(tb + T_G2 + to + s0); float pv[4];
#pragma unroll
                        for (int i = 0; i < 4; ++i) pv[i] = (s0 + i <= tq) ? aP[4 * g + i] * __builtin_amdgcn_exp2f(gg[i] - m2) : 0.f;
                        st4(Pl + tq * LDP + s0, pv[0], pv[1], pv[2], pv[3]); }
                } else if (wave < 6) { aNq = mma_nt8(aNq, Sl + (128 + r) * LD + 8 * hh, qb); }
            }
            ML_BAR();
            {
                const float wi = tb[T_WI + to + ttile * 32 + r];
#pragma unroll
                for (int i = 0; i < 16; ++i) aH[i] *= wi;
                const LAS bf16* pb = Pl + (ttile * 32 + r) * LDP + 8 * hh;
#pragma unroll
                for (int ks = 0; ks < 4; ++ks) aH = mfma32(tr_frag(tVh, LDV, 16 * ks * LDV), *(const LAS bf16x8*)(pb + 16 * ks), aH);
                if (wave >= 4 && wave < 6) {
#pragma unroll
                    for (int i = 0; i < 16; ++i) aNq[i] *= wi;
#pragma unroll
                    for (int ks = 0; ks < 4; ++ks) aNq = mfma32(tr_frag(tV, LDV, 16 * ks * LDV + 128), *(const LAS bf16x8*)(pb + 16 * ks), aNq);
                    if (hh == 0) tb[T_NQ + to + ttile * 32 + r] = aNq[0]; }
                { const int tq = ttile * 32 + r;
#pragma unroll
                  for (int g = 0; g < 4; ++g) st4(Hst + tq * LD + vth * 32 + 8 * g + 4 * hh, aH[4 * g], aH[4 * g + 1], aH[4 * g + 2], aH[4 * g + 3]); }
                const float dec = expf(Mc - Mc1);
#pragma unroll
                for (int i = 0; i < 16; ++i) { S0[i] *= dec; S1[i] *= dec; SN[i] *= dec; }
#pragma unroll
                for (int ks = 0; ks < 4; ++ks) { const bf16x8 bv = tr_frag(tVv, LDV, 16 * ks * LDV), a0 = tr_frag(tKk, LDK, 16 * ks * LDK), a1 = tr_frag(tKk, LDK, 16 * ks * LDK + 32);
                    S0 = mfma32(a0, bv, S0); S1 = mfma32(a1, bv, S1); }
                if (wave < 4) {
#pragma unroll
                    for (int ks = 0; ks < 4; ++ks) { const bf16x8 bn = tr_frag(tV, LDV, 16 * ks * LDV + 128), a = tr_frag(tKw, LDK, 16 * ks * LDK); SN = mfma32(a, bn, SN); } }
                ML_WRITE_SL();
            }
            ML_BAR();
            {
                float hv[16]; unpack16(*(const LAS v4u*)(Hst + t * LD + 16 * dg), *(const LAS v4u*)(Hst + t * LD + 16 * dg + 8), hv);
                const float inv = 1.0f / fmaxf(fabsf(tb[T_NQ + to + t]), tb[T_EDM + to + t]);
                float of[16]; unpack16(oc0, oc1, of);
                float ss = 0.f;
#pragma unroll
                for (int i = 0; i < 16; ++i) { hv[i] *= inv * fast_sigmoid(of[i]); ss += hv[i] * hv[i]; }
                ss += __shfl_xor(ss, 1); ss += __shfl_xor(ss, 2); ss += __shfl_xor(ss, 4);
                const float rstd = rsqrtf(ss * (1.f / 128.f) + EPS);
#pragma unroll
                for (int i = 0; i < 16; ++i) hv[i] = hv[i] * rstd * tb[T_HG + 16 * dg + i];
                v4u o0, o1; pack16(hv, o0, o1); bf16* od = CAT + row0 * 1024 + h * 128; *(GAS v4u*)(od + voffQ) = o0; *(GAS v4u*)(od + voffQ + 8) = o1;
            }
            if (cc < 7) ML_STEP1(c + 1, (cc + 1) & 1, cc < 6);
            ML_BAR();
        }
#undef ML_STEP1
#undef ML_WRITE_SL
#undef ML_LOAD_B
    }
}
}
__global__ void __launch_bounds__(NTHR, 2) fwd_kernel(KP p_unused) {
    extern __shared__ __attribute__((aligned(16))) unsigned char lds_raw[];
    LAS unsigned char* lds = (LAS unsigned char*)lds_raw;
    volatile LAS unsigned* MISC = (volatile LAS unsigned*)(lds + MISC_OFF);
    const int G = gridDim.x;
#define PH_IDS int tid = threadIdx.x; asm volatile("" : "+v"(tid)); const int lane = tid & 63, wave = __builtin_amdgcn_readfirstlane(tid >> 6); (void)lane; (void)wave;
    KPp p = kp_get();
    unsigned char* ws = p->ws;
    gu32* ctl = (gu32*)(ws + WS_CTL);
    { int t0 = threadIdx.x; asm volatile("" : "+v"(t0)); for (int u = t0; u < (LDS_BYTES - MISC_OFF) / 4; u += NTHR) ((LAS unsigned*)(lds + MISC_OFF))[u] = 0u; }
    __syncthreads();
    { const int lo0 = p->ph_lo, hi0 = p->ph_hi;
      if (hi0 - lo0 > 1) (void)xcd_barrier_post((unsigned*)(ctl + CW_BAR), MISC + 8); }
#define IN(k) (((p = kp_get()), (ws = p->ws), true) && p->ph_lo <= (k) && (k) < p->ph_hi)
#define SEAM(k) do { if (IN(k) && IN((k) + 1)) { XcdBarrier bar_; bar_.bar = (unsigned*)((gu32*)(ws + WS_CTL) + CW_BAR); bar_.x = xb_xcc_id(); bar_.st = (volatile LAS unsigned*)((LAS unsigned char*)lds_raw + MISC_OFF) + 8; xcd_barrier(bar_); } } while (0)
#define H ((bf16*)(ws + WS_H))
#define SEAMX() do { XcdBarrier bar_; bar_.bar = (unsigned*)((gu32*)(ws + WS_CTL) + CW_BAR); bar_.x = xb_xcc_id(); bar_.st = (volatile LAS unsigned*)((LAS unsigned char*)lds_raw + MISC_OFF) + 8; xcd_barrier(bar_); } while (0)
    if (IN(0)) { PH_IDS convert_weights(p, lds, 0, (G == 256 ? CV_FIRST : CV_ALL), blockIdx.x * NWAVES + wave, G * NWAVES, lane, wave); __syncthreads();
        norm_phase<1, false>(p, lds, tid, lane, wave, p->in[I_X], p->in[I_L0N1G], H); }
    SEAM(0);
    if (IN(1)) { if (G != 256 || blockIdx.x < CV_GEMM1) { const int Gg = G == 256 ? CV_GEMM1 : G;
        pg8::Gemm g{H, (const bf16*)(ws + WS_W0IN), MROWS, N0, 1024}; pg8::StaticOrder S; S.init(MROWS, N0, Gg, (int)blockIdx.x);
        pg8::EpiL0In E{(bf16*)(ws + WS_R), N0, attn_body::C2, (float*)(ws + WS_QKN)};
        pg8::gemm_phase<pg8::EpiL0In, pg8::StaticOrder, true, true>(lds, g, S, E); }
        if (G == 256) { PH_IDS __syncthreads(); convert_queue(p, lds, (unsigned*)(ws + WS_CTL) + CW_Q1, CV_FIRST, CV_ALL - CV_TAIL2 - CV_Q2 - CV_FIRST, tid, lane, wave); }     }
    SEAM(1);
    if (IN(2)) { const attn_body::bf16* P0 = (const attn_body::bf16*)(ws + WS_R);
        const attn_body::AttnTensors AT{P0, P0 + 512, P0 + 1024, (attn_body::bf16*)(ws + WS_CAT), (const float*)(ws + WS_FLOC0), (const float*)(ws + WS_FTOT0), (const float*)(ws + WS_QKN)};
        const attn_body::StaticOrder S(G, (int)blockIdx.x);
        attn_body::attn_phase<attn_body::StaticOrder>((char*)lds_raw, AT, S);
        __syncthreads();
        { PH_IDS conv_phase(p, lds, tid, lane, wave); if (G == 256) convert_queue(p, lds, (unsigned*)(ws + WS_CTL) + CW_Q2, CV_ALL - CV_TAIL2 - CV_Q2, CV_Q2, tid, lane, wave); } }
    SEAM(2);
    if (IN(3)) { pg8::Gemm g{(const bf16*)(ws + WS_CAT), (const bf16*)(ws + WS_W0OUT), MROWS, 1024, 1024}; pg8::StaticOrder S; S.init(MROWS, 1024, G, (int)blockIdx.x);
        pg8::EpiRes<true> E{p->in[I_X], (bf16*)(ws + WS_X), 1024, (float*)(ws + WS_ROWSS)};
        pg8::gemm_phase<pg8::EpiRes<true>, pg8::StaticOrder, true, true>(lds, g, S, E); }
    SEAM(3);
    if (IN(4)) { pg8::Gemm g{(const bf16*)(ws + WS_X), (const bf16*)(ws + WS_W0GU), MROWS, 2 * DFF, 1024};     pg8::StaticOrder S; S.init(MROWS, 2 * DFF, G, (int)blockIdx.x);
        pg8::EpiSwiGLU E{(bf16*)(ws + WS_R), DFF, (const float*)(ws + WS_ROWSS)};
        pg8::gemm_phase<pg8::EpiSwiGLU, pg8::StaticOrder, true, true>(lds, g, S, E);
        if (G == 256 && blockIdx.x >= 128) { PH_IDS __syncthreads(); convert_weights(p, lds, CV_ALL - CV_TAIL2, CV_ALL, (blockIdx.x - 128) * NWAVES + wave, 128 * NWAVES, lane, wave); } }
    SEAM(4);
    if (IN(5)) { pg8::Gemm g{(const bf16*)(ws + WS_R), (const bf16*)(ws + WS_W0D), MROWS, 1024, DFF}; pg8::StaticOrder S; S.init(MROWS, 1024, G, (int)blockIdx.x);
        pg8::EpiRes<false> E{ws + WS_X, (bf16*)(ws + WS_X), 1024, nullptr};
        pg8::gemm_phase<pg8::EpiRes<false>, pg8::StaticOrder, true, true>(lds, g, S, E); }
    SEAM(5);
    if (IN(6)) { PH_IDS norm_phase<2, true>(p, lds, tid, lane, wave, ws + WS_X, p->in[I_L1N1G], H); }
    SEAM(6);
    if (IN(7)) { pg8::Gemm g{H, (const bf16*)(ws + WS_W1IN), MROWS, N1, 1024}; pg8::StaticOrder S; S.init(MROWS, N1, G, (int)blockIdx.x);
        pg8::EpiBf16<0> E{(bf16*)(ws + WS_R), N1, nullptr, 0, 0, 1.f};
        pg8::gemm_phase<pg8::EpiBf16<0>, pg8::StaticOrder, true, true>(lds, g, S, E); }
    SEAM(7);
    if (IN(8)) { PH_IDS ml::pass_a(p, lds, tid, lane, wave); }
    SEAM(8);
    if (IN(9)) { PH_IDS ml::pass_b(p, lds, tid, lane, wave); }
    SEAM(9);
    if (IN(10)) { pg8::Gemm g{(const bf16*)(ws + WS_CAT), (const bf16*)(ws + WS_W1OUT), MROWS, 1024, 1024}; pg8::StaticOrder S; S.init(MROWS, 1024, G, (int)blockIdx.x);
        pg8::EpiRes<false> E{ws + WS_X, (bf16*)(ws + WS_X), 1024, nullptr};
        pg8::gemm_phase<pg8::EpiRes<false>, pg8::StaticOrder, true, true>(lds, g, S, E); }
    SEAM(10);
    if (IN(11)) { PH_IDS norm_phase<3, true>(p, lds, tid, lane, wave, ws + WS_X, p->in[I_L1N2G], H); }
    SEAM(11);
    if (IN(12)) { pg8::Gemm8 g{ws + WS_AG8, ws + WS_EGU8, MOE_ROWS, 2 * DFFE, 1024}; pg8::MoeOrder S; S.init((const unsigned*)(ws + WS_CTL) + CW_CNT, 2 * DFFE / 256, G, (int)blockIdx.x, true, (unsigned*)(ws + WS_CTL) + CW_RDY);
        pg8::EpiSwiGLU8 E{ws + WS_ACTM8, DFFE, 0.0078125f, 4.f};
        pg8::gemm_phase_f8<pg8::EpiSwiGLU8, pg8::MoeOrder, true, true>(lds, g, S, E); }
    if (IN(13)) { pg8::Gemm8 g{ws + WS_ACTM8, ws + WS_ED8, MOE_ROWS, 1024, DFFE}; pg8::MoeDownOrder S; S.init((const unsigned*)(ws + WS_CTL) + CW_CNT, G, (int)blockIdx.x, (const unsigned*)(ws + WS_CTL) + CW_RDY);
        pg8::EpiRowScale E{(bf16*)(ws + WS_Y), 1024, (const float*)(ws + WS_SGATE2), 0.00390625f, (bf16*)(ws + WS_YS)};
        pg8::gemm_phase_f8<pg8::EpiRowScale, pg8::MoeDownOrder, true, true>(lds, g, S, E); }
    SEAM(13);
    if (IN(14)) { PH_IDS final_phase(p, lane, wave); }
#undef IN
#undef SEAM
#undef SEAMX
#undef H
#undef PH_IDS
}

extern "C" void kernel_launch(void* const* d_in, const int* in_sizes, int n_in, void* d_out, int out_size, void* d_ws, size_t ws_size, hipStream_t stream) {
    static int grid = 0;
    if (grid == 0) {
        if (n_in != 29 || in_sizes[0] != MROWS * DMODEL || out_size != MROWS * DMODEL || ws_size < WS_END) { fprintf(stderr, "kernel_launch: unexpected problem (n_in %d, ws %zu < %zu?)\n", n_in, ws_size, (size_t)WS_END); grid = -1; return; }
        int dev = 0, cus = 0, per_cu = 0;
        if (hipGetDevice(&dev) != hipSuccess || hipDeviceGetAttribute(&cus, hipDeviceAttributeMultiprocessorCount, dev) != hipSuccess) { grid = -1; return; }
        if (hipFuncSetAttribute((const void*)fwd_kernel, hipFuncAttributeMaxDynamicSharedMemorySize, LDS_BYTES) != hipSuccess) { fprintf(stderr, "kernel_launch: hipFuncSetAttribute failed\n"); grid = -1; return; }
        if (hipOccupancyMaxActiveBlocksPerMultiprocessor(&per_cu, (const void*)fwd_kernel, NTHR, LDS_BYTES) != hipSuccess || per_cu < 1) { fprintf(stderr, "kernel_launch: occupancy query says %d\n", per_cu); }
        (void)hipGetLastError();
        grid = cus > 256 ? 256 : cus;
    }
    if (grid < 0) return;
    (void)hipMemsetAsync((char*)d_ws + WS_CTL, 0, CTL_ZERO_BYTES, stream);
    KP a{};
    for (int i = 0; i < 29; ++i) a.in[i] = (const float*)d_in[i];
    a.out = (float*)d_out; a.ws = (unsigned char*)d_ws;
#if MK_ONE_LAUNCH
    a.ph_lo = 0; a.ph_hi = NPHASE;
    hipLaunchKernelGGL(fwd_kernel, dim3(grid), dim3(NTHR), LDS_BYTES, stream, a);
#else
    for (int ph = 0; ph < NPHASE; ++ph) { a.ph_lo = ph; a.ph_hi = ph + 1; hipLaunchKernelGGL(fwd_kernel, dim3(grid), dim3(NTHR), LDS_BYTES, stream, a); }
#endif
}
```

```cpp
#include <hip/hip_runtime.h>
#include <cstdio>
#include <cstdint>
#include <cmath>
#ifndef WGM_D
#define WGM_D 2
#endif
#ifndef WGM_M
#define WGM_M 2
#endif
#ifndef MK_ONE_LAUNCH
#define MK_ONE_LAUNCH 1
#endif
namespace pg8 {
#define PG8_LAS __attribute__((address_space(3)))
typedef unsigned short bf16_t;
typedef short bf16x8 __attribute__((ext_vector_type(8)));
typedef float f32x4 __attribute__((ext_vector_type(4)));
typedef unsigned u32x4 __attribute__((ext_vector_type(4)));
constexpr int BM = 256, BK = 64, HALF = 128, HTB = HALF * BK * 2  , STAGE_BYTES = 8 * HTB, NXCD = 8, WGM = 8, WGM_DENSE = WGM_D, WGM_MOE = WGM_M;

__host__ __device__ __forceinline__ int lds_byte(int r, int c) { const int st = (r >> 4) * 2 + (c >> 5), rr = r & 15, cc = c & 31, ob = rr * 64 + cc * 2; return st * 1024 + (ob ^ (((ob >> 9) & 1) << 5)); }
__host__ __device__ __forceinline__ void stage_rc(int b, int& R, int& C) { const int st = b / 1024, sb = b % 1024, swz = sb ^ (((sb >> 9) & 1) << 5); R = (st >> 1) * 16 + swz / 64; C = (st & 1) * 32 + (swz % 64) / 2; }
__host__ __device__ __forceinline__ int perm32(int rho) { const int n = rho >> 4, i = rho & 15; return 8 * (i >> 2) + 4 * n + (i & 3); }

struct Unit { int pm, pn, pb, pa, ps, kt0, nkt, ys; };
struct Gemm { const bf16_t* A; const bf16_t* Bt; int M, N, K; };

struct StaticOrder {
    int nM, nN, nwg, G, c;
    __host__ __device__ void init(int M, int N, int G_, int c_) { nM = M / BM; nN = N / BM; nwg = nM * nN; G = G_; c = c_; }
    __host__ __device__ bool next(int i, Unit& u) const {
        const long L = (long)i * G + c; if (L >= nwg) return false;
        int wgid = (int)L; { const int q = nwg / NXCD, r = nwg % NXCD, xcd = wgid % NXCD, off = wgid / NXCD; wgid = (xcd < r ? xcd * (q + 1) : r * (q + 1) + (xcd - r) * q) + off; }
        const int nig = WGM_DENSE * nN, gid = wgid / nig, fm = gid * WGM_DENSE, gsz = (nM - fm) < WGM_DENSE ? (nM - fm) : WGM_DENSE;
        { const int w_ = wgid % nig; if (WGM_DENSE == 2) { u.pm = fm + (gsz == 2 ? (w_ & 1) : 0); u.pn = gsz == 2 ? (w_ >> 1) : w_; } else { u.pm = fm + (w_ % gsz); u.pn = w_ / gsz; } }     u.pb = u.pn; u.pa = u.pm; u.ps = u.pm; u.kt0 = 0; u.nkt = 0; u.ys = -1; return true;
    }
    __device__ __forceinline__ void a_ready(const Unit&) const {}
    __device__ __forceinline__ void done(const Unit&) const {}
};

__device__ __forceinline__ unsigned cvt_pk_bf16(float lo, float hi) { unsigned r; asm volatile("v_cvt_pk_bf16_f32 %0, %1, %2" : "=v"(r) : "v"(lo), "v"(hi)); return r; }
typedef float f32x2 __attribute__((ext_vector_type(2)));
__device__ __forceinline__ f32x2 gelu_pk(f32x2 v) {
    const f32x2 av = __builtin_elementwise_abs(v), d = av * 0.2316418882f + 1.0f;
    f32x2 t; t.x = __builtin_amdgcn_rcpf(d.x); t.y = __builtin_amdgcn_rcpf(d.y);
    f32x2 q = t * 0.5307027145f + (-0.7265760135f); q = q * t + 0.7107068705f; q = q * t + (-0.142248368f); q = q * t + 0.127414796f; q = q * t;
    const f32x2 s = (v * v) * (-0.72134752044f);
    f32x2 e; e.x = __builtin_amdgcn_exp2f(s.x); e.y = __builtin_amdgcn_exp2f(s.y);
    const f32x2 m = v * (q * e), r = v - m;
    f32x2 o; o.x = v.x < 0.f ? m.x : r.x; o.y = v.y < 0.f ? m.y : r.y; return o;
}

template <int ACT  > struct EpiBf16 {
    static constexpr bool PERM = true, AFTER_DRAIN = false; static_assert(ACT == 0 || ACT == 1, "EpiBf16: ACT is 0 (none) or 1 (gelu_pk)");
    bf16_t* O; int ldc; const float* bias; int split_cols; size_t split_stride; float scale0;
    __device__ __forceinline__ void operator()(const f32x4 (&acc)[2][2][4][2], const Unit& u, int wr, int wc, int fr, int fq) const {
        const int row0 = u.pm * BM + wr * 64 + fr; int colt = u.pn * BM; bf16_t* base = O;
        float sc = 1.f; if (split_cols) { const int t = colt / split_cols; base += (size_t)t * split_stride; colt -= t * split_cols; if (t == 0) sc = scale0; }
        const int col0 = colt + wc * 32 + 8 * fq, bcol0 = u.pn * BM + wc * 32 + 8 * fq;
        f32x4 bv[2][2];
#pragma unroll
        for (int bj = 0; bj < 2; ++bj)
#pragma unroll
            for (int n = 0; n < 2; ++n) bv[bj][n] = bias ? *(const f32x4*)(bias + bcol0 + bj * HALF + 4 * n) : (f32x4){0.f, 0.f, 0.f, 0.f};
#pragma unroll
        for (int ai = 0; ai < 2; ++ai)
#pragma unroll
            for (int m = 0; m < 4; ++m) { bf16_t* rowp = base + (size_t)(row0 + ai * HALF + m * 16) * ldc + col0;
#pragma unroll
                for (int bj = 0; bj < 2; ++bj) { f32x4 v0 = acc[ai][bj][m][0], v1 = acc[ai][bj][m][1]; if (bias) { v0 = v0 + bv[bj][0]; v1 = v1 + bv[bj][1]; }
                    if (ACT == 1) { f32x2 a = gelu_pk((f32x2){v0[0], v0[1]}), b = gelu_pk((f32x2){v0[2], v0[3]}), c = gelu_pk((f32x2){v1[0], v1[1]}), d = gelu_pk((f32x2){v1[2], v1[3]});
                        v0 = (f32x4){a.x, a.y, b.x, b.y}; v1 = (f32x4){c.x, c.y, d.x, d.y}; }
                    v0 = v0 * sc; v1 = v1 * sc; u32x4 w; w.x = cvt_pk_bf16(v0[0], v0[1]); w.y = cvt_pk_bf16(v0[2], v0[3]); w.z = cvt_pk_bf16(v1[0], v1[1]); w.w = cvt_pk_bf16(v1[2], v1[3]);
                    *(u32x4*)(rowp + bj * HALF) = w; } }
    }
};
__device__ __forceinline__ float silu_f(float g) { return g * __builtin_amdgcn_rcpf(1.0f + __builtin_amdgcn_exp2f(-1.4426950408889634f * g)); }
__device__ __forceinline__ float xrow16_sum(float x) {
    const auto s = __builtin_amdgcn_permlane16_swap(__float_as_uint(x), __float_as_uint(x), false, false); x = __uint_as_float(s[0]) + __uint_as_float(s[1]);
    const auto t = __builtin_amdgcn_permlane32_swap(__float_as_uint(x), __float_as_uint(x), false, false); return __uint_as_float(t[0]) + __uint_as_float(t[1]); }
struct EpiL0In {
    static constexpr bool PERM = true, AFTER_DRAIN = false;
    bf16_t* O; int ldc; float scale0; float* qkn;
    __device__ __forceinline__ void operator()(const f32x4 (&acc)[2][2][4][2], const Unit& u, int wr, int wc, int fr, int fq) const {
        const int row0 = u.pm * BM + wr * 64 + fr, col0 = u.pn * BM + wc * 32 + 8 * fq; const float sc = u.pn < 2 ? scale0 : 1.f;
        float mx[2][2] = {{0.f, 0.f}, {0.f, 0.f}};
#pragma unroll
        for (int ai = 0; ai < 2; ++ai)
#pragma unroll
            for (int m = 0; m < 4; ++m) { bf16_t* rowp = O + (size_t)(row0 + ai * HALF + m * 16) * ldc + col0;
#pragma unroll
                for (int bj = 0; bj < 2; ++bj) { const f32x4 v0 = acc[ai][bj][m][0] * sc, v1 = acc[ai][bj][m][1] * sc;
                    u32x4 w; w.x = cvt_pk_bf16(v0[0], v0[1]); w.y = cvt_pk_bf16(v0[2], v0[3]); w.z = cvt_pk_bf16(v1[0], v1[1]); w.w = cvt_pk_bf16(v1[2], v1[3]);
                    *(u32x4*)(rowp + bj * HALF) = w;
                    if (u.pn < 4) { float s = 0.f;
#pragma unroll
                        for (int e = 0; e < 4; ++e) { const float lo = __uint_as_float(w[e] << 16), hi = __uint_as_float(w[e] & 0xffff0000u); s += lo * lo + hi * hi; }
                        s = xrow16_sum(s); mx[ai][bj] = fmaxf(mx[ai][bj], s); } } }
        if (u.pn < 4) {
#pragma unroll
            for (int ai = 0; ai < 2; ++ai)
#pragma unroll
                for (int bj = 0; bj < 2; ++bj) { float v = mx[ai][bj]; v = fmaxf(v, __shfl_xor(v, 1)); v = fmaxf(v, __shfl_xor(v, 2)); v = fmaxf(v, __shfl_xor(v, 4)); v = fmaxf(v, __shfl_xor(v, 8));
                    if (fr == 0 && fq == 0) qkn[(((size_t)(u.pn >> 1) * 256 + 4 * u.pm + 2 * ai + wr) * 8 + 4 * (u.pn & 1) + 2 * bj + (wc >> 1)) * 2 + (wc & 1)] = v; } }
    }
};
template <bool BASEF> struct EpiRes {
    static constexpr bool PERM = true, AFTER_DRAIN = false;
    const void* base; bf16_t* out; int ldc; float* rowss;
    __device__ __forceinline__ void operator()(const f32x4 (&acc)[2][2][4][2], const Unit& u, int wr, int wc, int fr, int fq) const {
        const int row0 = u.pm * BM + wr * 64 + fr, col0 = u.pn * BM + wc * 32 + 8 * fq;
#pragma unroll
        for (int ai = 0; ai < 2; ++ai) { float ssm = 0.f;
#pragma unroll
            for (int m = 0; m < 4; ++m) { const size_t off = (size_t)(row0 + ai * HALF + m * 16) * ldc + col0; float ssq = 0.f;
#pragma unroll
                for (int bj = 0; bj < 2; ++bj) { f32x4 b0, b1;
                    if (BASEF) { b0 = *(const f32x4*)((const float*)base + off + bj * HALF); b1 = *(const f32x4*)((const float*)base + off + bj * HALF + 4); }
                    else { const u32x4 x = *(const u32x4*)((const bf16_t*)base + off + bj * HALF);
                        b0 = (f32x4){__uint_as_float(x.x << 16), __uint_as_float(x.x & 0xffff0000u), __uint_as_float(x.y << 16), __uint_as_float(x.y & 0xffff0000u)};
                        b1 = (f32x4){__uint_as_float(x.z << 16), __uint_as_float(x.z & 0xffff0000u), __uint_as_float(x.w << 16), __uint_as_float(x.w & 0xffff0000u)}; }
                    const f32x4 v0 = b0 + acc[ai][bj][m][0], v1 = b1 + acc[ai][bj][m][1];
                    u32x4 w; w.x = cvt_pk_bf16(v0[0], v0[1]); w.y = cvt_pk_bf16(v0[2], v0[3]); w.z = cvt_pk_bf16(v1[0], v1[1]); w.w = cvt_pk_bf16(v1[2], v1[3]);
                    *(u32x4*)(out + off + bj * HALF) = w;
                    if (rowss) {
#pragma unroll
                        for (int e = 0; e < 4; ++e) { const float lo = __uint_as_float(w[e] << 16), hi = __uint_as_float(w[e] & 0xffff0000u); ssq += lo * lo + hi * hi; } } }
                if (rowss) { ssq = xrow16_sum(ssq); if (fq == m) ssm = ssq; } }
            if (rowss) rowss[(size_t)(row0 + ai * HALF + fq * 16) * 16 + 4 * u.pn + wc] = ssm; }
    }
};
struct EpiSwiGLU {
    static constexpr bool PERM = true, AFTER_DRAIN = false;
    bf16_t* O; int ldo; const float* rowss;
    __device__ __forceinline__ void operator()(const f32x4 (&acc)[2][2][4][2], const Unit& u, int wr, int wc, int fr, int fq) const {
        const int row0 = u.pm * BM + wr * 64 + fr, col0 = u.pn * HALF + wc * 32 + 8 * fq;
        float rsv[2][4];
#pragma unroll
        for (int ai = 0; ai < 2; ++ai)
#pragma unroll
            for (int m = 0; m < 4; ++m) { float rs = 1.f; if (rowss) { const f32x4 a = *(const f32x4*)(rowss + (size_t)(row0 + ai * HALF + m * 16) * 16 + 4 * fq);
                    rs = rsqrtf(xrow16_sum((a[0] + a[1]) + (a[2] + a[3])) * (1.f / 1024.f) + 1e-6f); }
                rsv[ai][m] = rs; }
#pragma unroll
        for (int ai = 0; ai < 2; ++ai)
#pragma unroll
            for (int m = 0; m < 4; ++m) { bf16_t* rowp = O + (size_t)(row0 + ai * HALF + m * 16) * ldo + col0; const float rs = rsv[ai][m];
                const f32x4 g0 = acc[ai][0][m][0] * rs, g1 = acc[ai][0][m][1] * rs, u0 = acc[ai][1][m][0] * rs, u1 = acc[ai][1][m][1] * rs;
                u32x4 w; w.x = cvt_pk_bf16(silu_f(g0[0]) * u0[0], silu_f(g0[1]) * u0[1]); w.y = cvt_pk_bf16(silu_f(g0[2]) * u0[2], silu_f(g0[3]) * u0[3]);
                w.z = cvt_pk_bf16(silu_f(g1[0]) * u1[0], silu_f(g1[1]) * u1[1]); w.w = cvt_pk_bf16(silu_f(g1[2]) * u1[2], silu_f(g1[3]) * u1[3]);
                *(u32x4*)rowp = w; }
    }
};
__device__ __forceinline__ unsigned pk4_fp8(float a, float b, float c, float d) {
    a = __builtin_amdgcn_fmed3f(a, -448.f, 448.f); b = __builtin_amdgcn_fmed3f(b, -448.f, 448.f); c = __builtin_amdgcn_fmed3f(c, -448.f, 448.f); d = __builtin_amdgcn_fmed3f(d, -448.f, 448.f);
    unsigned w = 0u; w = __builtin_amdgcn_cvt_pk_fp8_f32(a, b, w, false); w = __builtin_amdgcn_cvt_pk_fp8_f32(c, d, w, true); return w;
}
struct EpiSwiGLU8 {
    static constexpr bool PERM = true, AFTER_DRAIN = false;
    unsigned char* O; int ldo; float si, so;
    __device__ __forceinline__ void operator()(const f32x4 (&acc)[2][2][4][2], const Unit& u, int wr, int wc, int fr, int fq) const {
        const int od = fq & 1; const int row0 = u.pm * BM + wr * 64 + fr + od * 16, col0 = u.pn * HALF + wc * 32 + 8 * (fq - od); const float s2 = si * so;
#pragma unroll
        for (int ai = 0; ai < 2; ++ai)
#pragma unroll
            for (int j = 0; j < 2; ++j) { unsigned wx[2], wy[2];
#pragma unroll
                for (int h = 0; h < 2; ++h) { const int m = 2 * j + h;
                    const f32x4 g0 = acc[ai][0][m][0] * si, g1 = acc[ai][0][m][1] * si, u0 = acc[ai][1][m][0] * s2, u1 = acc[ai][1][m][1] * s2;
                    wx[h] = pk4_fp8(silu_f(g0[0]) * u0[0], silu_f(g0[1]) * u0[1], silu_f(g0[2]) * u0[2], silu_f(g0[3]) * u0[3]);
                    wy[h] = pk4_fp8(silu_f(g1[0]) * u1[0], silu_f(g1[1]) * u1[1], silu_f(g1[2]) * u1[2], silu_f(g1[3]) * u1[3]); }
                const auto sx = __builtin_amdgcn_permlane16_swap(wx[0], wx[1], false, false), sy = __builtin_amdgcn_permlane16_swap(wy[0], wy[1], false, false);
                u32x4 w; w.x = sx[0]; w.y = sy[0]; w.z = sx[1]; w.w = sy[1];
                { const unsigned off_ = (unsigned)((row0 + ai * HALF + j * 32) * ldo + col0); asm volatile("global_store_dwordx4 %0, %1, %2 sc1\n\ts_nop 1" :: "v"(off_), "v"(w), "s"(O) : "memory"); } }
    }
};
struct EpiRowScale {
    static constexpr bool PERM = true, AFTER_DRAIN = false;
    bf16_t* Y; int ldc; const float* rs; float mul; bf16_t* YS;
    __device__ __forceinline__ void operator()(const f32x4 (&acc)[2][2][4][2], const Unit& u, int wr, int wc, int fr, int fq) const {
        const int row0 = u.pm * BM + wr * 64 + fr, col0 = u.pn * BM + wc * 32 + 8 * fq;
        bf16_t* const yb = u.ys < 0 ? Y : YS + ((long)u.ys * 2048 - 128 * BM) * (long)ldc;
        float sv[2][4];
#pragma unroll
        for (int ai = 0; ai < 2; ++ai)
#pragma unroll
            for (int m = 0; m < 4; ++m) sv[ai][m] = rs[row0 + ai * HALF + m * 16 + (u.ps - u.pm) * BM] * mul;
#pragma unroll
        for (int ai = 0; ai < 2; ++ai)
#pragma unroll
            for (int m = 0; m < 4; ++m) { const int row = row0 + ai * HALF + m * 16; const float s = sv[ai][m];
                bf16_t* rowp = yb + (size_t)row * ldc + col0;
#pragma unroll
                for (int bj = 0; bj < 2; ++bj) { const f32x4 v0 = acc[ai][bj][m][0] * s, v1 = acc[ai][bj][m][1] * s;
                    u32x4 w; w.x = cvt_pk_bf16(v0[0], v0[1]); w.y = cvt_pk_bf16(v0[2], v0[3]); w.z = cvt_pk_bf16(v1[0], v1[1]); w.w = cvt_pk_bf16(v1[2], v1[3]);
                    *(u32x4*)(rowp + bj * HALF) = w; } }
    }
};
struct MoeOrder {
    int nM, nN, nwg, G, c; int ct[9]; bool sparseA; mutable int prev = -1; unsigned* ready;
    __device__ __forceinline__ void init(const unsigned* cnt, int nN_, int G_, int c_, bool sparseA_, unsigned* ready_ = nullptr) { int acc = 0; ready = ready_;
#pragma unroll
        for (int e = 0; e < 8; ++e) { ct[e] = acc; acc += (int)((__builtin_amdgcn_readfirstlane((int)cnt[32 * e]) + 255) >> 8); }
        ct[8] = acc; nM = acc; nN = nN_; nwg = nM * nN; G = G_; c = c_; sparseA = sparseA_; }
    __device__ bool next(int i, Unit& u) const {
        const long L = (long)i * G + c; if (L >= nwg) return false;
        int wgid = (int)L; { const int q = nwg / NXCD, r = nwg % NXCD, xcd = wgid % NXCD, off = wgid / NXCD; wgid = (xcd < r ? xcd * (q + 1) : r * (q + 1) + (xcd - r) * q) + off; }
        const int nig = WGM_MOE * nN, gid = wgid / nig, fm = gid * WGM_MOE, gsz = (nM - fm) < WGM_MOE ? (nM - fm) : WGM_MOE;
        const int w_ = wgid % nig; int pm, pn; if (WGM_MOE == 2) { pm = fm + (gsz == 2 ? (w_ & 1) : 0); pn = gsz == 2 ? (w_ >> 1) : w_; } else { pm = fm + (w_ % gsz); pn = w_ / gsz; }
        pm = __builtin_amdgcn_readfirstlane(pm); pn = __builtin_amdgcn_readfirstlane(pn);
        int e = 0, cte = 0;
#pragma unroll
        for (int k = 1; k < 8; ++k) if (pm >= ct[k]) { e = k; cte = ct[k]; }
        u.pm = pm; u.pn = pn; u.pb = e * nN + pn; u.ps = 64 * e + (pm - cte); u.pa = sparseA ? u.ps : pm; u.kt0 = 0; u.nkt = 0; u.ys = -1; return true;
    }
    __device__ __forceinline__ void a_ready(const Unit&, bool) const {}
    __device__ __forceinline__ void publish(int pm) const { unsigned* const a = ready + 32 * pm; unsigned long long sv; unsigned t0, t1;
        asm volatile("s_mov_b64 %0, exec\n\ts_mov_b64 exec, 1\n\tv_mov_b32 %1, 0\n\tv_mov_b32 %2, 1\n\tglobal_atomic_add %1, %2, %3 sc1\n\ts_mov_b64 exec, %0" : "=&s"(sv), "=&v"(t0), "=&v"(t1) : "s"(a) : "memory"); }
    __device__ __forceinline__ void done(const Unit& u) const { if (ready) { if (prev >= 0) publish(prev); prev = u.pm; } }
    __device__ __forceinline__ void flush() const { if (ready && prev >= 0) { publish(prev); prev = -1; } }
};
struct MoeDownOrder {
    int nM, nF, G, c, r12, E, Sl, F, myfull; int ct[9]; const unsigned* ready;
    __device__ __forceinline__ void init(const unsigned* cnt, int G_, int c_, const unsigned* ready_) { int acc = 0;
#pragma unroll
        for (int e = 0; e < 8; ++e) { ct[e] = acc; acc += (int)((__builtin_amdgcn_readfirstlane((int)cnt[32 * e]) + 255) >> 8); }
        ct[8] = acc; nM = acc; nF = nM < 128 ? nM : 128; G = G_; c = c_; ready = ready_;
        int cv = c_, Gv = G_, nv = nM * 28, Fv = nF * 4; asm volatile("" : "+v"(cv), "+v"(Gv), "+v"(nv), "+v"(Fv));
        r12 = ready_ ? __builtin_amdgcn_readfirstlane(nv % Gv) : 0; E = G - r12; Sl = (nM - nF) * 28; F = nF * 4; myfull = __builtin_amdgcn_readfirstlane(cv < Fv ? (Fv - cv + Gv - 1) / Gv : 0); }
    __device__ __forceinline__ bool next(int i, Unit& u) const {
        int pm, pn, kt0 = 0, nkt = 0, ys = -1;
        if (i < myfull) { const int L = i * G + c; const int nwg = F; int wgid = L; { const int q = nwg / NXCD, r = nwg % NXCD, xcd = wgid % NXCD, off = wgid / NXCD; wgid = (xcd < r ? xcd * (q + 1) : r * (q + 1) + (xcd - r) * q) + off; }
            const int nig = WGM_MOE * 4, gid = wgid / nig, fm = gid * WGM_MOE, gsz = (nF - fm) < WGM_MOE ? (nF - fm) : WGM_MOE;
            { const int w_ = wgid % nig; if (WGM_MOE == 2) { pm = fm + (gsz == 2 ? (w_ & 1) : 0); pn = gsz == 2 ? (w_ >> 1) : w_; } else { pm = fm + (w_ % gsz); pn = w_ / gsz; } } }
        else { const int j = i - myfull; int s;
            if (c >= r12) s = j == 0 ? c - r12 : E + (j - 1) * G + c; else s = E + j * G + c;
            if (s >= Sl) return false; const int rem = s % 28; pm = nF + s / 28; pn = rem / 7; ys = rem % 7; kt0 = 4 * ys; nkt = 4; }
        pm = __builtin_amdgcn_readfirstlane(pm); pn = __builtin_amdgcn_readfirstlane(pn);
        int e = 0, cte = 0;
#pragma unroll
        for (int k = 1; k < 8; ++k) if (pm >= ct[k]) { e = k; cte = ct[k]; }
        Unit r; r.pm = pm; r.pn = pn; r.pb = e * 4 + pn; r.ps = 64 * e + (pm - cte); r.pa = pm;
        r.kt0 = __builtin_amdgcn_readfirstlane(kt0); r.nkt = __builtin_amdgcn_readfirstlane(nkt); r.ys = __builtin_amdgcn_readfirstlane(ys); u = r; return true;
    }
    __device__ __forceinline__ void a_ready(const Unit& u, bool w0) const {
        if (ready) {
            if (w0) { unsigned sp = 0u;
                while ((unsigned)__builtin_amdgcn_readfirstlane((int)__hip_atomic_load(ready + 32 * u.pm, __ATOMIC_RELAXED, __HIP_MEMORY_SCOPE_AGENT)) < 224u) { __builtin_amdgcn_s_sleep(2); if (++sp > (1u << 21)) break; }
            }
            asm volatile("" ::: "memory"); __builtin_amdgcn_s_barrier(); asm volatile("" ::: "memory");
        }
    }
    __device__ __forceinline__ void flush() const {}
    __device__ __forceinline__ void done(const Unit&) const {}
};
template <class Epi, class Sched, bool ALIGN_EPI = false, bool SP2 = false>
__device__ __forceinline__ void gemm_phase(PG8_LAS unsigned char* lds, const Gemm g, const Sched& S, const Epi& E) {
    int tid = threadIdx.x; asm volatile("" : "+v"(tid));
    const int wid = __builtin_amdgcn_readfirstlane(tid >> 6), lane = tid & 63, wr = wid >> 2, wc = wid & 3, fr = lane & 15, fq = lane >> 4;
    const int K = g.K, nt = K / BK;
    unsigned voffA[2], voffB[2];
#pragma unroll
    for (int i = 0; i < 2; ++i) { int R, C; stage_rc(tid * 16 + i * 8192, R, C); const int Rb = Epi::PERM ? ((R & ~31) + perm32(R & 31)) : R;
        voffA[i] = (unsigned)(R * K + C) * 2u; voffB[i] = (unsigned)(Rb * K + C) * 2u; }
    const size_t kstep = (size_t)(BK * 2);
    const size_t hstep = (size_t)HALF * K * 2;
    const size_t tstep = 2 * hstep;
    const unsigned ldsw = (unsigned)wid * 1024u; const unsigned ldsbase = (unsigned)__builtin_amdgcn_readfirstlane((int)((unsigned)(uintptr_t)lds + ldsw));
    const int aoff = lds_byte(wr * 64 + fr, fq * 8), boff = lds_byte(wc * 32 + fr, fq * 8);
#define PG8_SA(b, h) (((b) * 2 + (h)) * HTB)
#define PG8_SB(b, h) ((4 + (b) * 2 + (h)) * HTB)
#define PG8_STAGE(bufoff, gbase, voff) do { _Pragma("unroll") for (int _i = 0; _i < 2; ++_i) { unsigned keep_; \
        asm volatile("s_mov_b32 %0, m0\n\ts_mov_b32 m0, %3\n\ts_nop 0\n\tglobal_load_lds_dwordx4 %1, %2\n\ts_mov_b32 m0, %0" : "=&s"(keep_) : "v"((voff)[_i]), "s"((const char*)(gbase)), "s"(ldsbase + (unsigned)((bufoff) + _i * 8192)) : "memory"); } } while (0)
#define PG8_LDA(dst, b, h) do { _Pragma("unroll") for (int m = 0; m < 4; ++m) _Pragma("unroll") for (int k = 0; k < 2; ++k) dst[m][k] = *(const PG8_LAS bf16x8*)(lds + PG8_SA(b, h) + aoff + m * 2048 + k * 1024); } while (0)
#define PG8_LDB(dst, b, h) do { _Pragma("unroll") for (int n = 0; n < 2; ++n) _Pragma("unroll") for (int k = 0; k < 2; ++k) dst[n][k] = *(const PG8_LAS bf16x8*)(lds + PG8_SB(b, h) + boff + n * 2048 + k * 1024); } while (0)
#define PG8_MMA(ai, bj, At, Bt) do { __builtin_amdgcn_s_setprio(1); _Pragma("unroll") for (int m = 0; m < 4; ++m) _Pragma("unroll") for (int n = 0; n < 2; ++n) _Pragma("unroll") for (int k = 0; k < 2; ++k) \
        acc[ai][bj][m][n] = __builtin_amdgcn_mfma_f32_16x16x32_bf16(Bt[n][k], At[m][k], acc[ai][bj][m][n], 0, 0, 0); __builtin_amdgcn_s_setprio(0); } while (0)
#define PG8_MMAZ(ai, bj, At, Bt) do { __builtin_amdgcn_s_setprio(1); _Pragma("unroll") for (int m = 0; m < 4; ++m) _Pragma("unroll") for (int n = 0; n < 2; ++n) { const f32x4 z_ = {0.f, 0.f, 0.f, 0.f}; \
        const f32x4 c_ = __builtin_amdgcn_mfma_f32_16x16x32_bf16(Bt[n][0], At[m][0], z_, 0, 0, 0); acc[ai][bj][m][n] = __builtin_amdgcn_mfma_f32_16x16x32_bf16(Bt[n][1], At[m][1], c_, 0, 0, 0); } __builtin_amdgcn_s_setprio(0); } while (0)
#define PG8_WAIT_V(n) asm volatile("s_waitcnt vmcnt(" #n ")" ::: "memory")
#define PG8_WAIT_L(n) asm volatile("s_waitcnt lgkmcnt(" #n ")" ::: "memory")
#define PG8_BAR __builtin_amdgcn_s_barrier()
#define PG8_SCHED __builtin_amdgcn_sched_barrier(0)
    Unit cur, nxt; int ui = 0;
    if (!S.next(0, cur)) return;
    f32x4 acc[2][2][4][2];
    bf16x8 At[4][2], B0[2][2], B1[2][2];
    const char* cA = (const char*)g.A + (size_t)cur.pa * tstep; const char* cB = (const char*)g.Bt + (size_t)cur.pb * tstep;
    S.a_ready(cur);
    if constexpr (SP2) {
        PG8_STAGE(PG8_SB(0, 0), cB, voffB); PG8_STAGE(PG8_SB(0, 1), cB + hstep, voffB); PG8_STAGE(PG8_SA(0, 0), cA, voffA); PG8_STAGE(PG8_SA(0, 1), cA + hstep, voffA);
        if (wr == 1) PG8_BAR;
        PG8_WAIT_V(2); PG8_BAR;
        PG8_STAGE(PG8_SB(1, 0), cB + kstep, voffB); PG8_STAGE(PG8_SA(1, 0), cA + kstep, voffA); PG8_STAGE(PG8_SB(1, 1), cB + hstep + kstep, voffB);
        PG8_WAIT_V(6); PG8_BAR;
    } else {
        PG8_STAGE(PG8_SB(0, 0), cB, voffB); PG8_STAGE(PG8_SA(0, 0), cA, voffA); PG8_STAGE(PG8_SB(0, 1), cB + hstep, voffB); PG8_STAGE(PG8_SA(0, 1), cA + hstep, voffA);
        if (wr == 1) PG8_BAR;
        PG8_WAIT_V(4); PG8_BAR;
        PG8_STAGE(PG8_SB(1, 0), cB + kstep, voffB); PG8_STAGE(PG8_SA(1, 0), cA + kstep, voffA); PG8_STAGE(PG8_SB(1, 1), cB + hstep + kstep, voffB);
        PG8_WAIT_V(6); PG8_BAR;
    }
    for (;;) {
        const bool has_next = S.next(ui + 1, nxt);
        const char* nA = has_next ? (const char*)g.A + (size_t)nxt.pa * tstep : cA; const char* nB = has_next ? (const char*)g.Bt + (size_t)nxt.pb * tstep : cB;
        auto trip = [&](const int t, auto zf_) __attribute__((always_inline)) {
            constexpr bool ZC = decltype(zf_)::value;
            const bool last = (t == nt - 2);
            const char* a1 = cA + (size_t)(t + 1) * kstep;
            const char* a2 = last ? nA : cA + (size_t)(t + 2) * kstep; const char* b2 = last ? nB : cB + (size_t)(t + 2) * kstep;
            const char* a3 = a2 + kstep; const char* b3 = b2 + kstep;
            if (last && has_next) S.a_ready(nxt);
            if constexpr (SP2) {
            PG8_LDB(B0, 0, 0); PG8_LDB(B1, 0, 1); PG8_SCHED; PG8_LDA(At, 0, 0); PG8_STAGE(PG8_SA(1, 1), a1 + hstep, voffA);
            PG8_WAIT_V(8); PG8_WAIT_L(0); PG8_BAR; if constexpr (ZC) { PG8_MMAZ(0, 0, At, B0); PG8_MMAZ(0, 1, At, B1); } else { PG8_MMA(0, 0, At, B0); PG8_MMA(0, 1, At, B1); } PG8_BAR; PG8_SCHED;
            PG8_LDA(At, 0, 1); PG8_STAGE(PG8_SB(0, 0), b2, voffB); PG8_STAGE(PG8_SB(0, 1), b2 + hstep, voffB); PG8_STAGE(PG8_SA(0, 0), a2, voffA);
            PG8_WAIT_V(8); PG8_WAIT_L(0); PG8_BAR; if constexpr (ZC) { PG8_MMAZ(1, 0, At, B0); PG8_MMAZ(1, 1, At, B1); } else { PG8_MMA(1, 0, At, B0); PG8_MMA(1, 1, At, B1); } PG8_BAR; PG8_SCHED;
            PG8_LDB(B0, 1, 0); PG8_LDB(B1, 1, 1); PG8_SCHED; PG8_LDA(At, 1, 0); PG8_STAGE(PG8_SA(0, 1), a2 + hstep, voffA);
            PG8_WAIT_V(8); PG8_WAIT_L(0); PG8_BAR; PG8_MMA(0, 0, At, B0); PG8_MMA(0, 1, At, B1); PG8_BAR; PG8_SCHED;
            PG8_LDA(At, 1, 1); PG8_STAGE(PG8_SB(1, 0), b3, voffB); PG8_STAGE(PG8_SB(1, 1), b3 + hstep, voffB); PG8_STAGE(PG8_SA(1, 0), a3, voffA);
            PG8_WAIT_V(8); PG8_WAIT_L(0); PG8_BAR; PG8_MMA(1, 0, At, B0); PG8_MMA(1, 1, At, B1); PG8_BAR; PG8_SCHED;
            } else {
            if constexpr (ZC) { _Pragma("unroll") for (int a = 0; a < 2; ++a) _Pragma("unroll") for (int b = 0; b < 2; ++b) _Pragma("unroll") for (int m = 0; m < 4; ++m) _Pragma("unroll") for (int n = 0; n < 2; ++n) acc[a][b][m][n] = (f32x4){0.f, 0.f, 0.f, 0.f}; }
            PG8_LDB(B0, 0, 0); PG8_SCHED; PG8_LDA(At, 0, 0); PG8_STAGE(PG8_SA(1, 1), a1 + hstep, voffA);
            PG8_WAIT_L(8); PG8_BAR; PG8_WAIT_L(0); PG8_MMA(0, 0, At, B0); PG8_BAR; PG8_SCHED;
            PG8_LDB(B1, 0, 1); PG8_STAGE(PG8_SB(0, 0), b2, voffB);
            PG8_BAR; PG8_WAIT_L(0); PG8_MMA(0, 1, At, B1); PG8_BAR;
            PG8_LDA(At, 0, 1); PG8_STAGE(PG8_SA(0, 0), a2, voffA);
            PG8_BAR; PG8_WAIT_L(0); PG8_MMA(1, 0, At, B0); PG8_BAR; PG8_SCHED;
            PG8_STAGE(PG8_SB(0, 1), b2 + hstep, voffB);
            PG8_WAIT_V(6); PG8_BAR; PG8_MMA(1, 1, At, B1); PG8_BAR;
            PG8_LDB(B0, 1, 0); PG8_SCHED; PG8_LDA(At, 1, 0); PG8_STAGE(PG8_SA(0, 1), a2 + hstep, voffA);
            PG8_WAIT_L(8); PG8_BAR; PG8_WAIT_L(0); PG8_MMA(0, 0, At, B0); PG8_BAR; PG8_SCHED;
            PG8_LDB(B1, 1, 1); PG8_STAGE(PG8_SB(1, 0), b3, voffB);
            PG8_BAR; PG8_WAIT_L(0); PG8_MMA(0, 1, At, B1); PG8_BAR;
            PG8_LDA(At, 1, 1); PG8_STAGE(PG8_SA(1, 0), a3, voffA);
            PG8_BAR; PG8_WAIT_L(0); PG8_MMA(1, 0, At, B0); PG8_BAR; PG8_SCHED;
            PG8_STAGE(PG8_SB(1, 1), b3 + hstep, voffB);
            PG8_WAIT_V(6); PG8_BAR; PG8_MMA(1, 1, At, B1); PG8_BAR;
            }
        };
        trip(0, std::true_type{});
        for (int t = 2; t < nt; t += 2) trip(t, std::false_type{});
        if constexpr (ALIGN_EPI) { if (wr == 0) PG8_BAR; }
        if constexpr (!Epi::AFTER_DRAIN) { E(acc, cur, wr, wc, fr, fq); S.done(cur); }
        if (!has_next) break;
        cur = nxt; cA = nA; cB = nB; ++ui;
        if constexpr (ALIGN_EPI) { if (wr == 1) PG8_BAR; }
    }
    PG8_WAIT_V(0);
    if constexpr (!ALIGN_EPI) { if (wr == 0) PG8_BAR; }
    PG8_BAR;
    if constexpr (Epi::AFTER_DRAIN) { E.fused(acc, cur, wr, wc, fr, fq, lds, wid, lane); S.done(cur); }
#undef PG8_SA
#undef PG8_SB
#undef PG8_STAGE
#undef PG8_LDA
#undef PG8_LDB
#undef PG8_MMA
#undef PG8_MMAZ
#undef PG8_WAIT_V
#undef PG8_WAIT_L
#undef PG8_BAR
#undef PG8_SCHED
}
typedef int i32x4 __attribute__((ext_vector_type(4)));
typedef int i32x8 __attribute__((ext_vector_type(8)));
struct Gemm8 { const unsigned char* A; const unsigned char* Bt; int M, N, K; };
template <class Epi, class Sched, bool ALIGN_EPI = false, bool SP2 = false>
__device__ __forceinline__ void gemm_phase_f8(PG8_LAS unsigned char* lds, const Gemm8 g, const Sched& S, const Epi& E) {
    int tid = threadIdx.x; asm volatile("" : "+v"(tid));
    const int wid = __builtin_amdgcn_readfirstlane(tid >> 6), lane = tid & 63, wr = wid >> 2, wc = wid & 3, fr = lane & 15, fq = lane >> 4;
    const int K = g.K, nt = K / 128;
    unsigned voffA[2], voffB[2];
#pragma unroll
    for (int i = 0; i < 2; ++i) { int R, C; stage_rc(tid * 16 + i * 8192, R, C); const int Rb = Epi::PERM ? ((R & ~31) + perm32(R & 31)) : R;
        voffA[i] = (unsigned)(R * K + 2 * C); voffB[i] = (unsigned)(Rb * K + 2 * C); }
    const size_t kstep = (size_t)(BK * 2);
    const size_t hstep = (size_t)HALF * K;
    const size_t tstep = 2 * hstep;
    const unsigned ldsw = (unsigned)wid * 1024u; const unsigned ldsbase = (unsigned)__builtin_amdgcn_readfirstlane((int)((unsigned)(uintptr_t)lds + ldsw));
    const int aoff0 = lds_byte(wr * 64 + fr, fq * 8), boff0 = lds_byte(wc * 32 + fr, fq * 8);
#define PG8_SA(b, h) (((b) * 2 + (h)) * HTB)
#define PG8_SB(b, h) ((4 + (b) * 2 + (h)) * HTB)
#define PG8_STAGE(bufoff, gbase, voff) do { _Pragma("unroll") for (int _i = 0; _i < 2; ++_i) { unsigned keep_; \
        asm volatile("s_mov_b32 %0, m0\n\ts_mov_b32 m0, %3\n\ts_nop 0\n\tglobal_load_lds_dwordx4 %1, %2\n\ts_mov_b32 m0, %0" : "=&s"(keep_) : "v"((voff)[_i]), "s"((const char*)(gbase)), "s"(ldsbase + (unsigned)((bufoff) + _i * 8192)) : "memory"); } } while (0)
#define PG8_LD8(dst, off) do { const i32x4 lo_ = *(const PG8_LAS i32x4*)(lds + (off)), hi_ = *(const PG8_LAS i32x4*)(lds + (off) + 1024); dst = __builtin_shufflevector(lo_, hi_, 0, 1, 2, 3, 4, 5, 6, 7); } while (0)
#define PG8_LDA(dst, b, h) do { _Pragma("unroll") for (int m = 0; m < 4; ++m) PG8_LD8(dst[m], PG8_SA(b, h) + aoff + m * 2048); } while (0)
#define PG8_LDB(dst, b, h) do { _Pragma("unroll") for (int n = 0; n < 2; ++n) PG8_LD8(dst[n], PG8_SB(b, h) + boff + n * 2048); } while (0)
#define PG8_MMA(ai, bj, At, Bt) do { __builtin_amdgcn_s_setprio(1); _Pragma("unroll") for (int m = 0; m < 4; ++m) { \
        f32x4 c0_ = __builtin_shufflevector(acc8[ai][bj][m], acc8[ai][bj][m], 0, 1, 2, 3), c1_ = __builtin_shufflevector(acc8[ai][bj][m], acc8[ai][bj][m], 4, 5, 6, 7); \
        c0_ = __builtin_amdgcn_mfma_scale_f32_16x16x128_f8f6f4(Bt[0], At[m], c0_, 0, 0, 0, 0x7F7F7F7F, 0, 0x7F7F7F7F); c1_ = __builtin_amdgcn_mfma_scale_f32_16x16x128_f8f6f4(Bt[1], At[m], c1_, 0, 0, 0, 0x7F7F7F7F, 0, 0x7F7F7F7F); \
        acc8[ai][bj][m] = __builtin_shufflevector(c0_, c1_, 0, 1, 2, 3, 4, 5, 6, 7); } __builtin_amdgcn_s_setprio(0); } while (0)
#define PG8_MMAZ(ai, bj, At, Bt) do { __builtin_amdgcn_s_setprio(1); _Pragma("unroll") for (int m = 0; m < 4; ++m) { const f32x4 z_ = {0.f, 0.f, 0.f, 0.f}; \
        const f32x4 c0_ = __builtin_amdgcn_mfma_scale_f32_16x16x128_f8f6f4(Bt[0], At[m], z_, 0, 0, 0, 0x7F7F7F7F, 0, 0x7F7F7F7F), c1_ = __builtin_amdgcn_mfma_scale_f32_16x16x128_f8f6f4(Bt[1], At[m], z_, 0, 0, 0, 0x7F7F7F7F, 0, 0x7F7F7F7F); \
        acc8[ai][bj][m] = __builtin_shufflevector(c0_, c1_, 0, 1, 2, 3, 4, 5, 6, 7); } __builtin_amdgcn_s_setprio(0); } while (0)
#define PG8_WAIT_V(n) asm volatile("s_waitcnt vmcnt(" #n ")" ::: "memory")
#define PG8_WAIT_L(n) asm volatile("s_waitcnt lgkmcnt(" #n ")" ::: "memory")
#define PG8_BAR __builtin_amdgcn_s_barrier()
#define PG8_SCHED __builtin_amdgcn_sched_barrier(0)
    Unit cur, nxt; int ui = 0;
    if (!S.next(0, cur)) return;
    typedef float f32x8 __attribute__((ext_vector_type(8)));
    f32x8 acc8[2][2][4];
    i32x8 At[4], B0[2], B1[2];
    const char* cA = (const char*)g.A + (size_t)cur.pa * tstep + (size_t)__builtin_amdgcn_readfirstlane(cur.kt0) * kstep; const char* cB = (const char*)g.Bt + (size_t)cur.pb * tstep + (size_t)__builtin_amdgcn_readfirstlane(cur.kt0) * kstep;
    S.a_ready(cur, wid == 0);
    if constexpr (SP2) {
        PG8_STAGE(PG8_SB(0, 0), cB, voffB); PG8_STAGE(PG8_SB(0, 1), cB + hstep, voffB); PG8_STAGE(PG8_SA(0, 0), cA, voffA); PG8_STAGE(PG8_SA(0, 1), cA + hstep, voffA);
        if (wr == 1) PG8_BAR;
        PG8_WAIT_V(2); PG8_BAR;
        PG8_STAGE(PG8_SB(1, 0), cB + kstep, voffB); PG8_STAGE(PG8_SA(1, 0), cA + kstep, voffA); PG8_STAGE(PG8_SB(1, 1), cB + hstep + kstep, voffB);
        PG8_WAIT_V(6); PG8_BAR;
    } else {
        PG8_STAGE(PG8_SB(0, 0), cB, voffB); PG8_STAGE(PG8_SA(0, 0), cA, voffA); PG8_STAGE(PG8_SB(0, 1), cB + hstep, voffB); PG8_STAGE(PG8_SA(0, 1), cA + hstep, voffA);
        if (wr == 1) PG8_BAR;
        PG8_WAIT_V(4); PG8_BAR;
        PG8_STAGE(PG8_SB(1, 0), cB + kstep, voffB); PG8_STAGE(PG8_SA(1, 0), cA + kstep, voffA); PG8_STAGE(PG8_SB(1, 1), cB + hstep + kstep, voffB);
        PG8_WAIT_V(6); PG8_BAR;
    }
    for (;;) {
        const bool has_next = S.next(ui + 1, nxt);
        const char* nA = has_next ? (const char*)g.A + (size_t)nxt.pa * tstep + (size_t)__builtin_amdgcn_readfirstlane(nxt.kt0) * kstep : cA; const char* nB = has_next ? (const char*)g.Bt + (size_t)nxt.pb * tstep + (size_t)__builtin_amdgcn_readfirstlane(nxt.kt0) * kstep : cB;
        const int ntc = __builtin_amdgcn_readfirstlane(cur.nkt ? cur.nkt : nt);
        auto trip = [&](const int t, auto zf_) __attribute__((always_inline)) {
            constexpr bool ZC = decltype(zf_)::value;
            int aoff = aoff0, boff = boff0; asm volatile("" : "+v"(aoff), "+v"(boff));
            const bool last = (t == ntc - 2);
            const char* a1 = cA + (size_t)(t + 1) * kstep;
            const char* a2 = last ? nA : cA + (size_t)(t + 2) * kstep; const char* b2 = last ? nB : cB + (size_t)(t + 2) * kstep;
            const char* a3 = a2 + kstep; const char* b3 = b2 + kstep;
            if (last && has_next) S.a_ready(nxt, wid == 0);
            if constexpr (SP2) {
            PG8_LDB(B0, 0, 0); PG8_LDB(B1, 0, 1); PG8_SCHED; PG8_LDA(At, 0, 0); PG8_STAGE(PG8_SA(1, 1), a1 + hstep, voffA);
            PG8_WAIT_V(8); PG8_WAIT_L(0); PG8_BAR; if constexpr (ZC) { PG8_MMAZ(0, 0, At, B0); PG8_MMAZ(0, 1, At, B1); } else { PG8_MMA(0, 0, At, B0); PG8_MMA(0, 1, At, B1); } PG8_BAR; PG8_SCHED;
            PG8_LDA(At, 0, 1); PG8_STAGE(PG8_SB(0, 0), b2, voffB); PG8_STAGE(PG8_SB(0, 1), b2 + hstep, voffB); PG8_STAGE(PG8_SA(0, 0), a2, voffA);
            PG8_WAIT_V(8); PG8_WAIT_L(0); PG8_BAR; if constexpr (ZC) { PG8_MMAZ(1, 0, At, B0); PG8_MMAZ(1, 1, At, B1); } else { PG8_MMA(1, 0, At, B0); PG8_MMA(1, 1, At, B1); } PG8_BAR; PG8_SCHED;
            PG8_LDB(B0, 1, 0); PG8_LDB(B1, 1, 1); PG8_SCHED; PG8_LDA(At, 1, 0); PG8_STAGE(PG8_SA(0, 1), a2 + hstep, voffA);
            PG8_WAIT_V(8); PG8_WAIT_L(0); PG8_BAR; PG8_MMA(0, 0, At, B0); PG8_MMA(0, 1, At, B1); PG8_BAR; PG8_SCHED;
            PG8_LDA(At, 1, 1); PG8_STAGE(PG8_SB(1, 0), b3, voffB); PG8_STAGE(PG8_SB(1, 1), b3 + hstep, voffB); PG8_STAGE(PG8_SA(1, 0), a3, voffA);
            PG8_WAIT_V(8); PG8_WAIT_L(0); PG8_BAR; PG8_MMA(1, 0, At, B0); PG8_MMA(1, 1, At, B1); PG8_BAR; PG8_SCHED;
            } else {
            PG8_LDB(B0, 0, 0); PG8_SCHED; PG8_LDA(At, 0, 0); PG8_STAGE(PG8_SA(1, 1), a1 + hstep, voffA);
            PG8_WAIT_L(8); PG8_BAR; PG8_WAIT_L(0); PG8_MMA(0, 0, At, B0); PG8_BAR; PG8_SCHED;
            PG8_LDB(B1, 0, 1); PG8_STAGE(PG8_SB(0, 0), b2, voffB);
            PG8_BAR; PG8_WAIT_L(0); PG8_MMA(0, 1, At, B1); PG8_BAR;
            PG8_LDA(At, 0, 1); PG8_STAGE(PG8_SA(0, 0), a2, voffA);
            PG8_BAR; PG8_WAIT_L(0); PG8_MMA(1, 0, At, B0); PG8_BAR; PG8_SCHED;
            PG8_STAGE(PG8_SB(0, 1), b2 + hstep, voffB);
            PG8_WAIT_V(6); PG8_BAR; PG8_MMA(1, 1, At, B1); PG8_BAR;
            PG8_LDB(B0, 1, 0); PG8_SCHED; PG8_LDA(At, 1, 0); PG8_STAGE(PG8_SA(0, 1), a2 + hstep, voffA);
            PG8_WAIT_L(8); PG8_BAR; PG8_WAIT_L(0); PG8_MMA(0, 0, At, B0); PG8_BAR; PG8_SCHED;
            PG8_LDB(B1, 1, 1); PG8_STAGE(PG8_SB(1, 0), b3, voffB);
            PG8_BAR; PG8_WAIT_L(0); PG8_MMA(0, 1, At, B1); PG8_BAR;
            PG8_LDA(At, 1, 1); PG8_STAGE(PG8_SA(1, 0), a3, voffA);
            PG8_BAR; PG8_WAIT_L(0); PG8_MMA(1, 0, At, B0); PG8_BAR; PG8_SCHED;
            PG8_STAGE(PG8_SB(1, 1), b3 + hstep, voffB);
            PG8_WAIT_V(6); PG8_BAR; PG8_MMA(1, 1, At, B1); PG8_BAR;
            }
        };
        trip(0, std::true_type{});
#pragma unroll 1
        for (int t = 2; t < ntc; t += 2) trip(t, std::false_type{});
        if constexpr (ALIGN_EPI) { if (wr == 0) PG8_BAR; }
        if constexpr (!Epi::AFTER_DRAIN) { f32x4 acc[2][2][4][2];
#pragma unroll
            for (int a = 0; a < 2; ++a)
#pragma unroll
                for (int b = 0; b < 2; ++b)
#pragma unroll
                    for (int m = 0; m < 4; ++m) { acc[a][b][m][0] = __builtin_shufflevector(acc8[a][b][m], acc8[a][b][m], 0, 1, 2, 3); acc[a][b][m][1] = __builtin_shufflevector(acc8[a][b][m], acc8[a][b][m], 4, 5, 6, 7); }
            E(acc, cur, wr, wc, fr, fq); S.done(cur); }
        if (!has_next) break;
        cur = nxt; cA = nA; cB = nB; ++ui;
        if constexpr (ALIGN_EPI) { if (wr == 1) PG8_BAR; }
    }
    PG8_WAIT_V(0); S.flush();
    if constexpr (!ALIGN_EPI) { if (wr == 0) PG8_BAR; }
    PG8_BAR;
    static_assert(!Epi::AFTER_DRAIN, "fp8 body: plain epilogues only");
#undef PG8_SA
#undef PG8_SB
#undef PG8_STAGE
#undef PG8_LDA
#undef PG8_LDB
#undef PG8_MMA
#undef PG8_MMAZ
#undef PG8_LD8
#undef PG8_WAIT_V
#undef PG8_WAIT_L
#undef PG8_BAR
#undef PG8_SCHED
}
}
#include <hip/hip_bf16.h>
#include <cmath>
namespace attn_body {
using bf16=__hip_bfloat16;
using bf16x8=__attribute__((ext_vector_type(8)))short;
using s16x4=__attribute__((ext_vector_type(4)))short;
using f32x16=__attribute__((ext_vector_type(16)))float;
using u32x4=__attribute__((ext_vector_type(4)))unsigned;
constexpr int BATCH=2,NHEAD=8,SEQ=8192,D=64,DM=2560,OPITCH=1024;
constexpr int NW=8,QBLK=32,QB=QBLK*NW,KVBLK=64,NQB=SEQ/QB;
constexpr int ATTN_PITCH=DM, ATTN_UNIT_ROWS=QB;
__device__ __forceinline__ int crow(int r,int hi){return (r&3)+8*(r>>2)+4*hi;}
#define SBAR() __builtin_amdgcn_sched_barrier(0)
__device__ __forceinline__ void cmask(f32x16&p0,f32x16&p1,int jb,int qrel,int hi){
  const float NEG=-INFINITY; int kb=64*jb+4*hi;
  #pragma unroll
  for(int r=0;r<16;++r){int kv=kb+(r&3)+8*(r>>2); if(kv>qrel)p0[r]=NEG; if(kv+32>qrel)p1[r]=NEG;}
}

constexpr int NSLOT=3, SLOTB=8192;
constexpr int LDS_K=0, LDS_V=NSLOT*SLOTB, LDS_WS=2*NSLOT*SLOTB, LDS_OST=LDS_WS+NW*64*4, LDS_BIAS=LDS_OST+NW*4096, LDS_PRE=LDS_BIAS+SEQ*4, LDS_BYTES=LDS_PRE+1024;
constexpr float C2=0.125f*1.4426950408889634f;
__device__ __forceinline__ void glds16(const void*gsrc,unsigned lds_dst){unsigned keep;
  asm volatile("s_mov_b32 %0, m0\n\ts_mov_b32 m0, %2\n\ts_nop 0\n\tglobal_load_lds_dwordx4 %1, off\n\ts_mov_b32 m0, %0":"=&s"(keep):"v"(gsrc),"s"(lds_dst):"memory");}
__device__ __forceinline__ float max3f(float a,float b,float c){float r;asm("v_max3_f32 %0, %1, %2, %3":"=v"(r):"v"(a),"v"(b),"v"(c));return r;}
__device__ __forceinline__ float max2f(float a,float b){float r;asm("v_max_f32_e32 %0, %1, %2":"=v"(r):"v"(a),"v"(b));return r;}
__device__ __forceinline__ float fadd_s(float a,float b){float r;asm("v_add_f32_e32 %0, %1, %2":"=v"(r):"v"(a),"v"(b));return r;}
__device__ __forceinline__ float fsub_s(float a,float b){float r;asm("v_sub_f32_e32 %0, %1, %2":"=v"(r):"v"(a),"v"(b));return r;}
typedef float f32x2_t __attribute__((ext_vector_type(2))); typedef __bf16 bf16x2_t __attribute__((ext_vector_type(2)));
__device__ __forceinline__ unsigned cvtpk_s(float lo,float hi){f32x2_t v={lo,hi};bf16x2_t b=__builtin_convertvector(v,bf16x2_t);return __builtin_bit_cast(unsigned,b);}
#define WAIT_BAR(N) asm volatile("s_waitcnt vmcnt(" #N ") lgkmcnt(0)\n\ts_barrier":::"memory")

__device__ __forceinline__ void qkt(f32x16&p0,f32x16&p1,const char*Kslot,const bf16x8*qr,int r32,int hi){
  const char*kb=Kslot+hi*1024+r32*16;
  #pragma unroll
  for(int d0=0;d0<4;++d0){
    const bf16x8 b0=*reinterpret_cast<const bf16x8*>(kb+d0*2048);
    const bf16x8 b1=*reinterpret_cast<const bf16x8*>(kb+d0*2048+512);
    p0=__builtin_amdgcn_mfma_f32_32x32x16_bf16(b0,qr[d0],p0,0,0,0);p1=__builtin_amdgcn_mfma_f32_32x32x16_bf16(b1,qr[d0],p1,0,0,0);}
}
typedef __attribute__((address_space(3))) const char* lds_cptr;
typedef short v4i16_t __attribute__((ext_vector_type(4)));
__device__ __forceinline__ void kload8(bf16x8*kf,lds_cptr kp){
  kf[0]=*(const __attribute__((address_space(3))) bf16x8*)(kp);      kf[1]=*(const __attribute__((address_space(3))) bf16x8*)(kp+512);
  kf[2]=*(const __attribute__((address_space(3))) bf16x8*)(kp+2048); kf[3]=*(const __attribute__((address_space(3))) bf16x8*)(kp+2560);
  kf[4]=*(const __attribute__((address_space(3))) bf16x8*)(kp+4096); kf[5]=*(const __attribute__((address_space(3))) bf16x8*)(kp+4608);
  kf[6]=*(const __attribute__((address_space(3))) bf16x8*)(kp+6144); kf[7]=*(const __attribute__((address_space(3))) bf16x8*)(kp+6656);
}
__device__ __forceinline__ void kload2(bf16x8*kf,lds_cptr kp,int j){ kf[2*j]=*(const __attribute__((address_space(3))) bf16x8*)(kp+j*2048); kf[2*j+1]=*(const __attribute__((address_space(3))) bf16x8*)(kp+j*2048+512); }
__device__ __forceinline__ s16x4 vtr(lds_cptr p){ return __builtin_bit_cast(s16x4,__builtin_amdgcn_ds_read_tr16_b64_v4i16((__attribute__((address_space(3))) v4i16_t*)p)); }
__device__ __forceinline__ float rowmax(const f32x16&p0,const f32x16&p1){
  float a=max3f(p0[0],p0[1],p1[0]),b=max3f(p0[2],p0[3],p1[1]);a=max3f(a,p1[2],p1[3]);
  #pragma unroll
  for(int r=4;r<16;r+=4){a=max3f(a,p0[r],p0[r+1]);b=max3f(b,p0[r+2],p0[r+3]);a=max3f(a,p1[r],p1[r+1]);b=max3f(b,p1[r+2],p1[r+3]);}
  const float m=max2f(a,b);
  auto rr=__builtin_amdgcn_permlane32_swap(__float_as_uint(m),__float_as_uint(m),false,false);
  return max2f(__uint_as_float(rr[0]),__uint_as_float(rr[1]));
}
__device__ __forceinline__ void pv(f32x16*o,int vb,bf16x8 pa0,bf16x8 pa1,bf16x8 pa2,bf16x8 pa3){
  #pragma unroll
  for(int d0=0;d0<2;++d0){s16x4 lo[4],hi[4];
    #pragma unroll
    for(int ks=0;ks<4;++ks){
      asm volatile("ds_read_b64_tr_b16 %0,%1 offset:%c2":"=&v"(lo[ks]):"v"(vb),"i"(d0*4096+ks*1024):"memory");
      asm volatile("ds_read_b64_tr_b16 %0,%1 offset:%c2":"=&v"(hi[ks]):"v"(vb),"i"(d0*4096+ks*1024+512):"memory");}
    asm volatile("s_waitcnt lgkmcnt(0)":::"memory");SBAR();
    #define PK(k) (bf16x8){lo[k][0],lo[k][1],lo[k][2],lo[k][3],hi[k][0],hi[k][1],hi[k][2],hi[k][3]}
    o[d0]=__builtin_amdgcn_mfma_f32_32x32x16_bf16(pa0,PK(0),o[d0],0,0,0);
    o[d0]=__builtin_amdgcn_mfma_f32_32x32x16_bf16(pa1,PK(1),o[d0],0,0,0);
    o[d0]=__builtin_amdgcn_mfma_f32_32x32x16_bf16(pa2,PK(2),o[d0],0,0,0);
    o[d0]=__builtin_amdgcn_mfma_f32_32x32x16_bf16(pa3,PK(3),o[d0],0,0,0);
    #undef PK
  }
}

#ifndef ATTN_STORE16
#define ATTN_STORE16(p,v) (*(u32x4*)(p)=(v))
#endif
typedef float f32x4b __attribute__((ext_vector_type(4)));
template<int THRL> __device__ __forceinline__ void attn_unit(int b,int h,int qb,const bf16*Q,const bf16*__restrict__ K,const bf16*__restrict__ V,bf16*O,const float*__restrict__ floc,const float*__restrict__ ftot,const float*__restrict__ qkn,char*shm){
  int tid=threadIdx.x; asm volatile("":"+v"(tid)); const int lane=tid&63,r32=lane&31,hi=lane>>5; const int wid=__builtin_amdgcn_readfirstlane(tid>>6);
  const long rowbase=(long)b*SEQ; const int q0=qb*QB;
  typedef __attribute__((address_space(3))) float* lds_fptr;
  const lds_fptr prel=(lds_fptr)((lds_cptr)shm+LDS_PRE); const lds_fptr biasl=(lds_fptr)((lds_cptr)shm+LDS_BIAS);
  { const int nblk=4*(qb+1);
    if(wid==0){ int pl_=lane; asm volatile("":"+v"(pl_));
      float a0=(pl_<nblk)?ftot[(b*128+pl_)*8+h]:0.f, a1=(pl_+64<nblk)?ftot[(b*128+64+pl_)*8+h]:0.f; float s0=a0,s1=a1;
      #pragma unroll
      for(int o_=1;o_<64;o_<<=1){ const float t0_=__shfl_up(s0,o_),t1_=__shfl_up(s1,o_); if(pl_>=o_){s0+=t0_;s1+=t1_;} }
      s1+=__shfl(s0,63); const float p0_=s0-a0,p1_=s1-a1;
      prel[pl_]=p0_; prel[pl_+64]=p1_;
      const float*kn_=qkn+(size_t)(256+b*128)*16+h*2; const float*qn_=qkn+(size_t)(b*128)*16+h*2;
      float k2=(pl_<nblk)?(kn_[pl_*16]+kn_[pl_*16+1]):0.f; { const float k2b=(pl_+64<nblk)?(kn_[(pl_+64)*16]+kn_[(pl_+64)*16+1]):0.f; k2=fmaxf(k2,k2b); }
      float q2=(pl_<4)?(qn_[(4*qb+pl_)*16]+qn_[(4*qb+pl_)*16+1]):0.f;
      #pragma unroll
      for(int o_=1;o_<64;o_<<=1){ k2=fmaxf(k2,__shfl_xor(k2,o_)); q2=fmaxf(q2,__shfl_xor(q2,o_)); }
      const float need=30.f+2.04f*sqrtf(k2*q2);
      const float cu=__shfl(qb<16?p0_:p1_,(4*qb)&63);
      const bool c0_=((pl_&1)==0)&&(pl_<=4*qb)&&((p0_-cu)*1.4426950408889634f>=need);
      const bool c1_=((pl_&1)==0)&&(pl_+64<=4*qb)&&((p1_-cu)*1.4426950408889634f>=need);
      const unsigned long long m0_=__ballot(c0_),m1_=__ballot(c1_);
      const int ts_=m1_?(127-__builtin_clzll(m1_)):(m0_?(63-__builtin_clzll(m0_)):0);
      if(pl_==0)prel[128]=__int_as_float(ts_); }
    asm volatile("s_waitcnt vmcnt(0) lgkmcnt(0)\n\ts_barrier":::"memory"); }
  const int tstart=__builtin_amdgcn_readfirstlane(__float_as_int(prel[128]));
  const bf16*Qw=Q+(rowbase+q0+wid*QBLK)*DM+h*D;
  const bf16*Kh=K+(rowbase+(long)tstart*KVBLK)*DM+h*D,*Vh=V+(rowbase+(long)tstart*KVBLK)*DM+h*D;
  const lds_cptr shm3=(lds_cptr)shm;
  const unsigned lds0=(unsigned)(uintptr_t)shm;
  float*wsf=(float*)(shm+LDS_WS)+wid*64;
  const bf16*ksrc=Kh+(long)lane*DM+wid*8;
  const bf16*vsrc=Vh+(long)(16*(wid&3)+(lane>>2))*DM+(wid>>2)*32+(lane&3)*8;
  const unsigned kdst=lds0+LDS_K+wid*1024, vdst=lds0+LDS_V+wid*1024;
  #define DMA_K(t,slot) glds16(ksrc+(long)(t)*KVBLK*DM,(unsigned)__builtin_amdgcn_readfirstlane(kdst+(slot)))
  #define DMA_V(t,slot) glds16(vsrc+(long)(t)*KVBLK*DM,(unsigned)__builtin_amdgcn_readfirstlane(vdst+(slot)))
  const int vb0=(int)(lds0+LDS_V)+((lane>>4)&1)*32+(lane&3)*8+(4*hi+((lane&15)>>2))*64;
  const char*Kbase=shm+LDS_K; bf16x8 kf[8];
  const lds_cptr kp0=shm3+LDS_K+hi*1024+r32*16; const lds_cptr vp0=shm3+LDS_V+((lane>>4)&1)*32+(lane&3)*8+(4*hi+((lane&15)>>2))*64;
  const int NT=(q0+QB)/KVBLK-tstart;
  DMA_K(0,0);DMA_V(0,0);DMA_K(1,SLOTB);
  bf16x8 qr[4];
  #pragma unroll
  for(int d0=0;d0<4;++d0)qr[d0]=*reinterpret_cast<const bf16x8*>(&Qw[(long)r32*DM+d0*16+hi*8]);
  { const float cref=prel[4*qb];
    for(int s_=64*tstart+tid;s_<256*(qb+1);s_+=NW*64) biasl[s_-64*tstart]=(cref-(prel[s_>>6]+floc[((long)b*8+h)*SEQ+s_]))*1.4426950408889634f;
    asm volatile("s_waitcnt vmcnt(0) lgkmcnt(0)\n\ts_barrier":::"memory"); }
  #define BIASINIT(P0,P1,t) do{ const __attribute__((address_space(3))) f32x4b* bq_=(const __attribute__((address_space(3))) f32x4b*)(biasl+64*(t)+4*hi); \
    _Pragma("unroll") for(int g_=0;g_<4;++g_){ const f32x4b x0_=bq_[2*g_],x1_=bq_[8+2*g_]; \
      P0[4*g_]=x0_[0]-mhat;P0[4*g_+1]=x0_[1]-mhat;P0[4*g_+2]=x0_[2]-mhat;P0[4*g_+3]=x0_[3]-mhat; P1[4*g_]=x1_[0]-mhat;P1[4*g_+1]=x1_[1]-mhat;P1[4*g_+2]=x1_[2]-mhat;P1[4*g_+3]=x1_[3]-mhat; } }while(0)
  float mhat=0.f,l_reg=0.f;f32x16 o[2];o[0]=f32x16{};o[1]=f32x16{};
  const int qrel=wid*QBLK+r32;
  #define CMASK(P0,P1,t) do{int jb_=(t)-(NT-4); if(jb_>=0)cmask(P0,P1,jb_,qrel,hi);}while(0)
  bool resc=false;
  #define START(P0,P1) do{ const float rm=rowmax(P0,P1); resc=false; \
    { const float dl=rm; mhat=fadd_s(mhat,dl); \
      _Pragma("unroll") for(int r=0;r<16;++r){P0[r]=fsub_s(P0[r],dl);P1[r]=fsub_s(P1[r],dl);} } \
    _Pragma("unroll") for(int r=0;r<16;++r)P0[r]=__builtin_amdgcn_exp2f(P0[r]); }while(0)
  #define RESC() do{ if(resc){ asm volatile("s_waitcnt lgkmcnt(0)":::"memory"); \
      _Pragma("unroll") for(int d_=0;d_<2;++d_) _Pragma("unroll") for(int r=0;r<16;++r)o[d_][r]*=wsf[crow(r,hi)]; } }while(0)
  f32x16 pA0,pA1,pB0,pB1;
  int sl_prev=0,sl_cur=0,sl_next=SLOTB;
  #define ROT() do{sl_prev=sl_cur;sl_cur=sl_next;sl_next=(sl_next==(NSLOT-1)*SLOTB)?0:sl_next+SLOTB;}while(0)
  DMA_K(2,2*SLOTB);
  WAIT_BAR(3);
  BIASINIT(pA0,pA1,0);qkt(pA0,pA1,Kbase,qr,r32,hi);asm volatile("s_nop 15\n\ts_nop 7":"+v"(pA0),"+v"(pA1));CMASK(pA0,pA1,0);
  START(pA0,pA1);
  _Pragma("unroll") for(int r=0;r<16;++r)pA1[r]=__builtin_amdgcn_exp2f(pA1[r]);
  WAIT_BAR(0);
  DMA_K(3,0);DMA_V(1,SLOTB);
  ROT();
  kload8(kf,kp0+sl_cur);
  WAIT_BAR(2);
  s16x4 vlo[8],vhi[8]; u32x4 pw0,pw1,pw2,pw3;
  #define PKW(P,B) cvtpk_s(P[B],P[B+1])
  #define PAF(k) __builtin_bit_cast(bf16x8,pw##k)
  #define VFR(i) (bf16x8){vlo[i][0],vlo[i][1],vlo[i][2],vlo[i][3],vhi[i][0],vhi[i][1],vhi[i][2],vhi[i][3]}
  #define PIN(x) asm volatile("":"+v"(x))
  #define MX3(a,b,c) __builtin_fmaxf(__builtin_fmaxf((a),(b)),(c))
  #define GAPA(MF,A0,A1,A2,A3,W0,W1,PW) do{ MF; sacc+=A0; sacc+=A1; sacc+=A2; sacc+=A3; PIN(sacc); W0; W1; PIN(PW); SBAR(); }while(0)
  #define EX(v) __builtin_amdgcn_exp2f(v)
  #define GAPB(MF,X,B) do{ MF; X[B]=EX(X[B]); X[B+1]=EX(X[B+1]); X[B+2]=EX(X[B+2]); X[B+3]=EX(X[B+3]); PIN(X); SBAR(); }while(0)
  #define VRD(i) do{ vlo[i]=vtr(vp_+(((i)>>2)*4096+((i)&3)*1024)); vhi[i]=vtr(vp_+(((i)>>2)*4096+((i)&3)*1024+512)); }while(0)
  #define KRD(G,j) do{ if(G){ kload2(kf,kp0+sl_next,j); SBAR(); } }while(0)
  #define STEP(C0,C1,P0,P1,t,GK,GV,GL) do{ SBAR(); BIASINIT(C0,C1,t); SBAR(); \
    const lds_cptr vp_=vp0+sl_prev; \
    VRD(0); SBAR(); float sacc=(P0[0]+P0[1]); \
    GAPA(C0=__builtin_amdgcn_mfma_f32_32x32x16_bf16(kf[0],qr[0],C0,0,0,0), P0[2],P0[3],P0[4],P0[5],     pw0[0]=PKW(P0,0), pw0[1]=PKW(P0,2), pw0); \
    VRD(4); SBAR(); GAPA(C1=__builtin_amdgcn_mfma_f32_32x32x16_bf16(kf[1],qr[0],C1,0,0,0), P0[6],P0[7],P0[8],P0[9],     pw0[2]=PKW(P0,4), pw0[3]=PKW(P0,6), pw0); \
    VRD(1); SBAR(); GAPA(C0=__builtin_amdgcn_mfma_f32_32x32x16_bf16(kf[2],qr[1],C0,0,0,0),   P0[10],P0[11],P0[12],P0[13], pw1[0]=PKW(P0,8), pw1[1]=PKW(P0,10), pw1); \
    VRD(5); SBAR(); GAPA(C1=__builtin_amdgcn_mfma_f32_32x32x16_bf16(kf[3],qr[1],C1,0,0,0),   P0[14],P0[15],P1[0],P1[1],   pw1[2]=PKW(P0,12),pw1[3]=PKW(P0,14), pw1); \
    VRD(2); SBAR(); GAPA(C0=__builtin_amdgcn_mfma_f32_32x32x16_bf16(kf[4],qr[2],C0,0,0,0),   P1[2],P1[3],P1[4],P1[5],     pw2[0]=PKW(P1,0), pw2[1]=PKW(P1,2), pw2); \
    VRD(6); SBAR(); GAPA(C1=__builtin_amdgcn_mfma_f32_32x32x16_bf16(kf[5],qr[2],C1,0,0,0),   P1[6],P1[7],P1[8],P1[9],     pw2[2]=PKW(P1,4), pw2[3]=PKW(P1,6), pw2); \
    VRD(3); SBAR(); GAPA(C0=__builtin_amdgcn_mfma_f32_32x32x16_bf16(kf[6],qr[3],C0,0,0,0),   P1[10],P1[11],P1[12],P1[13], pw3[0]=PKW(P1,8), pw3[1]=PKW(P1,10), pw3); \
    VRD(7); SBAR(); GAPA(C1=__builtin_amdgcn_mfma_f32_32x32x16_bf16(kf[7],qr[3],C1,0,0,0),   P1[14],P1[15],0.f,0.f,       pw3[2]=PKW(P1,12),pw3[3]=PKW(P1,14), pw3); \
    l_reg+=sacc; \
    if(GK){DMA_K((t)+3,sl_cur);} if(GV){DMA_V((t)+1,sl_next);} \
    CMASK(C0,C1,t); \
    { float a=MX3(C0[0],C0[1],C1[0]),b=MX3(C0[2],C0[3],C1[1]); a=MX3(a,C1[2],C1[3]); \
      _Pragma("unroll") for(int r=4;r<16;r+=4){a=MX3(a,C0[r],C0[r+1]);b=MX3(b,C0[r+2],C0[r+3]);a=MX3(a,C1[r],C1[r+1]);b=MX3(b,C1[r+2],C1[r+3]);} \
      float rm=__builtin_fmaxf(a,b); { auto rr=__builtin_amdgcn_permlane32_swap(__float_as_uint(rm),__float_as_uint(rm),false,false); rm=__builtin_fmaxf(__uint_as_float(rr[0]),__uint_as_float(rr[1])); } \
      resc=false; \
      if(__builtin_expect(__any(rm>(float)THRL),0)){ const float dl=__builtin_fmaxf(rm,0.f); mhat+=dl; \
        _Pragma("unroll") for(int r=0;r<16;++r){C0[r]-=dl;C1[r]-=dl;} \
        const float f=__builtin_amdgcn_exp2f(-dl); l_reg*=f; if(hi==0)wsf[r32]=f; resc=true; } } \
    SBAR(); \
    GAPB(o[0]=__builtin_amdgcn_mfma_f32_32x32x16_bf16(PAF(0),VFR(0),o[0],0,0,0), C0,0); \
    GAPB(o[1]=__builtin_amdgcn_mfma_f32_32x32x16_bf16(PAF(0),VFR(4),o[1],0,0,0), C0,4); \
    KRD(GL,0); GAPB(o[0]=__builtin_amdgcn_mfma_f32_32x32x16_bf16(PAF(1),VFR(1),o[0],0,0,0), C0,8); \
    KRD(GL,1); GAPB(o[1]=__builtin_amdgcn_mfma_f32_32x32x16_bf16(PAF(1),VFR(5),o[1],0,0,0), C0,12); \
    KRD(GL,2); GAPB(o[0]=__builtin_amdgcn_mfma_f32_32x32x16_bf16(PAF(2),VFR(2),o[0],0,0,0), C1,0); \
    KRD(GL,3); GAPB(o[1]=__builtin_amdgcn_mfma_f32_32x32x16_bf16(PAF(2),VFR(6),o[1],0,0,0), C1,4); \
    GAPB(o[0]=__builtin_amdgcn_mfma_f32_32x32x16_bf16(PAF(3),VFR(3),o[0],0,0,0), C1,8); \
    GAPB(o[1]=__builtin_amdgcn_mfma_f32_32x32x16_bf16(PAF(3),VFR(7),o[1],0,0,0), C1,12); \
    }while(0)
  int t=1;
  #undef CMASK
  #define CMASK(P0,P1,t) do{}while(0)
  for(;t+5<NT;t+=2){
    STEP(pB0,pB1,pA0,pA1,t,true,true,true);     WAIT_BAR(2); RESC(); ROT();
    STEP(pA0,pA1,pB0,pB1,t+1,true,true,true);   WAIT_BAR(2); RESC(); ROT();
  }
  #undef CMASK
  #define CMASK(P0,P1,t) do{int jb_=(t)-(NT-4); if(jb_>=0)cmask(P0,P1,jb_,qrel,hi);}while(0)
  #define ENDW(tt) do{ if((tt)+3<NT){WAIT_BAR(2);} else if((tt)+2<NT){WAIT_BAR(1);} else {WAIT_BAR(0);} }while(0)
  for(;t+1<NT;t+=2){
    STEP(pB0,pB1,pA0,pA1,t,(t+3<NT),(t+1<NT),(t+1<NT));       ENDW(t);   RESC(); ROT();
    STEP(pA0,pA1,pB0,pB1,t+1,(t+4<NT),(t+2<NT),(t+2<NT));     ENDW(t+1); RESC(); ROT();
  }
  STEP(pB0,pB1,pA0,pA1,NT-1,false,false,false); RESC();
  { float sacc=pB0[0]+pB0[1]; _Pragma("unroll") for(int r=2;r<16;++r)sacc+=pB0[r]; _Pragma("unroll") for(int r=0;r<16;++r)sacc+=pB1[r]; l_reg+=sacc;
    pw0=(u32x4){PKW(pB0,0),PKW(pB0,2),PKW(pB0,4),PKW(pB0,6)};pw1=(u32x4){PKW(pB0,8),PKW(pB0,10),PKW(pB0,12),PKW(pB0,14)};pw2=(u32x4){PKW(pB1,0),PKW(pB1,2),PKW(pB1,4),PKW(pB1,6)};pw3=(u32x4){PKW(pB1,8),PKW(pB1,10),PKW(pB1,12),PKW(pB1,14)};
    SBAR(); pv(o,vb0+sl_cur,PAF(0),PAF(1),PAF(2),PAF(3)); }
  #undef PKW
  #undef PAF
  #undef VFR
  #undef PIN
  #undef MX3
  #undef GAPA
  #undef GAPB
  #undef EX
  #undef VRD
  #undef KRD
  #undef STEP
  #undef ENDW
  {auto rr=__builtin_amdgcn_permlane32_swap(__float_as_uint(l_reg),__float_as_uint(l_reg),false,false);l_reg=__uint_as_float(rr[0])+__uint_as_float(rr[1]);}
  if(hi==0)wsf[32+r32]=l_reg;asm volatile("s_waitcnt lgkmcnt(0)":::"memory");
  float rli[16];
  #pragma unroll
  for(int r=0;r<16;++r)rli[r]=__builtin_amdgcn_rcpf(wsf[32+crow(r,hi)]);
  bf16*Ow=O+(rowbase+q0+wid*QBLK)*OPITCH+h*D;
  { bf16*stg=(bf16*)(shm+LDS_OST)+wid*2048;
    #pragma unroll
    for(int r=0;r<16;++r){const int orow=crow(r,hi);
      #pragma unroll
      for(int d0=0;d0<2;++d0)stg[orow*64+d0*32+r32]=__float2bfloat16(o[d0][r]*rli[r]);}
    asm volatile("s_waitcnt lgkmcnt(0)":::"memory");
    #pragma unroll
    for(int i=0;i<4;++i){const int row=i*8+(lane>>3),ch=lane&7; const u32x4 v=*(const u32x4*)(stg+row*64+ch*8); ATTN_STORE16(Ow+(long)row*OPITCH+ch*8,v);} }
  asm volatile("s_waitcnt lgkmcnt(0)\n\ts_barrier":::"memory");
  #undef DMA_K
  #undef DMA_V
  #undef BIASINIT
  #undef CMASK
  #undef START
  #undef RESC
  #undef ROT
}
constexpr int ATTN_LDS_BYTES=LDS_BYTES;
struct AttnTensors { const bf16* Q; const bf16* K; const bf16* V; bf16* O; const float* floc; const float* ftot; const float* qkn; };
struct AttnUnit { int bh; int qb; };
struct StaticOrder {
  int vcu, G;
  __device__ __forceinline__ explicit StaticOrder(int grid,int block):vcu((grid%8==0)?(block%8)*(grid/8)+block/8:block),G(grid){}
  __device__ __forceinline__ bool next(int i,AttnUnit&u)const{ const int pair=vcu+(i>>1)*G; if(pair>=256)return false; const int s=pair&15; u.bh=pair>>4; u.qb=(i&1)?s:31-s; return true; }
  __device__ __forceinline__ void a_ready(const AttnUnit&)const{}
  __device__ __forceinline__ void done(const AttnUnit&)const{}
};
template<class Sched,int THRL=8> __device__ __forceinline__ void attn_phase(char*lds,const AttnTensors&T,const Sched&S){
  AttnUnit u;
  for(int i=0;S.next(i,u);++i){ S.a_ready(u); attn_unit<THRL>(u.bh/NHEAD,u.bh%NHEAD,u.qb,T.Q,T.K,T.V,T.O,T.floc,T.ftot,T.qkn,lds); S.done(u); }
}
#undef SBAR
#undef WAIT_BAR
}
#define GAS __attribute__((address_space(1)))
#define LAS __attribute__((address_space(3)))
typedef unsigned short bf16;
typedef unsigned v4u __attribute__((ext_vector_type(4)));
typedef float f32x4 __attribute__((ext_vector_type(4)));
typedef short bf16x8 __attribute__((ext_vector_type(8)));
typedef GAS unsigned gu32;
typedef GAS unsigned long long gu64;
#define RLX_AGENT __ATOMIC_RELAXED, __HIP_MEMORY_SCOPE_AGENT
#define LDS_WAIT() asm volatile("s_waitcnt lgkmcnt(0)" ::: "memory")
#define VM_WAIT() asm volatile("s_waitcnt vmcnt(0)" ::: "memory")
__device__ __forceinline__ unsigned long long rt() { return __builtin_amdgcn_s_memrealtime(); }
__device__ __forceinline__ unsigned f2bf(float f) { unsigned u = __builtin_bit_cast(unsigned, f); return (u + 0x7fffu + ((u >> 16) & 1u)) >> 16; }
__device__ __forceinline__ unsigned pk2(float lo, float hi) { return f2bf(lo) | (f2bf(hi) << 16); }

#define XB_TMO      128
#define XB_XCNT(j)  (256  + 64 * (j))
#define XB_XSUB(j)  (1280 + 64 * (j))
#define XB_XGEN(j)  (2304 + 64 * (j))
#define XB_TOP      3328
#define XB_TOPGEN   3392
#define XCD_BAR_WORDS 3456
#define XB_SPIN_CAP (1u << 18)

__device__ __forceinline__ unsigned xb_ld(unsigned* p)              { return __hip_atomic_load(p, __ATOMIC_RELAXED, __HIP_MEMORY_SCOPE_AGENT); }
__device__ __forceinline__ unsigned xb_add(unsigned* p, unsigned v) { return __hip_atomic_fetch_add(p, v, __ATOMIC_RELAXED, __HIP_MEMORY_SCOPE_AGENT); }
__device__ __forceinline__ unsigned xb_xcc_id() { return (unsigned)__builtin_amdgcn_s_getreg((3 << 11) | 20) & 0xFu; }
#define XB_SPIN(cond, bar) do { unsigned _sp = 0; while (cond) { __builtin_amdgcn_s_sleep(1); \
    if ((++_sp & 255u) == 0u) { if (xb_ld(&(bar)[XB_TMO])) break; if (_sp > XB_SPIN_CAP) { atomicAdd(&(bar)[XB_TMO], 1u); break; } } } } while (0)

struct XcdBarrier {
    unsigned* bar; unsigned x;
    volatile LAS unsigned* st;
};

__device__ __forceinline__ XcdBarrier xcd_barrier_post(unsigned* bar, volatile LAS unsigned* st) {
    XcdBarrier b; b.bar = bar; b.x = xb_xcc_id(); b.st = st;
    if (threadIdx.x == 0) (void)xb_add(&bar[XB_XCNT(b.x)], 1u);
    return b;
}
__device__ __forceinline__ void xcd_barrier_complete(unsigned* bar, unsigned x, unsigned& nloc, unsigned& nx) {
    const unsigned G = gridDim.x * gridDim.y * gridDim.z;
    unsigned sum, cnt, mine, sp = 0u;
    for (;;) {
        sum = 0u; cnt = 0u; mine = 0u;
#pragma unroll
        for (unsigned j = 0; j < 16; ++j) { const unsigned c = xb_ld(&bar[XB_XCNT(j)]); sum += c; cnt += (c > 0u) ? 1u : 0u; mine = (j == x) ? c : mine; }
        if (sum == G) break;
        __builtin_amdgcn_s_sleep(1);
        if ((++sp & 255u) == 0u) { if (xb_ld(&bar[XB_TMO])) break; if (sp > XB_SPIN_CAP) { atomicAdd(&bar[XB_TMO], 1u); break; } }
    }
    nloc = mine > 0u ? mine : 1u; nx = cnt > 0u ? cnt : 1u;
}

__device__ __forceinline__ void xcd_barrier(const XcdBarrier& b) {
    asm volatile("s_waitcnt vmcnt(0)" ::: "memory");
    __syncthreads();
    if (threadIdx.x == 0) {
        unsigned* bar = b.bar;
        __builtin_amdgcn_s_waitcnt(0);
        unsigned nloc = b.st[0], nx = b.st[1];
        if (nloc == 0u) { xcd_barrier_complete(bar, b.x, nloc, nx); b.st[0] = nloc; b.st[1] = nx; }
        const unsigned old = xb_add(&bar[XB_XSUB(b.x)], 1u);
        const unsigned gen = old / nloc;
        if (old + 1u == (gen + 1u) * nloc) {
            __builtin_amdgcn_fence(__ATOMIC_RELEASE, "agent");
            asm volatile("s_waitcnt vmcnt(0)" ::: "memory");
            const unsigned og = xb_add(&bar[XB_TOP], 1u);
            const unsigned tg = og / nx;
            if (og + 1u == (tg + 1u) * nx) xb_add(&bar[XB_TOPGEN], 1u);
            else XB_SPIN(xb_ld(&bar[XB_TOPGEN]) == tg, bar);
            __builtin_amdgcn_fence(__ATOMIC_ACQUIRE, "agent");
            asm volatile("s_waitcnt vmcnt(0)" ::: "memory");
        } else {
            XB_SPIN(xb_ld(&bar[XB_TOPGEN]) == gen, bar);
            __builtin_amdgcn_fence(__ATOMIC_ACQUIRE, "agent");
            asm volatile("s_waitcnt vmcnt(0)" ::: "memory");
        }
    }
    __syncthreads();
}
constexpr int NWAVES = 8, NTHR = 512;
constexpr int BATCH = 2, SEQ = 8192, DMODEL = 1024, MROWS = BATCH * SEQ;
constexpr int N0 = 2560, N0SRC = 2568, DFF = 2816, N1 = 3072, N1SRC = 3088, NEXP = 8, DFFE = 3584;
constexpr int MOE_TILES = 136, MOE_ROWS = MOE_TILES * 256;
constexpr float EPS = 1e-6f, LOG2E = 1.4426950408889634f;
constexpr int NPHASE = 15;
#ifndef MK_ONE_LAUNCH
#define MK_ONE_LAUNCH 1
#endif
constexpr size_t MiB = 1u << 20;
constexpr size_t WS_CTL = 0, CTL_ZERO_BYTES = 65536;
constexpr size_t WS_FLOC0 = 1 * MiB, WS_FLOC1 = WS_FLOC0 + 512 * 1024, WS_IG1 = WS_FLOC1 + 512 * 1024;
constexpr size_t WS_TOKS = WS_IG1 + 512 * 1024;
constexpr size_t WS_SGATE2 = WS_TOKS + 128 * 1024;
constexpr size_t WS_FTOT0 = WS_SGATE2 + 512 * 1024, WS_FTOT1 = WS_FTOT0 + 8192, WS_GMAX1 = WS_FTOT1 + 8192, WS_HIST = WS_GMAX1 + 8192, WS_META = WS_HIST + 8192, WS_QKN = WS_META + 4096;
static_assert(WS_QKN + 32768 <= 4 * MiB, "small arrays");
constexpr size_t WS_EGU8 = 4 * MiB;
constexpr size_t WS_ED8 = 60 * MiB;
constexpr size_t WS_H = 116 * MiB;
constexpr size_t WS_W0IN = 148 * MiB, WS_W0OUT = WS_W0IN + 5 * MiB, WS_W0GU = WS_W0OUT + 2 * MiB, WS_W0D = WS_W0GU + 11 * MiB, WS_W1IN = WS_W0D + 5632 * 1024,
                 WS_WQ = WS_W1IN + 6 * MiB, WS_WK = WS_WQ + 256 * 1024, WS_W1OUT = WS_WK + 256 * 1024;
static_assert(WS_W1OUT + 2 * MiB == 180 * MiB, "dense weights");
constexpr size_t WS_R = 180 * MiB;
constexpr size_t WS_CAT = 276 * MiB, WS_Q1 = 308 * MiB, WS_K1 = 340 * MiB, WS_TST = 372 * MiB;
constexpr size_t WS_X = 392 * MiB;
constexpr size_t WS_ROWSS = 424 * MiB;
constexpr size_t WS_AG8 = 88 * MiB;
constexpr size_t WS_YS = 160 * MiB;
constexpr size_t WS_ACTM8 = 232 * MiB;
constexpr size_t WS_Y = 88 * MiB;
constexpr size_t WS_END = WS_ROWSS + (size_t)MROWS * 64;
static_assert(WS_AG8 + (size_t)8 * 16384 * 1024 <= WS_ACTM8 && WS_Y + (size_t)MOE_ROWS * 1024 * 4 <= WS_ACTM8 && WS_ED8 + (size_t)8 * 1024 * DFFE <= WS_Y && WS_EGU8 + (size_t)8 * 7168 * 1024 <= WS_ED8 && WS_ACTM8 + (size_t)MOE_ROWS * DFFE <= WS_X && WS_TST + (size_t)256 * 160 * 128 * 4 <= WS_X && WS_END <= 455 * MiB, "moe map");
constexpr int CW_TMO = 0, CW_BAR = 4096, CW_CNT = 13056, CW_Q2 = 8256, CW_Q1 = 8320, CW_RDY = 8448;
constexpr int SCR_BYTES = 155648, MISC_OFF = SCR_BYTES, LDS_BYTES = 159744;
__device__ __forceinline__ float bf2f(unsigned short b) { return __uint_as_float((unsigned)b << 16); }
__device__ __forceinline__ float bflo(unsigned w) { return __uint_as_float(w << 16); }
__device__ __forceinline__ float bfhi(unsigned w) { return __uint_as_float(w & 0xffff0000u); }
__device__ __forceinline__ float wave_sum(float v) {
#pragma unroll
    for (int o = 1; o < 64; o <<= 1) v += __shfl_xor(v, o);
    return v;
}
__device__ __forceinline__ float wave_max(float v) {
#pragma unroll
    for (int o = 1; o < 64; o <<= 1) v = fmaxf(v, __shfl_xor(v, o));
    return v;
}
__device__ __forceinline__ float scan_add(float v, int lane) {
#pragma unroll
    for (int o = 1; o < 64; o <<= 1) { const float t = __shfl_up(v, o); if (lane >= o) v += t; }
    return v;
}
__device__ __forceinline__ float scan_max(float v, int lane) {
#pragma unroll
    for (int o = 1; o < 64; o <<= 1) { const float t = __shfl_up(v, o); if (lane >= o) v = fmaxf(v, t); }
    return v;
}
__device__ __forceinline__ float log_sigmoid(float z) { return fminf(z, 0.f) - log1pf(expf(-fabsf(z))); }
__device__ __forceinline__ float sigmoid_f(float z) { return 1.0f / (1.0f + expf(-z)); }

struct KP {
    const float* in[29]; float* out; unsigned char* ws; int ph_lo, ph_hi;
};
typedef const __attribute__((address_space(4))) KP* KPp;
__device__ __forceinline__ KPp kp_get() { KPp q = (KPp)__builtin_amdgcn_kernarg_segment_ptr(); asm volatile("" : "+s"(q)); return q; }
enum { I_X = 0, I_L0N1G, I_L0WIN, I_L0BF, I_L0DWW, I_L0DWB, I_L0CLNG, I_L0CLNB, I_L0WOUT, I_L0N2G, I_L0WG, I_L0WU, I_L0WD,
       I_L1N1G, I_L1WIN, I_L1BI, I_L1BF, I_L1CW, I_L1CB, I_L1WQ, I_L1WK, I_L1HG, I_L1WOUT, I_L1N2G, I_L1RT, I_L1EG, I_L1EU, I_L1ED, I_FNG };

__device__ __forceinline__ void cvt_item(const float* src, int ld, int c0, int k0, bf16* dst, int K, int r0, float scale, LAS float* scr, int lane, const float* ksc = nullptr) {
    const GAS float* s = (const GAS float*)src + (size_t)k0 * ld + c0;
    f32x4 v[16];
#pragma unroll
    for (int i = 0; i < 16; ++i) v[i] = __builtin_nontemporal_load((const GAS f32x4*)(s + (size_t)(4 * i + (lane >> 4)) * ld + 4 * (lane & 15)));
#pragma unroll
    for (int i = 0; i < 16; ++i) { LAS float* p = scr + (4 * i + (lane >> 4)) * 65 + 4 * (lane & 15); p[0] = v[i][0]; p[1] = v[i][1]; p[2] = v[i][2]; p[3] = v[i][3]; }
    LDS_WAIT(); asm volatile("" ::: "memory");
    const int c = lane & 7;
    float ks[8];
#pragma unroll
    for (int i = 0; i < 8; ++i) ks[i] = ksc ? scale * ksc[k0 + 8 * c + i] : scale;
#pragma unroll
    for (int j = 0; j < 8; ++j) { const int n = (lane >> 3) + 8 * j; const LAS float* q = scr + (8 * c) * 65 + n;
        v4u o; o.x = pk2(q[0] * ks[0], q[65] * ks[1]); o.y = pk2(q[130] * ks[2], q[195] * ks[3]); o.z = pk2(q[260] * ks[4], q[325] * ks[5]); o.w = pk2(q[390] * ks[6], q[455] * ks[7]);
        __builtin_nontemporal_store(o, (GAS v4u*)(dst + (size_t)(r0 + n) * K + k0 + 8 * c)); }
    LDS_WAIT(); asm volatile("" ::: "memory");
}
__device__ __forceinline__ void cvt_item8(const float* src, int ld, int c0, int k0, unsigned char* dst, int K, int r0, float scale, LAS float* scr, int lane) {
    const GAS float* s = (const GAS float*)src + (size_t)k0 * ld + c0;
    f32x4 v[16];
#pragma unroll
    for (int i = 0; i < 16; ++i) v[i] = __builtin_nontemporal_load((const GAS f32x4*)(s + (size_t)(4 * i + (lane >> 4)) * ld + 4 * (lane & 15)));
#pragma unroll
    for (int i = 0; i < 16; ++i) { LAS float* p = scr + (4 * i + (lane >> 4)) * 65 + 4 * (lane & 15); p[0] = v[i][0]; p[1] = v[i][1]; p[2] = v[i][2]; p[3] = v[i][3]; }
    LDS_WAIT(); asm volatile("" ::: "memory");
    const int c = lane & 3;
#pragma unroll
    for (int j = 0; j < 4; ++j) { const int n = (lane >> 2) + 16 * j; const LAS float* q = scr + (16 * c) * 65 + n;
        v4u o; o.x = pg8::pk4_fp8(q[0] * scale, q[65] * scale, q[130] * scale, q[195] * scale); o.y = pg8::pk4_fp8(q[260] * scale, q[325] * scale, q[390] * scale, q[455] * scale);
        o.z = pg8::pk4_fp8(q[520] * scale, q[585] * scale, q[650] * scale, q[715] * scale); o.w = pg8::pk4_fp8(q[780] * scale, q[845] * scale, q[910] * scale, q[975] * scale);
        __builtin_nontemporal_store(o, (GAS v4u*)(dst + (size_t)(r0 + n) * K + k0 + 16 * c)); }
    LDS_WAIT(); asm volatile("" ::: "memory");
}
constexpr int CV_DENSE = 16 * 40 + 256 + 16 * 88 + 44 * 16 + 16 * 48 + 32 + 32 + 256, CV_EXP = 8 * 16 * 112 + 8 * 56 * 16, CV_ALL = CV_DENSE + CV_EXP;
constexpr int CV_FIRST = 16 * 40;
constexpr int CV_GEMM1 = 160;
constexpr int CV_TAIL2 = 3072, CV_Q2 = 3072;
__device__ __forceinline__ void convert_weights(KPp p, LAS unsigned char* lds, int it_lo, int it_hi, int gw, int ngw, int lane, int wave) {
    LAS float* scr = (LAS float*)(lds + wave * 16640);
    unsigned char* ws = p->ws;
    constexpr int J0 = 16 * 40, J1 = 256, J2 = 16 * 88, J3 = 44 * 16, J4 = 16 * 48, J5 = 32, J6 = 32, J7 = 256, J8 = 8 * 16 * 112;
    for (int it = it_lo + gw; it < it_hi; it += ngw) {
        const float* src; int ld, c0, k0, K, r0; size_t dsto; float scale = 1.f; bool f8 = false; const float* ksc = nullptr;
        int r = it;
        if (r < J0) { const int kb = r / 40, nb = r % 40, n0 = nb * 64; src = p->in[I_L0WIN]; ld = N0SRC; c0 = n0 < 1536 ? n0 : n0 + 8; k0 = kb * 64; dsto = WS_W0IN; K = 1024; r0 = n0; }
        else if ((r -= J0) < J1) { const int kb = r / 16, nb = r % 16; src = p->in[I_L0WOUT]; ld = 1024; c0 = nb * 64; k0 = kb * 64; dsto = WS_W0OUT; K = 1024; r0 = nb * 64; }
        else if ((r -= J1) < J2) { const int kb = r / 88, nb = r % 88, n0 = nb * 64, pn = n0 >> 8, j = n0 & 255; src = j < 128 ? p->in[I_L0WG] : p->in[I_L0WU]; ld = DFF; c0 = 128 * pn + (j & 127); k0 = kb * 64; dsto = WS_W0GU; K = 1024; r0 = n0; ksc = p->in[I_L0N2G]; }
        else if ((r -= J2) < J3) { const int kb = r / 16, nb = r % 16; src = p->in[I_L0WD]; ld = 1024; c0 = nb * 64; k0 = kb * 64; dsto = WS_W0D; K = DFF; r0 = nb * 64; }
        else if ((r -= J3) < J4) { const int kb = r / 48, nb = r % 48; src = p->in[I_L1WIN]; ld = N1SRC; c0 = nb * 64; k0 = kb * 64; dsto = WS_W1IN; K = 1024; r0 = nb * 64; }
        else if ((r -= J4) < J5) { const int h = r >> 2, kb = (r >> 1) & 1, nb = r & 1; src = p->in[I_L1WQ] + (size_t)h * 16384; ld = 128; c0 = nb * 64; k0 = kb * 64; dsto = WS_WQ + (size_t)h * 32768; K = 128; r0 = nb * 64; }
        else if ((r -= J5) < J6) { const int h = r >> 2, kb = (r >> 1) & 1, nb = r & 1; src = p->in[I_L1WK] + (size_t)h * 16384; ld = 128; c0 = nb * 64; k0 = kb * 64; dsto = WS_WK + (size_t)h * 32768; K = 128; r0 = nb * 64; scale = 0.08838834764831845f; }
        else if ((r -= J6) < J7) { const int kb = r / 16, nb = r % 16; src = p->in[I_L1WOUT]; ld = 1024; c0 = nb * 64; k0 = kb * 64; dsto = WS_W1OUT; K = 1024; r0 = nb * 64; }
        else if ((r -= J7) < J8) { const int e = r / (16 * 112), q = r % (16 * 112), kb = q / 112, nb = q % 112, n0 = nb * 64, pn = n0 >> 8, j = n0 & 255;
            src = (j < 128 ? p->in[I_L1EG] : p->in[I_L1EU]) + (size_t)e * 1024 * DFFE; ld = DFFE; c0 = 128 * pn + (j & 127); k0 = kb * 64; dsto = WS_EGU8 + (size_t)e * 7168 * 1024; K = 1024; r0 = n0; f8 = true; scale = 32.f; }
        else { r -= J8; const int e = r / (56 * 16), q = r % (56 * 16), kb = q / 16, nb = q % 16;
            src = p->in[I_L1ED] + (size_t)e * DFFE * 1024; ld = 1024; c0 = nb * 64; k0 = kb * 64; dsto = WS_ED8 + (size_t)e * 1024 * DFFE; K = DFFE; r0 = nb * 64; f8 = true; scale = 64.f; }
        if (f8) cvt_item8(src, ld, c0, k0, ws + dsto, K, r0, scale, scr, lane);
        else cvt_item(src, ld, c0, k0, (bf16*)(ws + dsto), K, r0, scale, scr, lane, ksc);
    }
}

__device__ __forceinline__ void convert_queue(KPp p, LAS unsigned char* lds, unsigned* ctr, int it_lo, int n, int tid, int lane, int wave) {
    LAS int* slot = (LAS int*)(lds + 135168);
    int nxt = 0; if (tid == 0) nxt = (int)atomicAdd(ctr, 8u);
    for (;;) {
        if (tid == 0) slot[0] = nxt;
        __syncthreads();
        const int base = slot[0];
        __syncthreads();
        if (base >= n) break;
        if (tid == 0) nxt = (int)atomicAdd(ctr, 8u);
        if (base + wave < n) convert_weights(p, lds, it_lo + base + wave, it_lo + base + wave + 1, 0, 1, lane, wave);
    }
}

template <int MODE, bool SRCB, bool CVT0 = false> __device__ __forceinline__ void norm_phase(KPp p, LAS unsigned char* lds, int tid, int lane, int wave, const void* src, const float* gain, bf16* dst) {
    constexpr int NC = MODE == 0 ? 0 : (MODE == 2 ? 16 : 8);
    unsigned char* ws = p->ws;
    LAS float* wt = (LAS float*)lds;
    LAS float* gt = (LAS float*)(lds + 65536);
    LAS int* et = (LAS int*)(lds + 65536 + 4096);
    LAS int* lr = et + 128; LAS float* gl = (LAS float*)(et + 256); LAS int* eb = et + 384;
    LAS unsigned char* rc = lds + 73728;
    v4u cb[4][2], nb[4][2]; f32x4 cf[4][2][2], nf[4][2][2];
#define NP_LOAD(RB, RF, BLK, BT) do { const int row0_ = (BLK) * 64 + wave * 8 + (BT) * 4; \
        _Pragma("unroll") for (int r_ = 0; r_ < 4; ++r_) _Pragma("unroll") for (int j_ = 0; j_ < 2; ++j_) { \
            if (SRCB) RB[r_][j_] = *(const GAS v4u*)((const bf16*)src + (size_t)(row0_ + r_) * DMODEL + 8 * lane + 512 * j_); \
            else { const GAS f32x4* xr_ = (const GAS f32x4*)((const float*)src + (size_t)(row0_ + r_) * DMODEL + 8 * lane + 512 * j_); RF[r_][j_][0] = xr_[0]; RF[r_][j_][1] = xr_[1]; } } } while (0)
    if ((int)blockIdx.x < MROWS / 64) NP_LOAD(cb, cf, (int)blockIdx.x, 0);
    float g[2][8];
#pragma unroll
    for (int j = 0; j < 2; ++j) { const f32x4 a = *(const GAS f32x4*)(gain + 8 * lane + 512 * j), c = *(const GAS f32x4*)(gain + 8 * lane + 512 * j + 4);
        g[j][0] = a[0]; g[j][1] = a[1]; g[j][2] = a[2]; g[j][3] = a[3]; g[j][4] = c[0]; g[j][5] = c[1]; g[j][6] = c[2]; g[j][7] = c[3]; }
    const float hb0 = MODE == 1 ? p->in[I_L0BF][wave] : (MODE == 2 ? p->in[I_L1BI][wave] : 0.f), hb1 = MODE == 2 ? p->in[I_L1BF][wave] : 0.f;
    if (CVT0) { const int G_ = gridDim.x; convert_weights(p, lds, 0, (G_ == 256 ? CV_FIRST : CV_ALL), blockIdx.x * NWAVES + wave, G_ * NWAVES, lane, wave); __syncthreads(); }
    if (NC) {
        const float* wsrc = MODE == 1 ? p->in[I_L0WIN] + 1536 : MODE == 2 ? p->in[I_L1WIN] + 3072 : p->in[I_L1RT];
        const int wld = MODE == 1 ? N0SRC : MODE == 2 ? N1SRC : 8;
#pragma unroll
        for (int it = 0; it < 1024 * (NC / 4) / NTHR; ++it) { const int i_ = tid + NTHR * it, k = i_ / (NC / 4), c4 = i_ % (NC / 4);
            const f32x4 w = *(const GAS f32x4*)(wsrc + (size_t)k * wld + 4 * c4);
            wt[(4 * c4 + 0) * 1024 + k] = w[0]; wt[(4 * c4 + 1) * 1024 + k] = w[1]; wt[(4 * c4 + 2) * 1024 + k] = w[2]; wt[(4 * c4 + 3) * 1024 + k] = w[3]; }
        __syncthreads();
    }
    for (int blk = blockIdx.x; blk < MROWS / 64; blk += gridDim.x) {
#pragma unroll 1
        for (int bt = 0; bt < 2; ++bt) {
            const int rl0 = wave * 8 + bt * 4;
            { const int nblk = bt ? blk + (int)gridDim.x : blk; if (nblk < MROWS / 64) NP_LOAD(nb, nf, nblk, bt ^ 1); }
            float v[4][2][8];
#pragma unroll
            for (int r = 0; r < 4; ++r) { const int row = blk * 64 + rl0 + r; float ss = 0.f;
#pragma unroll
                for (int j = 0; j < 2; ++j) {
                    if (SRCB) { const v4u x = cb[r][j];
                        v[r][j][0] = bflo(x.x); v[r][j][1] = bfhi(x.x); v[r][j][2] = bflo(x.y); v[r][j][3] = bfhi(x.y); v[r][j][4] = bflo(x.z); v[r][j][5] = bfhi(x.z); v[r][j][6] = bflo(x.w); v[r][j][7] = bfhi(x.w); }
                    else { const f32x4 a = cf[r][j][0], c = cf[r][j][1];
                        v[r][j][0] = a[0]; v[r][j][1] = a[1]; v[r][j][2] = a[2]; v[r][j][3] = a[3]; v[r][j][4] = c[0]; v[r][j][5] = c[1]; v[r][j][6] = c[2]; v[r][j][7] = c[3]; }
#pragma unroll
                    for (int e = 0; e < 8; ++e) ss += v[r][j][e] * v[r][j][e]; }
                const float rstd = rsqrtf(wave_sum(ss) * (1.f / DMODEL) + EPS);
#pragma unroll
                for (int j = 0; j < 2; ++j) {
#pragma unroll
                    for (int e = 0; e < 8; ++e) v[r][j][e] = v[r][j][e] * rstd * g[j][e];
                    v4u o; o.x = pk2(v[r][j][0], v[r][j][1]); o.y = pk2(v[r][j][2], v[r][j][3]); o.z = pk2(v[r][j][4], v[r][j][5]); o.w = pk2(v[r][j][6], v[r][j][7]);
                    if (MODE != 3) *(GAS v4u*)(dst + (size_t)row * DMODEL + 8 * lane + 512 * j) = o;
                    else { typedef unsigned u32x2 __attribute__((ext_vector_type(2))); *(LAS u32x2*)(rc + (rl0 + r) * 1024 + 8 * lane + 512 * j) = (u32x2){pg8::pk4_fp8(4.f * v[r][j][0], 4.f * v[r][j][1], 4.f * v[r][j][2], 4.f * v[r][j][3]), pg8::pk4_fp8(4.f * v[r][j][4], 4.f * v[r][j][5], 4.f * v[r][j][6], 4.f * v[r][j][7])}; } } }
            if (NC) {
                constexpr int NP = 4 * (NC ? NC : 1);
                float pt[NP];
#pragma unroll
                for (int c = 0; c < NC; ++c) {
                    f32x4 w[2][2];
#pragma unroll
                    for (int j = 0; j < 2; ++j) { w[j][0] = *(const LAS f32x4*)(wt + c * 1024 + 8 * lane + 512 * j); w[j][1] = *(const LAS f32x4*)(wt + c * 1024 + 8 * lane + 512 * j + 4); }
#pragma unroll
                    for (int r = 0; r < 4; ++r) { float s = 0.f;
#pragma unroll
                        for (int j = 0; j < 2; ++j) s += (v[r][j][0] * w[j][0][0] + v[r][j][1] * w[j][0][1]) + (v[r][j][2] * w[j][0][2] + v[r][j][3] * w[j][0][3]) + (v[r][j][4] * w[j][1][0] + v[r][j][5] * w[j][1][1]) + (v[r][j][6] * w[j][1][2] + v[r][j][7] * w[j][1][3]);
                        pt[r * NC + c] = s; } }
                if (NP == 32) {
#pragma unroll
                    for (int i = 0; i < NP; ++i) pt[i] += __shfl_xor(pt[i], 32); }
#pragma unroll
                for (int hh = NP / 2, mask = (NP == 64 ? 32 : 16); hh >= 1; hh >>= 1, mask >>= 1) { const bool up = (lane & mask) != 0;
#pragma unroll
                    for (int i = 0; i < hh; ++i) { const float keep = up ? pt[i + hh] : pt[i], send = up ? pt[i] : pt[i + hh]; pt[i] = keep + __shfl_xor(send, mask); } }
                const int pi = lane & (NP - 1);
                if (lane < NP) gt[(rl0 + pi / NC) * 16 + (pi % NC)] = pt[0];
            }
#pragma unroll
            for (int r = 0; r < 4; ++r)
#pragma unroll
                for (int j = 0; j < 2; ++j) { if (SRCB) cb[r][j] = nb[r][j]; else { cf[r][j][0] = nf[r][j][0]; cf[r][j][1] = nf[r][j][1]; } }
        }
        if (MODE == 3) {
            __syncthreads();
            if (wave == 0) { float a[8];
#pragma unroll
                for (int c = 0; c < 8; ++c) a[c] = gt[lane * 16 + c];
                int e1 = 0; float l1 = a[0];
#pragma unroll
                for (int c = 1; c < 8; ++c) if (a[c] > l1) { l1 = a[c]; e1 = c; }
                int e2 = -1; float l2 = -INFINITY;
#pragma unroll
                for (int c = 0; c < 8; ++c) if (c != e1 && a[c] > l2) { l2 = a[c]; e2 = c; }
                const float g1 = 1.f / (1.f + expf(l2 - l1)), g2 = 1.f - g1;
                int r1 = 0, r2 = 0, mycnt = 0;
#pragma unroll
                for (int e = 0; e < 8; ++e) { const unsigned long long m = __ballot(e1 == e || e2 == e);
                    const int before = (int)__builtin_amdgcn_mbcnt_hi((unsigned)(m >> 32), __builtin_amdgcn_mbcnt_lo((unsigned)m, 0u));
                    if (e1 == e) r1 = before; if (e2 == e) r2 = before; if (lane == e) mycnt = __popcll(m); }
                et[lane * 2] = e1; et[lane * 2 + 1] = e2; gl[lane * 2] = g1; gl[lane * 2 + 1] = g2; lr[lane * 2] = r1; lr[lane * 2 + 1] = r2;
                if (lane < 8) eb[lane] = (int)atomicAdd((unsigned*)(ws + WS_CTL) + CW_CNT + 32 * lane, (unsigned)mycnt); }
        }
        if (NC) {
            __syncthreads();
            const int row = blk * 64 + lane, h = wave;
            if (MODE == 1) {
                const float lf = log_sigmoid(gt[lane * 16 + h] + hb0); const float cs = scan_add(lf, lane);
                ((float*)(ws + WS_FLOC0))[((size_t)(row / SEQ) * 8 + h) * SEQ + (row % SEQ)] = cs;     if (lane == 63) ((float*)(ws + WS_FTOT0))[blk * 8 + h] = cs;
            } else if (MODE == 2) {
                const float li = gt[lane * 16 + h] + hb0; const float lf = log_sigmoid(gt[lane * 16 + 8 + h] + hb1); const float cs = scan_add(lf, lane);
                ((float*)(ws + WS_FLOC1))[row * 8 + h] = cs; ((float*)(ws + WS_IG1))[row * 8 + h] = li;
                const float gm = wave_max(li - cs);
                if (lane == 63) { ((float*)(ws + WS_FTOT1))[blk * 8 + h] = cs; ((float*)(ws + WS_GMAX1))[blk * 8 + h] = gm; }
            } else if (MODE == 3) {
                int srv = 0;
                if (lane < 16) { const int q_ = wave * 16 + lane, e_ = et[q_]; srv = e_ * 16384 + eb[e_] + lr[q_];
                    ((int*)(ws + WS_TOKS))[blk * 128 + q_] = srv; ((float*)(ws + WS_SGATE2))[srv] = gl[q_]; }
#pragma unroll
                for (int rr = 0; rr < 8; ++rr) { const int rl = wave * 8 + rr; const v4u rowv = *(const LAS v4u*)(rc + rl * 1024 + lane * 16);
#pragma unroll
                    for (int k = 0; k < 2; ++k) { const int sr = __builtin_amdgcn_readlane(srv, rr * 2 + k);
                        *(GAS v4u*)(ws + WS_AG8 + (size_t)sr * 1024 + lane * 16) = rowv; } }
            }
            __syncthreads();
        }
    }
}

__device__ __forceinline__ void final_phase(KPp p, int lane, int wave) {
    unsigned char* ws = p->ws; const bf16* Y = (const bf16*)(ws + WS_Y); const bf16* X = (const bf16*)(ws + WS_X);
    float g[2][8];
#pragma unroll
    for (int j = 0; j < 2; ++j) { const f32x4 a = *(const GAS f32x4*)(p->in[I_FNG] + 8 * lane + 512 * j), c = *(const GAS f32x4*)(p->in[I_FNG] + 8 * lane + 512 * j + 4);
        g[j][0] = a[0]; g[j][1] = a[1]; g[j][2] = a[2]; g[j][3] = a[3]; g[j][4] = c[0]; g[j][5] = c[1]; g[j][6] = c[2]; g[j][7] = c[3]; }
    int ct[8]; { int acc = 0;
#pragma unroll
        for (int e = 0; e < 8; ++e) { ct[e] = acc; acc += (int)((((const unsigned*)(ws + WS_CTL))[CW_CNT + 32 * e] + 255) >> 8); } }
    int nr1 = 0, nr2 = 0; { const int row0_ = blockIdx.x * NWAVES + wave; if (row0_ < MROWS) { nr1 = ((const int*)(ws + WS_TOKS))[row0_ * 2]; nr2 = ((const int*)(ws + WS_TOKS))[row0_ * 2 + 1]; } }
    for (int row = blockIdx.x * NWAVES + wave; row < MROWS; row += gridDim.x * NWAVES) {
        const int r1 = nr1, r2 = nr2;
        { const int nrow_ = row + gridDim.x * NWAVES; if (nrow_ < MROWS) { nr1 = ((const int*)(ws + WS_TOKS))[nrow_ * 2]; nr2 = ((const int*)(ws + WS_TOKS))[nrow_ * 2 + 1]; } }
        int c1 = 0, c2 = 0;
#pragma unroll
        for (int k = 1; k < 8; ++k) { if ((r1 >> 14) >= k) c1 = ct[k]; if ((r2 >> 14) >= k) c2 = ct[k]; }
        const int s1 = c1 * 256 + (r1 & 16383), s2 = c2 * 256 + (r2 & 16383);
        float v[2][8]; float ss = 0.f; const bf16* YS = (const bf16*)(ws + WS_YS);
#pragma unroll
        for (int j = 0; j < 2; ++j) { const int c0 = 8 * lane + 512 * j; const v4u zz = {0u, 0u, 0u, 0u}; const v4u x = *(const GAS v4u*)(X + (size_t)row * DMODEL + c0), y1 = s1 < 32768 ? *(const GAS v4u*)(Y + (size_t)s1 * DMODEL + c0) : zz, y2 = s2 < 32768 ? *(const GAS v4u*)(Y + (size_t)s2 * DMODEL + c0) : zz;
            v[j][0] = bflo(x.x) + bflo(y1.x) + bflo(y2.x); v[j][1] = bfhi(x.x) + bfhi(y1.x) + bfhi(y2.x); v[j][2] = bflo(x.y) + bflo(y1.y) + bflo(y2.y); v[j][3] = bfhi(x.y) + bfhi(y1.y) + bfhi(y2.y);
            v[j][4] = bflo(x.z) + bflo(y1.z) + bflo(y2.z); v[j][5] = bfhi(x.z) + bfhi(y1.z) + bfhi(y2.z); v[j][6] = bflo(x.w) + bflo(y1.w) + bflo(y2.w); v[j][7] = bfhi(x.w) + bfhi(y1.w) + bfhi(y2.w);
#pragma unroll
            for (int q = 0; q < 2; ++q) { const int sq = q ? s2 : s1; if (sq >= 32768) {
                for (int ks = 0; ks < 7; ++ks) { const v4u y = *(const GAS v4u*)(YS + ((size_t)ks * 2048 + (sq - 32768)) * DMODEL + c0);
                    v[j][0] += bflo(y.x); v[j][1] += bfhi(y.x); v[j][2] += bflo(y.y); v[j][3] += bfhi(y.y); v[j][4] += bflo(y.z); v[j][5] += bfhi(y.z); v[j][6] += bflo(y.w); v[j][7] += bfhi(y.w); } } }
#pragma unroll
            for (int e = 0; e < 8; ++e) ss += v[j][e] * v[j][e]; }
        const float rstd = rsqrtf(wave_sum(ss) * (1.f / DMODEL) + EPS);
#pragma unroll
        for (int j = 0; j < 2; ++j) { GAS f32x4* o = (GAS f32x4*)(p->out + (size_t)row * DMODEL + 8 * lane + 512 * j);
            o[0] = (f32x4){v[j][0] * rstd * g[j][0], v[j][1] * rstd * g[j][1], v[j][2] * rstd * g[j][2], v[j][3] * rstd * g[j][3]};
            o[1] = (f32x4){v[j][4] * rstd * g[j][4], v[j][5] * rstd * g[j][5], v[j][6] * rstd * g[j][6], v[j][7] * rstd * g[j][7]}; }
    }
}

__device__ __forceinline__ float fast_sigmoid(float z) { return __builtin_amdgcn_rcpf(1.0f + __builtin_amdgcn_exp2f(-1.4426950408889634f * z)); }
__device__ __forceinline__ void conv_phase(KPp p, LAS unsigned char* lds, int tid, int lane, int wave) {
    unsigned char* ws = p->ws; const bf16* P0 = (const bf16*)(ws + WS_R); bf16* CAT = (bf16*)(ws + WS_CAT);
    LAS bf16* ub = (LAS bf16*)lds;
    LAS float* yt = (LAS float*)(lds + 96256);
    const int c = tid;
    float w[31]; float bias = 0.f; f32x4 ga = {}, gb = {}, ba = {}, bb = {}; bool first = true;
#pragma unroll
    for (int j = 0; j < 31; ++j) w[j] = 0.f;
    for (int u = blockIdx.x; u < MROWS / 64; u += gridDim.x) {
        const int row0 = u * 64, b = row0 / SEQ, t0 = row0 % SEQ;
        {
            v4u av[12], gv[12];
#pragma unroll
            for (int i = 0; i < 12; ++i) { const int q = tid + NTHR * i, r = q >> 6, ch = q & 63, t = t0 - 30 + r; av[i] = (v4u){0u, 0u, 0u, 0u}; gv[i] = av[i];
                if (r < 94 && t >= 0) { const bf16* s = P0 + (size_t)(b * SEQ + t) * N0 + 1536 + 8 * ch; av[i] = *(const GAS v4u*)s; gv[i] = *(const GAS v4u*)(s + 512); } }
            if (first) { first = false; asm volatile("" ::: "memory");
#pragma unroll
                for (int j = 0; j < 31; ++j) w[j] = p->in[I_L0DWW][j * 512 + c];
                bias = p->in[I_L0DWB][c];
                ga = *(const GAS f32x4*)(p->in[I_L0CLNG] + lane * 8); gb = *(const GAS f32x4*)(p->in[I_L0CLNG] + lane * 8 + 4); ba = *(const GAS f32x4*)(p->in[I_L0CLNB] + lane * 8); bb = *(const GAS f32x4*)(p->in[I_L0CLNB] + lane * 8 + 4); }
#pragma unroll
            for (int i = 0; i < 12; ++i) { const int q = tid + NTHR * i, r = q >> 6, ch = q & 63;
                if (r < 94) { v4u o;
                    o.x = pk2(bflo(av[i].x) * fast_sigmoid(bflo(gv[i].x)), bfhi(av[i].x) * fast_sigmoid(bfhi(gv[i].x))); o.y = pk2(bflo(av[i].y) * fast_sigmoid(bflo(gv[i].y)), bfhi(av[i].y) * fast_sigmoid(bfhi(gv[i].y)));
                    o.z = pk2(bflo(av[i].z) * fast_sigmoid(bflo(gv[i].z)), bfhi(av[i].z) * fast_sigmoid(bfhi(gv[i].z))); o.w = pk2(bflo(av[i].w) * fast_sigmoid(bflo(gv[i].w)), bfhi(av[i].w) * fast_sigmoid(bfhi(gv[i].w)));
                    *(LAS v4u*)(ub + r * 512 + 8 * ch) = o; } }
        }
        __syncthreads();
        for (int sub = 0; sub < 4; ++sub) {
            float y[16];
#pragma unroll
            for (int i = 0; i < 16; ++i) y[i] = bias;
            const LAS bf16* ucol = ub + (sub * 16) * 512 + c;
#pragma unroll
            for (int r = 0; r < 46; ++r) { const float uv = bf2f(ucol[r * 512]);
#pragma unroll
                for (int i = 0; i < 16; ++i) { const int j = r - i; if (j >= 0 && j <= 30) y[i] += w[j] * uv; } }
#pragma unroll
            for (int i = 0; i < 16; ++i) yt[i * 512 + c] = y[i];
            __syncthreads();
#pragma unroll
            for (int k = 0; k < 2; ++k) { const int i = wave * 2 + k;
                const f32x4 v0 = *(const LAS f32x4*)(yt + i * 512 + lane * 8), v1 = *(const LAS f32x4*)(yt + i * 512 + lane * 8 + 4);
                const float mu = wave_sum((v0[0] + v0[1]) + (v0[2] + v0[3]) + (v1[0] + v1[1]) + (v1[2] + v1[3])) * (1.f / 512.f);
                const f32x4 d0 = v0 - mu, d1 = v1 - mu;
                const float var = wave_sum((d0[0] * d0[0] + d0[1] * d0[1]) + (d0[2] * d0[2] + d0[3] * d0[3]) + (d1[0] * d1[0] + d1[1] * d1[1]) + (d1[2] * d1[2] + d1[3] * d1[3])) * (1.f / 512.f);
                const float rstd = rsqrtf(var + EPS);
                f32x4 o0 = d0 * rstd * ga + ba, o1 = d1 * rstd * gb + bb;
#pragma unroll
                for (int e = 0; e < 4; ++e) { o0[e] = o0[e] * fast_sigmoid(o0[e]); o1[e] = o1[e] * fast_sigmoid(o1[e]); }
                v4u o; o.x = pk2(o0[0], o0[1]); o.y = pk2(o0[2], o0[3]); o.z = pk2(o1[0], o1[1]); o.w = pk2(o1[2], o1[3]);
                *(GAS v4u*)(CAT + (size_t)(row0 + sub * 16 + i) * 1024 + 512 + lane * 8) = o; }
            __syncthreads();
        }
    }
}
namespace ml {
typedef float f32x16 __attribute__((ext_vector_type(16)));
typedef short s16x4 __attribute__((ext_vector_type(4)));
typedef unsigned u32x2 __attribute__((ext_vector_type(2)));
constexpr int LD = 136, LDV = 160, LDK = 160, LDP = 72, LDH = 132;
constexpr int O_QL = 0, O_KL = 17408, O_KP = 34816, O_VL = 55296, O_PL = 75776, O_SL = 93184, O_TB = 136704;
constexpr int O_PLB = 75776, O_HSB = 84992, O_SLB = 102400, O_TBB = 145920;
constexpr int T_FPRE = 0, T_MST = 128, T_G2 = 272, T_M2 = 336, T_WI = 400, T_EDM = 464, T_NQ = 528, T_WS = 592, T_CW = 656, T_HG = 1296, T_END = 1296 + 128, T_DB2 = T_END;
static_assert(O_TB + T_END * 4 <= SCR_BYTES && O_TBB + (T_DB2 + 320) * 4 <= SCR_BYTES, "mlstm lds");
__device__ __forceinline__ f32x16 mfma32(bf16x8 a, bf16x8 b, f32x16 c) { return __builtin_amdgcn_mfma_f32_32x32x16_bf16(a, b, c, 0, 0, 0); }
__device__ __forceinline__ const LAS bf16* tr_lane(const LAS bf16* X, int ldx, int lane) { const int g4 = lane >> 4, hh = g4 >> 1, cg = g4 & 1, i = lane & 15, q = i >> 2, pp = i & 3; return X + (8 * hh + q) * ldx + 16 * cg + 4 * pp; }
__device__ __forceinline__ bf16x8 tr_frag(const LAS bf16* a, int ldx, int off) {
    const s16x4 lo = __builtin_bit_cast(s16x4, __builtin_amdgcn_ds_read_tr16_b64_v4i16((LAS s16x4*)(a + off)));
    const s16x4 hi = __builtin_bit_cast(s16x4, __builtin_amdgcn_ds_read_tr16_b64_v4i16((LAS s16x4*)(a + off + 4 * ldx)));
    return (bf16x8){lo[0], lo[1], lo[2], lo[3], hi[0], hi[1], hi[2], hi[3]};
}
#define ML_BAR() asm volatile("s_waitcnt lgkmcnt(0)\n\ts_barrier" ::: "memory")
#define ML_LAUNDER(ptr) asm volatile("" : "+v"(ptr))
__device__ __forceinline__ f32x16 mma_nt8(f32x16 acc, const LAS bf16* a, const LAS bf16* b) {
#pragma unroll
    for (int ks = 0; ks < 8; ++ks) acc = mfma32(*(const LAS bf16x8*)(a + 16 * ks), *(const LAS bf16x8*)(b + 16 * ks), acc);
    return acc;
}
__device__ __forceinline__ void st4(LAS bf16* d, float a, float b, float c, float e) { *(LAS u32x2*)d = (u32x2){pk2(a, b), pk2(c, e)}; }
__device__ __forceinline__ void gate_setup(const unsigned char* ws, LAS float* tb, int b, int h, int lane, int wave) {
    if (wave == 0) {
        const float* ft = (const float*)(ws + WS_FTOT1); const float* gm = (const float*)(ws + WS_GMAX1);
        const float a0 = ft[(b * 128 + lane) * 8 + h], a1 = ft[(b * 128 + 64 + lane) * 8 + h];
        const float s0 = scan_add(a0, lane), s1 = scan_add(a1, lane) + __shfl(s0, 63);
        const float f0 = s0 - a0, f1 = s1 - a1;
        tb[T_FPRE + lane] = f0; tb[T_FPRE + 64 + lane] = f1;
        const float m0 = scan_max(gm[(b * 128 + lane) * 8 + h] - f0, lane); const float m1 = fmaxf(scan_max(gm[(b * 128 + 64 + lane) * 8 + h] - f1, lane), __shfl(m0, 63));
        tb[T_MST + 1 + lane] = fmaxf(m0, 0.f); tb[T_MST + 65 + lane] = fmaxf(m1, 0.f); if (lane == 0) tb[T_MST] = 0.f;
    }
}
__device__ __forceinline__ void unpack16(const v4u x0, const v4u x1, float (&f)[16]) {
    f[0] = bflo(x0.x); f[1] = bfhi(x0.x); f[2] = bflo(x0.y); f[3] = bfhi(x0.y); f[4] = bflo(x0.z); f[5] = bfhi(x0.z); f[6] = bflo(x0.w); f[7] = bfhi(x0.w);
    f[8] = bflo(x1.x); f[9] = bfhi(x1.x); f[10] = bflo(x1.y); f[11] = bfhi(x1.y); f[12] = bflo(x1.z); f[13] = bfhi(x1.z); f[14] = bflo(x1.w); f[15] = bfhi(x1.w);
}
__device__ __forceinline__ void pack16(const float (&f)[16], v4u& x0, v4u& x1) {
    x0.x = pk2(f[0], f[1]); x0.y = pk2(f[2], f[3]); x0.z = pk2(f[4], f[5]); x0.w = pk2(f[6], f[7]); x1.x = pk2(f[8], f[9]); x1.y = pk2(f[10], f[11]); x1.z = pk2(f[12], f[13]); x1.w = pk2(f[14], f[15]);
}

__device__ __forceinline__ void pass_a(KPp p, LAS unsigned char* lds, int tid, int lane, int wave) {
    unsigned char* ws = p->ws;
    const bf16* P1 = (const bf16*)(ws + WS_R); bf16* Q1 = (bf16*)(ws + WS_Q1); bf16* K1 = (bf16*)(ws + WS_K1); float* TST = (float*)(ws + WS_TST);
    const float* FLOC1 = (const float*)(ws + WS_FLOC1); const float* IG1 = (const float*)(ws + WS_IG1);
    LAS bf16* Ql = (LAS bf16*)(lds + O_QL); LAS bf16* Kl = (LAS bf16*)(lds + O_KL); LAS bf16* Kp = (LAS bf16*)(lds + O_KP); LAS bf16* Vl = (LAS bf16*)(lds + O_VL); LAS bf16* Ul = (LAS bf16*)(lds + O_PL);
    LAS bf16* Xl0 = (LAS bf16*)(lds + O_SL);
    LAS float* tb = (LAS float*)(lds + O_TB);
    const int r = lane & 31, hh = lane >> 5, vtile = wave & 3, kt0 = 2 * (wave >> 2), t = tid >> 3, dg = tid & 7;
    const unsigned voffX = (unsigned)(t * N1 + 16 * dg), voffQ = (unsigned)(t * 1024 + 16 * dg), voffG = (unsigned)(t * 8);
    const LAS bf16* const trV = tr_lane(Vl, LDV, lane); const LAS bf16* const trK = tr_lane(Kp, LDK, lane);
#define ML_XLOAD(cidx, x0_, x1_, h0_, h1_) do { const bf16* xs_ = P1 + ((size_t)b * SEQ + (size_t)(cidx) * 64) * N1 + h * 128; x0_ = *(const GAS v4u*)(xs_ + voffX); x1_ = *(const GAS v4u*)(xs_ + voffX + 8); \
        h0_ = (v4u){0u, 0u, 0u, 0u}; h1_ = h0_; if (t < 3 && (cidx) > 0) { const bf16* hs_ = xs_ - (size_t)3 * N1; h0_ = *(const GAS v4u*)(hs_ + voffX); h1_ = *(const GAS v4u*)(hs_ + voffX + 8); } } while (0)
#define ML_XSTORE(xb, x0_, x1_, h0_, h1_) do { *(LAS v4u*)((xb) + (t + 3) * LD + 16 * dg) = x0_; *(LAS v4u*)((xb) + (t + 3) * LD + 16 * dg + 8) = x1_; \
        if (t < 3) { *(LAS v4u*)((xb) + t * LD + 16 * dg) = h0_; *(LAS v4u*)((xb) + t * LD + 16 * dg + 8) = h1_; } } while (0)
    for (int unit = blockIdx.x; unit < 256; unit += gridDim.x) {
        const int b = unit >> 7, h = (unit >> 4) & 7, j = unit & 15;
        { v4u x0, x1, h0, h1; ML_XLOAD(8 * j, x0, x1, h0, h1); ML_XSTORE(Xl0, x0, x1, h0, h1); }
        gate_setup(ws, tb, b, h, lane, wave);
        for (int idx = tid; idx < 640; idx += NTHR) { const int jj = idx >> 7, d = idx & 127; tb[T_CW + idx] = jj < 4 ? p->in[I_L1CW][jj * 1024 + h * 128 + d] : p->in[I_L1CB][h * 128 + d]; }
        *(LAS u32x2*)(Vl + t * LDV + 128 + 4 * dg) = (u32x2){dg == 0 ? 0x3F80u : 0u, 0u};
        bf16x8 wf[8];
        { const bf16* wsrc = (const bf16*)(ws + (wave < 4 ? WS_WQ : WS_WK)) + (size_t)(h * 128 + (wave & 3) * 32 + r) * 128 + 8 * hh;
#pragma unroll
          for (int ks = 0; ks < 8; ++ks) wf[ks] = *(const GAS bf16x8*)(wsrc + 16 * ks); }
        f32x16 aT0 = {}, aT1 = {}, aN = {};
        ML_BAR();
        const float Mend = tb[T_MST + 8 * j + 8];
#pragma unroll 1
        for (int cc = 0; cc < 8; ++cc) {
            const int c = 8 * j + cc; const size_t row0 = (size_t)b * SEQ + c * 64;
            const LAS bf16* Xl = Xl0 + (cc & 1) * (67 * LD); LAS bf16* Xn = Xl0 + ((cc & 1) ^ 1) * (67 * LD);
            const LAS bf16* tV = trV; const LAS bf16* tK = trK; ML_LAUNDER(tV); ML_LAUNDER(tK);
            const LAS bf16* tVv = tV + vtile * 32; const LAS bf16* tKk = tK + kt0 * 32; const LAS bf16* tKw = tK + wave * 32;
            {
                const bf16* vs = P1 + row0 * N1 + 1024 + h * 128; const v4u v0 = *(const GAS v4u*)(vs + voffX), v1 = *(const GAS v4u*)(vs + voffX + 8);
                const float gi = (IG1 + row0 * 8 + h)[voffG], fl = (FLOC1 + row0 * 8 + h)[voffG];
                float yv[16];
#pragma unroll
                for (int i = 0; i < 16; ++i) yv[i] = tb[T_CW + 512 + 16 * dg + i];
#pragma unroll
                for (int jj = 0; jj < 4; ++jj) { float xf[16]; unpack16(*(const LAS v4u*)(Xl + (t + jj) * LD + 16 * dg), *(const LAS v4u*)(Xl + (t + jj) * LD + 16 * dg + 8), xf);
#pragma unroll
                    for (int i = 0; i < 16; ++i) yv[i] += tb[T_CW + jj * 128 + 16 * dg + i] * xf[i]; }
#pragma unroll
                for (int i = 0; i < 16; ++i) yv[i] = yv[i] * fast_sigmoid(yv[i]);
                v4u u0, u1; pack16(yv, u0, u1); *(LAS v4u*)(Ul + t * LD + 16 * dg) = u0; *(LAS v4u*)(Ul + t * LD + 16 * dg + 8) = u1;
                *(LAS v4u*)(Vl + t * LDV + 16 * dg) = v0; *(LAS v4u*)(Vl + t * LDV + 16 * dg + 8) = v1;
                if (dg == 0) tb[T_WS + t] = expf(gi - (tb[T_FPRE + c] + fl) - Mend);
            }
            ML_BAR();
            {
                f32x16 a0 = {}, a1 = {}; const LAS bf16* ub = Ul + r * LD + 8 * hh; const int et = wave & 3;
#pragma unroll
                for (int ks = 0; ks < 8; ++ks) { a0 = mfma32(wf[ks], *(const LAS bf16x8*)(ub + 16 * ks), a0); a1 = mfma32(wf[ks], *(const LAS bf16x8*)(ub + 32 * LD + 16 * ks), a1); }
                if (wave < 4) {
#pragma unroll
                    for (int g = 0; g < 4; ++g) { const int e0 = et * 32 + 8 * g + 4 * hh;
                        st4(Ql + r * LD + e0, a0[4 * g], a0[4 * g + 1], a0[4 * g + 2], a0[4 * g + 3]); st4(Ql + (32 + r) * LD + e0, a1[4 * g], a1[4 * g + 1], a1[4 * g + 2], a1[4 * g + 3]); }
                } else { const float w0 = tb[T_WS + r], w1 = tb[T_WS + 32 + r];
#pragma unroll
                    for (int g = 0; g < 4; ++g) { const int e0 = et * 32 + 8 * g + 4 * hh;
                        st4(Kl + r * LD + e0, a0[4 * g], a0[4 * g + 1], a0[4 * g + 2], a0[4 * g + 3]); st4(Kl + (32 + r) * LD + e0, a1[4 * g], a1[4 * g + 1], a1[4 * g + 2], a1[4 * g + 3]);
                        st4(Kp + r * LDK + e0, a0[4 * g] * w0, a0[4 * g + 1] * w0, a0[4 * g + 2] * w0, a0[4 * g + 3] * w0); st4(Kp + (32 + r) * LDK + e0, a1[4 * g] * w1, a1[4 * g + 1] * w1, a1[4 * g + 2] * w1, a1[4 * g + 3] * w1); } }
            }
            ML_BAR();
            {
                v4u x0 = {}, x1 = {}, h0 = {}, h1 = {};
                if (cc < 7) ML_XLOAD(c + 1, x0, x1, h0, h1);
                bf16* qd = Q1 + row0 * 1024 + h * 128; bf16* kd = K1 + row0 * 1024 + h * 128;
                *(GAS v4u*)(qd + voffQ) = *(const LAS v4u*)(Ql + t * LD + 16 * dg); *(GAS v4u*)(qd + voffQ + 8) = *(const LAS v4u*)(Ql + t * LD + 16 * dg + 8);
                *(GAS v4u*)(kd + voffQ) = *(const LAS v4u*)(Kl + t * LD + 16 * dg); *(GAS v4u*)(kd + voffQ + 8) = *(const LAS v4u*)(Kl + t * LD + 16 * dg + 8);
#pragma unroll
                for (int ks = 0; ks < 4; ++ks) { const bf16x8 bv = tr_frag(tVv, LDV, 16 * ks * LDV), a0 = tr_frag(tKk, LDK, 16 * ks * LDK), a1 = tr_frag(tKk, LDK, 16 * ks * LDK + 32);
                    aT0 = mfma32(a0, bv, aT0); aT1 = mfma32(a1, bv, aT1); }
                if (wave < 4) {
#pragma unroll
                    for (int ks = 0; ks < 4; ++ks) { const bf16x8 bn = tr_frag(tV, LDV, 16 * ks * LDV + 128), a = tr_frag(tKw, LDK, 16 * ks * LDK); aN = mfma32(a, bn, aN); } }
                if (cc < 7) ML_XSTORE(Xn, x0, x1, h0, h1);
            }
            ML_BAR();
        }
        {
            bf16* T = (bf16*)TST + ((size_t)unit * 8 + wave) * (6 * 64 * 8) + lane * 8;
#pragma unroll
            for (int g = 0; g < 4; ++g) *(GAS v4u*)(T + g * 512) = (v4u){pk2(aT0[4 * g], aT0[4 * g + 1]), pk2(aT0[4 * g + 2], aT0[4 * g + 3]), pk2(aT1[4 * g], aT1[4 * g + 1]), pk2(aT1[4 * g + 2], aT1[4 * g + 3])};
            if (wave < 4) {
#pragma unroll
                for (int g = 0; g < 2; ++g) *(GAS v4u*)(T + (4 + g) * 512) = (v4u){pk2(aN[8 * g], aN[8 * g + 1]), pk2(aN[8 * g + 2], aN[8 * g + 3]), pk2(aN[8 * g + 4], aN[8 * g + 5]), pk2(aN[8 * g + 6], aN[8 * g + 7])}; }
        }
    }
#undef ML_XLOAD
#undef ML_XSTORE
}

__device__ __forceinline__ void pass_b(KPp p, LAS unsigned char* lds, int tid, int lane, int wave) {
    unsigned char* ws = p->ws;
    const bf16* P1 = (const bf16*)(ws + WS_R); const bf16* Q1 = (const bf16*)(ws + WS_Q1); const bf16* K1 = (const bf16*)(ws + WS_K1); const float* TST = (const float*)(ws + WS_TST); bf16* CAT = (bf16*)(ws + WS_CAT);
    const float* FLOC1 = (const float*)(ws + WS_FLOC1); const float* IG1 = (const float*)(ws + WS_IG1);
    LAS bf16* Ql = (LAS bf16*)(lds + O_QL); LAS bf16* Kl = (LAS bf16*)(lds + O_KL); LAS bf16* Kp = (LAS bf16*)(lds + O_KP); LAS bf16* Vl = (LAS bf16*)(lds + O_VL); LAS bf16* Pl = (LAS bf16*)(lds + O_PLB);
    LAS bf16* Sl = (LAS bf16*)(lds + O_SLB); LAS bf16* Hst = (LAS bf16*)(lds + O_HSB); LAS float* tb = (LAS float*)(lds + O_TBB);
    const int r = lane & 31, hh = lane >> 5, vth = wave >> 1, ttile = wave & 1, vtile = wave & 3, kt0 = 2 * (wave >> 2), t = tid >> 3, dg = tid & 7;
    const unsigned voffX = (unsigned)(t * N1 + 16 * dg), voffQ = (unsigned)(t * 1024 + 16 * dg), voffG = (unsigned)(t * 8);
    const LAS bf16* const trV = tr_lane(Vl, LDV, lane); const LAS bf16* const trK = tr_lane(Kp, LDK, lane);
    for (int u0 = blockIdx.x; u0 < 256; u0 += gridDim.x) {
        const int unit = gridDim.x == 256 ? (((u0 & 7) * 2 + (u0 >> 7)) * 16 + ((u0 >> 3) & 15)) : u0;
        const int b = unit >> 7, h = (unit >> 4) & 7, j = unit & 15;
        v4u nq0, nq1, nk0, nk1, nv0, nv1; float ngi, nfl, ngil = 0.f, nfll = 0.f;
#define ML_LOAD_B(cidx) do { const size_t rw_ = (size_t)b * SEQ + (size_t)(cidx) * 64; const bf16* qs_ = Q1 + rw_ * 1024 + h * 128; const bf16* ks2_ = K1 + rw_ * 1024 + h * 128; const bf16* vs_ = P1 + rw_ * N1 + 1024 + h * 128; \
            nq0 = *(const GAS v4u*)(qs_ + voffQ); nq1 = *(const GAS v4u*)(qs_ + voffQ + 8); nk0 = *(const GAS v4u*)(ks2_ + voffQ); nk1 = *(const GAS v4u*)(ks2_ + voffQ + 8); nv0 = *(const GAS v4u*)(vs_ + voffX); nv1 = *(const GAS v4u*)(vs_ + voffX + 8); \
            ngi = (IG1 + rw_ * 8 + h)[voffG]; nfl = (FLOC1 + rw_ * 8 + h)[voffG]; if (wave == 0) { ngil = (IG1 + rw_ * 8 + h)[lane * 8]; nfll = (FLOC1 + rw_ * 8 + h)[lane * 8]; } } while (0)
        ML_LOAD_B(8 * j);
        gate_setup(ws, tb, b, h, lane, wave);
        if (tid < 128) tb[T_HG + tid] = p->in[I_L1HG][h * 128 + tid];
        *(LAS u32x2*)(Vl + t * LDV + 128 + 4 * dg) = (u32x2){dg == 0 ? 0x3F80u : 0u, 0u};
        ML_BAR();
        f32x16 S0 = {}, S1 = {}, SN = {};
        { const float Mstart = tb[T_MST + 8 * j];
#pragma unroll 5
          for (int jp = 0; jp < j; ++jp) { const float wgt = expf(tb[T_MST + 8 * jp + 8] - Mstart); const bf16* T = (const bf16*)TST + ((size_t)(unit - j + jp) * 8 + wave) * (6 * 64 * 8) + lane * 8;
#pragma unroll
              for (int g = 0; g < 4; ++g) { const v4u x = *(const GAS v4u*)(T + g * 512);
                  S0[4 * g] += wgt * bflo(x.x); S0[4 * g + 1] += wgt * bfhi(x.x); S0[4 * g + 2] += wgt * bflo(x.y); S0[4 * g + 3] += wgt * bfhi(x.y);
                  S1[4 * g] += wgt * bflo(x.z); S1[4 * g + 1] += wgt * bfhi(x.z); S1[4 * g + 2] += wgt * bflo(x.w); S1[4 * g + 3] += wgt * bfhi(x.w); }
              if (wave < 4) {
#pragma unroll
                  for (int g = 0; g < 2; ++g) { const v4u xn = *(const GAS v4u*)(T + (4 + g) * 512);
                      SN[8 * g] += wgt * bflo(xn.x); SN[8 * g + 1] += wgt * bfhi(xn.x); SN[8 * g + 2] += wgt * bflo(xn.y); SN[8 * g + 3] += wgt * bfhi(xn.y);
                      SN[8 * g + 4] += wgt * bflo(xn.z); SN[8 * g + 5] += wgt * bfhi(xn.z); SN[8 * g + 6] += wgt * bflo(xn.w); SN[8 * g + 7] += wgt * bfhi(xn.w); } } } }
#define ML_WRITE_SL() do { _Pragma("unroll") for (int g = 0; g < 4; ++g) { const int k0 = kt0 * 32 + 8 * g + 4 * hh; \
            st4(Sl + (vtile * 32 + r) * LD + k0, S0[4 * g], S0[4 * g + 1], S0[4 * g + 2], S0[4 * g + 3]); st4(Sl + (vtile * 32 + r) * LD + k0 + 32, S1[4 * g], S1[4 * g + 1], S1[4 * g + 2], S1[4 * g + 3]); \
            if (wave < 4) st4(Sl + (128 + r) * LD + wave * 32 + 8 * g + 4 * hh, SN[4 * g], SN[4 * g + 1], SN[4 * g + 2], SN[4 * g + 3]); } } while (0)
        ML_WRITE_SL();
        v4u oc0, oc1;
#define ML_STEP1(cidx, par_, more_) do { const int c_ = (cidx); const float Mc_ = tb[T_MST + c_], Mc1_ = tb[T_MST + c_ + 1], Fp_ = tb[T_FPRE + c_]; const int to_ = (par_) ? (T_DB2 - T_G2) : 0; \
            const bf16* os_ = P1 + ((size_t)b * SEQ + (size_t)c_ * 64) * N1 + 2048 + h * 128; oc0 = *(const GAS v4u*)(os_ + voffX); oc1 = *(const GAS v4u*)(os_ + voffX + 8); \
            const float w_ = expf(ngi - (Fp_ + nfl) - Mc1_); \
            *(LAS v4u*)(Ql + t * LD + 16 * dg) = nq0; *(LAS v4u*)(Ql + t * LD + 16 * dg + 8) = nq1; *(LAS v4u*)(Kl + t * LD + 16 * dg) = nk0; *(LAS v4u*)(Kl + t * LD + 16 * dg + 8) = nk1; \
            *(LAS v4u*)(Vl + t * LDV + 16 * dg) = nv0; *(LAS v4u*)(Vl + t * LDV + 16 * dg + 8) = nv1; \
            float kf_[16]; unpack16(nk0, nk1, kf_); _Pragma("unroll") for (int i = 0; i < 16; ++i) kf_[i] *= w_; \
            v4u p0_, p1_; pack16(kf_, p0_, p1_); *(LAS v4u*)(Kp + t * LDK + 16 * dg) = p0_; *(LAS v4u*)(Kp + t * LDK + 16 * dg + 8) = p1_; \
            if (wave == 0) { const float F_ = Fp_ + nfll; const float Gl_ = ngil - F_; const float M_ = fmaxf(Mc_, scan_max(Gl_, lane)); \
                tb[T_G2 + to_ + lane] = Gl_ * LOG2E; tb[T_M2 + to_ + lane] = M_ * LOG2E; tb[T_WI + to_ + lane] = expf(Mc_ - M_); tb[T_EDM + to_ + lane] = expf(-(F_ + M_)); } \
            if (more_) ML_LOAD_B(c_ + 1); } while (0)
        ML_STEP1(8 * j, 0, true);
        ML_BAR();
#pragma unroll 1
        for (int cc = 0; cc < 8; ++cc) {
            const int c = 8 * j + cc; const size_t row0 = (size_t)b * SEQ + c * 64; const int to = (cc & 1) ? (T_DB2 - T_G2) : 0;
            const float Mc = tb[T_MST + c], Mc1 = tb[T_MST + c + 1];
            const LAS bf16* tV = trV; const LAS bf16* tK = trK; ML_LAUNDER(tV); ML_LAUNDER(tK);
            const LAS bf16* tVv = tV + vtile * 32; const LAS bf16* tVh = tV + vth * 32; const LAS bf16* tKk = tK + kt0 * 32; const LAS bf16* tKw = tK + wave * 32;
            f32x16 aH = {}, aNq = {};
            {
                const LAS bf16* qb = Ql + (ttile * 32 + r) * LD + 8 * hh;
                aH = mma_nt8(aH, Sl + (vth * 32 + r) * LD + 8 * hh, qb);
                if (wave < 4) { const int stile = wave >> 1; f32x16 aP = {}; aP = mma_nt8(aP, Kl + (stile * 32 + r) * LD + 8 * hh, qb);
                    const int tq = ttile * 32 + r; const float m2 = tb[T_M2 + to + tq];
#pragma unroll
                    for (int g = 0; g < 4; ++g) { const int s0 = stile * 32 + 8 * g + 4 * hh; const f32x4 gg = *(const LAS f32x4*)(tb + T_G2 + to + s0); float pv[4];
#pragma unroll
                        for (int i = 0; i < 4; ++i) pv[i] = (s0 + i <= tq) ? aP[4 * g + i] * __builtin_amdgcn_exp2f(gg[i] - m2) : 0.f;
                        st4(Pl + tq * LDP + s0, pv[0], pv[1], pv[2], pv[3]); }
                } else if (wave < 6) { aNq = mma_nt8(aNq, Sl + (128 + r) * LD + 8 * hh, qb); }
            }
            ML_BAR();
            {
                const float wi = tb[T_WI + to + ttile * 32 + r];
#pragma unroll
                for (int i = 0; i < 16; ++i) aH[i] *= wi;
                const LAS bf16* pb = Pl + (ttile * 32 + r) * LDP + 8 * hh;
#pragma unroll
                for (int ks = 0; ks < 4; ++ks) aH = mfma32(tr_frag(tVh, LDV, 16 * ks * LDV), *(const LAS bf16x8*)(pb + 16 * ks), aH);
                if (wave >= 4 && wave < 6) {
#pragma unroll
                    for (int i = 0; i < 16; ++i) aNq[i] *= wi;
#pragma unroll
                    for (int ks = 0; ks < 4; ++ks) aNq = mfma32(tr_frag(tV, LDV, 16 * ks * LDV + 128), *(const LAS bf16x8*)(pb + 16 * ks), aNq);
                    if (hh == 0) tb[T_NQ + to + ttile * 32 + r] = aNq[0]; }
                { const int tq = ttile * 32 + r;
#pragma unroll
                  for (int g = 0; g < 4; ++g) st4(Hst + tq * LD + vth * 32 + 8 * g + 4 * hh, aH[4 * g], aH[4 * g + 1], aH[4 * g + 2], aH[4 * g + 3]); }
                const float dec = expf(Mc - Mc1);
#pragma unroll
                for (int i = 0; i < 16; ++i) { S0[i] *= dec; S1[i] *= dec; SN[i] *= dec; }
#pragma unroll
                for (int ks = 0; ks < 4; ++ks) { const bf16x8 bv = tr_frag(tVv, LDV, 16 * ks * LDV), a0 = tr_frag(tKk, LDK, 16 * ks * LDK), a1 = tr_frag(tKk, LDK, 16 * ks * LDK + 32);
                    S0 = mfma32(a0, bv, S0); S1 = mfma32(a1, bv, S1); }
                if (wave < 4) {
#pragma unroll
                    for (int ks = 0; ks < 4; ++ks) { const bf16x8 bn = tr_frag(tV, LDV, 16 * ks * LDV + 128), a = tr_frag(tKw, LDK, 16 * ks * LDK); SN = mfma32(a, bn, SN); } }
                ML_WRITE_SL();
            }
            ML_BAR();
            {
                float hv[16]; unpack16(*(const LAS v4u*)(Hst + t * LD + 16 * dg), *(const LAS v4u*)(Hst + t * LD + 16 * dg + 8), hv);
                const float inv = 1.0f / fmaxf(fabsf(tb[T_NQ + to + t]), tb[T_EDM + to + t]);
                float of[16]; unpack16(oc0, oc1, of);
                float ss = 0.f;
#pragma unroll
                for (int i = 0; i < 16; ++i) { hv[i] *= inv * fast_sigmoid(of[i]); ss += hv[i] * hv[i]; }
                ss += __shfl_xor(ss, 1); ss += __shfl_xor(ss, 2); ss += __shfl_xor(ss, 4);
                const float rstd = rsqrtf(ss * (1.f / 128.f) + EPS);
#pragma unroll
                for (int i = 0; i < 16; ++i) hv[i] = hv[i] * rstd * tb[T_HG + 16 * dg + i];
                v4u o0, o1; pack16(hv, o0, o1); bf16* od = CAT + row0 * 1024 + h * 128; *(GAS v4u*)(od + voffQ) = o0; *(GAS v4u*)(od + voffQ + 8) = o1;
            }
            if (cc < 7) ML_STEP1(c + 1, (cc + 1) & 1, cc < 6);
            ML_BAR();
        }
#undef ML_STEP1
#undef ML_WRITE_SL
#undef ML_LOAD_B
    }
}
}
__global__ void __launch_bounds__(NTHR, 2) fwd_kernel(KP p_unused) {
    extern __shared__ __attribute__((aligned(16))) unsigned char lds_raw[];
    LAS unsigned char* lds = (LAS unsigned char*)lds_raw;
    volatile LAS unsigned* MISC = (volatile LAS unsigned*)(lds + MISC_OFF);
    const int G = gridDim.x;
#define PH_IDS int tid = threadIdx.x; asm volatile("" : "+v"(tid)); const int lane = tid & 63, wave = __builtin_amdgcn_readfirstlane(tid >> 6); (void)lane; (void)wave;
    KPp p = kp_get();
    unsigned char* ws = p->ws;
    gu32* ctl = (gu32*)(ws + WS_CTL);
    { int t0 = threadIdx.x; asm volatile("" : "+v"(t0)); for (int u = t0; u < (LDS_BYTES - MISC_OFF) / 4; u += NTHR) ((LAS unsigned*)(lds + MISC_OFF))[u] = 0u; }
    __syncthreads();
    { const int lo0 = p->ph_lo, hi0 = p->ph_hi;
      if (hi0 - lo0 > 1) (void)xcd_barrier_post((unsigned*)(ctl + CW_BAR), MISC + 8); }
#define IN(k) (((p = kp_get()), (ws = p->ws), true) && p->ph_lo <= (k) && (k) < p->ph_hi)
#define SEAM(k) do { if (IN(k) && IN((k) + 1)) { XcdBarrier bar_; bar_.bar = (unsigned*)((gu32*)(ws + WS_CTL) + CW_BAR); bar_.x = xb_xcc_id(); bar_.st = (volatile LAS unsigned*)((LAS unsigned char*)lds_raw + MISC_OFF) + 8; xcd_barrier(bar_); } } while (0)
#define H ((bf16*)(ws + WS_H))
#define SEAMX() do { XcdBarrier bar_; bar_.bar = (unsigned*)((gu32*)(ws + WS_CTL) + CW_BAR); bar_.x = xb_xcc_id(); bar_.st = (volatile LAS unsigned*)((LAS unsigned char*)lds_raw + MISC_OFF) + 8; xcd_barrier(bar_); } while (0)
    if (IN(0)) { PH_IDS norm_phase<1, false, true>(p, lds, tid, lane, wave, p->in[I_X], p->in[I_L0N1G], H);     }
    SEAM(0);
    if (IN(1)) { if (G != 256 || blockIdx.x < CV_GEMM1) { const int Gg = G == 256 ? CV_GEMM1 : G;
        pg8::Gemm g{H, (const bf16*)(ws + WS_W0IN), MROWS, N0, 1024}; pg8::StaticOrder S; S.init(MROWS, N0, Gg, (int)blockIdx.x);
        pg8::EpiL0In E{(bf16*)(ws + WS_R), N0, attn_body::C2, (float*)(ws + WS_QKN)};
        pg8::gemm_phase<pg8::EpiL0In, pg8::StaticOrder, true, true>(lds, g, S, E); }
        if (G == 256) { PH_IDS __syncthreads(); convert_queue(p, lds, (unsigned*)(ws + WS_CTL) + CW_Q1, CV_FIRST, CV_ALL - CV_TAIL2 - CV_Q2 - CV_FIRST, tid, lane, wave); }     }
    SEAM(1);
    if (IN(2)) { const attn_body::bf16* P0 = (const attn_body::bf16*)(ws + WS_R);
        const attn_body::AttnTensors AT{P0, P0 + 512, P0 + 1024, (attn_body::bf16*)(ws + WS_CAT), (const float*)(ws + WS_FLOC0), (const float*)(ws + WS_FTOT0), (const float*)(ws + WS_QKN)};
        const attn_body::StaticOrder S(G, (int)blockIdx.x);
        attn_body::attn_phase<attn_body::StaticOrder>((char*)lds_raw, AT, S);
        __syncthreads();
        { PH_IDS conv_phase(p, lds, tid, lane, wave); if (G == 256) convert_queue(p, lds, (unsigned*)(ws + WS_CTL) + CW_Q2, CV_ALL - CV_TAIL2 - CV_Q2, CV_Q2, tid, lane, wave); } }
    SEAM(2);
    if (IN(3)) { pg8::Gemm g{(const bf16*)(ws + WS_CAT), (const bf16*)(ws + WS_W0OUT), MROWS, 1024, 1024}; pg8::StaticOrder S; S.init(MROWS, 1024, G, (int)blockIdx.x);
        pg8::EpiRes<true> E{p->in[I_X], (bf16*)(ws + WS_X), 1024, (float*)(ws + WS_ROWSS)};
        pg8::gemm_phase<pg8::EpiRes<true>, pg8::StaticOrder, true, true>(lds, g, S, E); }
    SEAM(3);
    if (IN(4)) { pg8::Gemm g{(const bf16*)(ws + WS_X), (const bf16*)(ws + WS_W0GU), MROWS, 2 * DFF, 1024};     pg8::StaticOrder S; S.init(MROWS, 2 * DFF, G, (int)blockIdx.x);
        pg8::EpiSwiGLU E{(bf16*)(ws + WS_R), DFF, (const float*)(ws + WS_ROWSS)};
        pg8::gemm_phase<pg8::EpiSwiGLU, pg8::StaticOrder, true, true>(lds, g, S, E);
        if (G == 256 && blockIdx.x >= 128) { PH_IDS __syncthreads(); convert_weights(p, lds, CV_ALL - CV_TAIL2, CV_ALL, (blockIdx.x - 128) * NWAVES + wave, 128 * NWAVES, lane, wave); } }
    SEAM(4);
    if (IN(5)) { pg8::Gemm g{(const bf16*)(ws + WS_R), (const bf16*)(ws + WS_W0D), MROWS, 1024, DFF}; pg8::StaticOrder S; S.init(MROWS, 1024, G, (int)blockIdx.x);
        pg8::EpiRes<false> E{ws + WS_X, (bf16*)(ws + WS_X), 1024, nullptr};
        pg8::gemm_phase<pg8::EpiRes<false>, pg8::StaticOrder, true, true>(lds, g, S, E); }
    SEAM(5);
    if (IN(6)) { PH_IDS norm_phase<2, true>(p, lds, tid, lane, wave, ws + WS_X, p->in[I_L1N1G], H); }
    SEAM(6);
    if (IN(7)) { pg8::Gemm g{H, (const bf16*)(ws + WS_W1IN), MROWS, N1, 1024}; pg8::StaticOrder S; S.init(MROWS, N1, G, (int)blockIdx.x);
        pg8::EpiBf16<0> E{(bf16*)(ws + WS_R), N1, nullptr, 0, 0, 1.f};
        pg8::gemm_phase<pg8::EpiBf16<0>, pg8::StaticOrder, true, true>(lds, g, S, E); }
    SEAM(7);
    if (IN(8)) { PH_IDS ml::pass_a(p, lds, tid, lane, wave); }
    SEAM(8);
    if (IN(9)) { PH_IDS ml::pass_b(p, lds, tid, lane, wave); }
    SEAM(9);
    if (IN(10)) { pg8::Gemm g{(const bf16*)(ws + WS_CAT), (const bf16*)(ws + WS_W1OUT), MROWS, 1024, 1024}; pg8::StaticOrder S; S.init(MROWS, 1024, G, (int)blockIdx.x);
        pg8::EpiRes<false> E{ws + WS_X, (bf16*)(ws + WS_X), 1024, nullptr};
        pg8::gemm_phase<pg8::EpiRes<false>, pg8::StaticOrder, true, true>(lds, g, S, E); }
    SEAM(10);
    if (IN(11)) { PH_IDS norm_phase<3, true>(p, lds, tid, lane, wave, ws + WS_X, p->in[I_L1N2G], H); }
    SEAM(11);
    if (IN(12)) { pg8::Gemm8 g{ws + WS_AG8, ws + WS_EGU8, MOE_ROWS, 2 * DFFE, 1024}; pg8::MoeOrder S; S.init((const unsigned*)(ws + WS_CTL) + CW_CNT, 2 * DFFE / 256, G, (int)blockIdx.x, true, (unsigned*)(ws + WS_CTL) + CW_RDY);
        pg8::EpiSwiGLU8 E{ws + WS_ACTM8, DFFE, 0.0078125f, 4.f};
        pg8::gemm_phase_f8<pg8::EpiSwiGLU8, pg8::MoeOrder, true, true>(lds, g, S, E); }
    if (IN(13)) { pg8::Gemm8 g{ws + WS_ACTM8, ws + WS_ED8, MOE_ROWS, 1024, DFFE}; pg8::MoeDownOrder S; S.init((const unsigned*)(ws + WS_CTL) + CW_CNT, G, (int)blockIdx.x, (const unsigned*)(ws + WS_CTL) + CW_RDY);
        pg8::EpiRowScale E{(bf16*)(ws + WS_Y), 1024, (const float*)(ws + WS_SGATE2), 0.00390625f, (bf16*)(ws + WS_YS)};
        pg8::gemm_phase_f8<pg8::EpiRowScale, pg8::MoeDownOrder, true, true>(lds, g, S, E); }
    SEAM(13);
    if (IN(14)) { PH_IDS final_phase(p, lane, wave); }
#undef IN
#undef SEAM
#undef SEAMX
#undef H
#undef PH_IDS
}

extern "C" void kernel_launch(void* const* d_in, const int* in_sizes, int n_in, void* d_out, int out_size, void* d_ws, size_t ws_size, hipStream_t stream) {
    static int grid = 0;
    if (grid == 0) {
        if (n_in != 29 || in_sizes[0] != MROWS * DMODEL || out_size != MROWS * DMODEL || ws_size < WS_END) { fprintf(stderr, "kernel_launch: unexpected problem (n_in %d, ws %zu < %zu?)\n", n_in, ws_size, (size_t)WS_END); grid = -1; return; }
        int dev = 0, cus = 0, per_cu = 0;
        if (hipGetDevice(&dev) != hipSuccess || hipDeviceGetAttribute(&cus, hipDeviceAttributeMultiprocessorCount, dev) != hipSuccess) { grid = -1; return; }
        if (hipFuncSetAttribute((const void*)fwd_kernel, hipFuncAttributeMaxDynamicSharedMemorySize, LDS_BYTES) != hipSuccess) { fprintf(stderr, "kernel_launch: hipFuncSetAttribute failed\n"); grid = -1; return; }
        if (hipOccupancyMaxActiveBlocksPerMultiprocessor(&per_cu, (const void*)fwd_kernel, NTHR, LDS_BYTES) != hipSuccess || per_cu < 1) { fprintf(stderr, "kernel_launch: occupancy query says %d\n", per_cu); }
        (void)hipGetLastError();
        grid = cus > 256 ? 256 : cus;
    }
    if (grid < 0) return;
    (void)hipMemsetAsync((char*)d_ws + WS_CTL, 0, CTL_ZERO_BYTES, stream);
    KP a{};
    for (int i = 0; i < 29; ++i) a.in[i] = (const float*)d_in[i];
    a.out = (float*)d_out; a.ws = (unsigned char*)d_ws;
#if MK_ONE_LAUNCH
    a.ph_lo = 0; a.ph_hi = NPHASE;
    hipLaunchKernelGGL(fwd_kernel, dim3(grid), dim3(NTHR), LDS_BYTES, stream, a);
#else
    for (int ph = 0; ph < NPHASE; ++ph) { a.ph_lo = ph; a.ph_hi = ph + 1; hipLaunchKernelGGL(fwd_kernel, dim3(grid), dim3(NTHR), LDS_BYTES, stream, a); }
#endif
}
```
